# Optimizing an MI355X kernel written in HIP

```python
import jax, jax.numpy as jnp
from jax import lax
import numpy as np

D_MODEL = 1024
BATCH = 16
SEQ = 4096
DEPTH = 2
DEC_BATCH = 8
DEC_SEQ = 16
PAST_LEN = 2048

CHUNK = 64
MIX = D_MODEL
HEAD_DIM = 64
N_ATT_HEADS = 8
D_ATT = N_ATT_HEADS * HEAD_DIM
POOL_WINDOWS = (2, 4, 8, 16)
POOL_GROUP = 64
D_POOL = POOL_GROUP * len(POOL_WINDOWS)
POOL_STATE = max(POOL_WINDOWS) - 1
CONV_GROUP = 64
N_CONV_GROUPS = 4
D_CONV = CONV_GROUP * N_CONV_GROUPS
CONV_W = 3
Q_BLOCK = 128
EPS = 1e-6
IN_SPLITS = (D_POOL, D_POOL, D_ATT, D_ATT, D_ATT, D_ATT, N_ATT_HEADS, D_CONV, D_CONV, D_CONV, D_CONV)
IN_COLS = 2 * D_POOL + 4 * D_ATT + N_ATT_HEADS + 4 * D_CONV

kernel_name = "hybrid_pool_fox_shortconv_stream_step"


def _split_points():
    pts, acc = [], 0
    for w in IN_SPLITS[:-1]:
        acc += w
        pts.append(acc)
    return pts


def rmsnorm(x, g):
    xf = x.astype(jnp.float32)
    y = xf * lax.rsqrt(jnp.mean(xf * xf, axis=-1, keepdims=True) + EPS)
    return (y * g.astype(jnp.float32)).astype(x.dtype)


def pool_mixer(u, prev, past):
    T = u.shape[1]
    ext = jnp.concatenate([prev.astype(u.dtype), u], axis=1)
    cs = jnp.cumsum(ext.astype(jnp.float32), axis=1)
    cs = jnp.concatenate([jnp.zeros_like(cs[:, :1]), cs], axis=1)
    pos = past + jnp.arange(T)
    means = []
    for g, w in enumerate(POOL_WINDOWS):
        c0, c1 = g * POOL_GROUP, (g + 1) * POOL_GROUP
        hi = cs[:, POOL_STATE + 1:POOL_STATE + 1 + T, c0:c1]
        lo = cs[:, POOL_STATE + 1 - w:POOL_STATE + 1 - w + T, c0:c1]
        cnt = jnp.minimum(pos + 1, w).astype(jnp.float32)[None, :, None]
        means.append((hi - lo) / cnt)
    pooled = jnp.concatenate(means, axis=-1) - u.astype(jnp.float32)
    return pooled, ext[:, -POOL_STATE:]


def conv_mixer(bg, cg, xc, prev):
    T = xc.shape[1]
    z = cg * xc
    ext = jnp.concatenate([prev.astype(z.dtype), z], axis=1)
    return ext, T


def attend(q, K, V, Fq, Fk, q_pos, k_pos):
    B, T, H, Dh = q.shape
    qb = min(Q_BLOCK, T)
    nb = T // qb
    scale = Dh ** -0.5
    qs = q.reshape(B, nb, qb, H, Dh).transpose(1, 0, 2, 3, 4)
    fqs = Fq.reshape(B, nb, qb, H).transpose(1, 0, 3, 2)
    ps = q_pos.reshape(nb, qb)
    fkT = Fk.transpose(0, 2, 1)[:, :, None, :]

    def block(args):
        qblk, fblk, pblk = args
        s = jnp.einsum('bqhd,bkhd->bhqk', qblk, K, preferred_element_type=jnp.float32) * scale
        s = s + fblk[..., None] - fkT
        mask = k_pos[None, :] <= pblk[:, None]
        s = jnp.where(mask[None, None], s, -jnp.inf)
        p = jax.nn.softmax(s, axis=-1)
        return jnp.einsum('bhqk,bkhd->bqhd', p.astype(V.dtype), V)

    o = lax.map(block, (qs, fqs, ps))
    return o.transpose(1, 0, 2, 3, 4).reshape(B, T, H, Dh)


def layer(x, prev_k, prev_v, prev_logf, prev_pool, prev_conv,
          norm_g, w_in, b_f, q_norm_g, k_norm_g, pool_w, pool_scale, conv_w, w_out):
    B, T, _ = x.shape
    past = prev_k.shape[1]
    h = rmsnorm(x, norm_g)
    proj = jnp.einsum('btd,de->bte', h, w_in)
    pu, pg, q, k, v, ag, fl, cb, cc, cx, cgate = jnp.split(proj, _split_points(), axis=-1)

    pooled, new_pool = pool_mixer(pu, prev_pool, past)
    pooled = pooled.reshape(B, T, len(POOL_WINDOWS), POOL_GROUP)
    a = jnp.einsum('btgc,gcd->btgd', pooled, pool_w.astype(jnp.float32)).reshape(B, T, D_POOL)
    a = (a * pool_scale.astype(jnp.float32)).astype(h.dtype) * jax.nn.silu(pg)

    q = rmsnorm(q.reshape(B, T, N_ATT_HEADS, HEAD_DIM), q_norm_g)
    k = rmsnorm(k.reshape(B, T, N_ATT_HEADS, HEAD_DIM), k_norm_g)
    v = v.reshape(B, T, N_ATT_HEADS, HEAD_DIM)
    logf = jax.nn.log_sigmoid(fl.astype(jnp.float32) + b_f.astype(jnp.float32))
    K = jnp.concatenate([prev_k.astype(k.dtype), k], axis=1)
    V = jnp.concatenate([prev_v.astype(v.dtype), v], axis=1)
    F = jnp.cumsum(jnp.concatenate([prev_logf.astype(jnp.float32), logf], axis=1), axis=1)
    k_pos = jnp.arange(past + T)
    q_pos = past + jnp.arange(T)
    o = attend(q, K, V, F[:, past:], F, q_pos, k_pos)
    b = o.reshape(B, T, D_ATT).astype(h.dtype) * jax.nn.silu(ag)

    ext, _ = conv_mixer(cb, cc, cx, prev_conv)
    y = sum(conv_w[j][None, None, :] * ext[:, j:j + T] for j in range(CONV_W))
    c = (cb * y) * jax.nn.silu(cgate)
    new_conv = ext[:, -(CONV_W - 1):]

    mixed = jnp.concatenate([a, b, c.astype(h.dtype)], axis=-1)
    x_out = x + jnp.einsum('bte,ed->btd', mixed, w_out).astype(x.dtype)
    return x_out, k, v, logf.astype(x.dtype), new_pool, new_conv


def setup_inputs(seed: int = 0) -> dict:
    key = jax.random.key(seed)
    ks = jax.random.split(key, 20)
    f32 = jnp.float32
    x_prompt = jax.random.normal(ks[0], (BATCH, SEQ, D_MODEL), f32)
    x_sample = jax.random.normal(ks[1], (DEC_BATCH, DEC_SEQ, D_MODEL), f32)
    cache_k = jax.random.normal(ks[2], (DEPTH, DEC_BATCH, PAST_LEN, N_ATT_HEADS, HEAD_DIM), f32)
    cache_v = jax.random.normal(ks[3], (DEPTH, DEC_BATCH, PAST_LEN, N_ATT_HEADS, HEAD_DIM), f32)
    cache_logf = jax.nn.log_sigmoid(3.0 + jax.random.normal(ks[4], (DEPTH, DEC_BATCH, PAST_LEN, N_ATT_HEADS), f32))
    state_pool = jax.random.normal(ks[5], (DEPTH, DEC_BATCH, POOL_STATE, D_POOL), f32)
    state_conv = jax.random.normal(ks[6], (DEPTH, DEC_BATCH, CONV_W - 1, D_CONV), f32)
    norm_g = 1.0 + 0.1 * jax.random.normal(ks[7], (DEPTH, D_MODEL), f32)
    w_in = jax.random.normal(ks[8], (DEPTH, D_MODEL, IN_COLS), f32) * D_MODEL ** -0.5
    b_f = 3.0 + 0.1 * jax.random.normal(ks[9], (DEPTH, N_ATT_HEADS), f32)
    q_norm_g = 1.0 + 0.1 * jax.random.normal(ks[10], (DEPTH, HEAD_DIM), f32)
    k_norm_g = 1.0 + 0.1 * jax.random.normal(ks[11], (DEPTH, HEAD_DIM), f32)
    pool_w = jax.random.normal(ks[12], (DEPTH, len(POOL_WINDOWS), POOL_GROUP, POOL_GROUP), f32) * POOL_GROUP ** -0.5
    pool_scale = 1.0 + 0.1 * jax.random.normal(ks[13], (DEPTH, D_POOL), f32)
    conv_w = jax.random.normal(ks[14], (DEPTH, CONV_W, D_CONV), f32) * CONV_W ** -0.5
    w_out = jax.random.normal(ks[15], (DEPTH, MIX, D_MODEL), f32) * (0.5 * MIX ** -0.5)
    return {"x_prompt": x_prompt, "x_sample": x_sample,
            "cache_k": cache_k, "cache_v": cache_v, "cache_logf": cache_logf,
            "state_pool": state_pool, "state_conv": state_conv,
            "norm_g": norm_g, "w_in": w_in, "b_f": b_f, "q_norm_g": q_norm_g, "k_norm_g": k_norm_g,
            "pool_w": pool_w, "pool_scale": pool_scale, "conv_w": conv_w, "w_out": w_out}


def reference(x_prompt, x_sample, cache_k, cache_v, cache_logf, state_pool, state_conv,
              norm_g, w_in, b_f, q_norm_g, k_norm_g, pool_w, pool_scale, conv_w, w_out):
    Bp = x_prompt.shape[0]
    dt = x_prompt.dtype
    xp, xs = x_prompt, x_sample
    kp, vp, fp, pp, cp = [], [], [], [], []
    ksm, vsm, fsm, psm, csm = [], [], [], [], []
    for l in range(DEPTH):
        params = (norm_g[l], w_in[l], b_f[l], q_norm_g[l], k_norm_g[l],
                  pool_w[l], pool_scale[l], conv_w[l], w_out[l])
        xp, k1, v1, f1, p1, c1 = layer(
            xp,
            jnp.zeros((Bp, 0, N_ATT_HEADS, HEAD_DIM), dt),
            jnp.zeros((Bp, 0, N_ATT_HEADS, HEAD_DIM), dt),
            jnp.zeros((Bp, 0, N_ATT_HEADS), dt),
            jnp.zeros((Bp, POOL_STATE, D_POOL), dt),
            jnp.zeros((Bp, CONV_W - 1, D_CONV), dt),
            *params)
        kp.append(k1); vp.append(v1); fp.append(f1); pp.append(p1); cp.append(c1)
        xs, k2, v2, f2, p2, c2 = layer(
            xs, cache_k[l], cache_v[l], cache_logf[l], state_pool[l], state_conv[l], *params)
        ksm.append(k2); vsm.append(v2); fsm.append(f2); psm.append(p2); csm.append(c2)
    return (xp, xs,
            jnp.stack(kp), jnp.stack(vp), jnp.stack(fp), jnp.stack(pp), jnp.stack(cp),
            jnp.stack(ksm), jnp.stack(vsm), jnp.stack(fsm), jnp.stack(psm), jnp.stack(csm))
```

```cpp
#include <hip/hip_runtime.h>
#include <hip/hip_cooperative_groups.h>
#include <hip/hip_bf16.h>
#include <cstdio>
#include <cstdint>
#include <cmath>
namespace pg8 {
#define PG8_LAS __attribute__((address_space(3)))
typedef unsigned short bf16_t;
typedef short bf16x8 __attribute__((ext_vector_type(8)));
typedef float f32x4 __attribute__((ext_vector_type(4)));
typedef unsigned u32x4 __attribute__((ext_vector_type(4)));
constexpr int BM = 256, BK = 64, HALF = 128, HTB = HALF * BK * 2  , STAGE_BYTES = 8 * HTB, NXCD = 8, WGM = 8;

__host__ __device__ __forceinline__ int lds_byte(int r, int c) { const int st = (r >> 4) * 2 + (c >> 5), rr = r & 15, cc = c & 31, ob = rr * 64 + cc * 2; return st * 1024 + (ob ^ (((ob >> 9) & 1) << 5)); }
__host__ __device__ __forceinline__ void stage_rc(int b, int& R, int& C) { const int st = b / 1024, sb = b % 1024, swz = sb ^ (((sb >> 9) & 1) << 5); R = (st >> 1) * 16 + swz / 64; C = (st & 1) * 32 + (swz % 64) / 2; }
__host__ __device__ __forceinline__ int perm32(int rho) { const int n = rho >> 4, i = rho & 15; return 8 * (i >> 2) + 4 * n + (i & 3); }

struct Unit { int pm, pn; };
struct Gemm { const bf16_t* A; const bf16_t* Bt; int M, N, K; };

struct StaticOrder {
    int nM, nN, nwg, G, c;
    __host__ __device__ void init(int M, int N, int G_, int c_) { nM = M / BM; nN = N / BM; nwg = nM * nN; G = G_; c = c_; }
    __host__ __device__ bool next(int i, Unit& u) const {
        const long L = (long)i * G + c; if (L >= nwg) return false;
        int wgid = (int)L; { const int q = nwg / NXCD, r = nwg % NXCD, xcd = wgid % NXCD, off = wgid / NXCD; wgid = (xcd < r ? xcd * (q + 1) : r * (q + 1) + (xcd - r) * q) + off; }
        const int nig = WGM * nN, gid = wgid / nig, fm = gid * WGM, gsz = (nM - fm) < WGM ? (nM - fm) : WGM;
        u.pm = fm + ((wgid % nig) % gsz); u.pn = (wgid % nig) / gsz; return true;
    }
    __device__ __forceinline__ void a_ready(const Unit&) const {}
    __device__ __forceinline__ void done(const Unit&) const {}
};

__device__ __forceinline__ unsigned cvt_pk_bf16(float lo, float hi) { unsigned r; asm volatile("v_cvt_pk_bf16_f32 %0, %1, %2" : "=v"(r) : "v"(lo), "v"(hi)); return r; }
typedef float f32x2 __attribute__((ext_vector_type(2)));
constexpr int E_MP = 65536, E_PP = 3584, E_KSROWS = 2176, E_PAST = 2048;
constexpr float E_C2 = 0.125f * 1.4426950408889634f;
struct EpiIn {
    static constexpr bool PERM = true, AFTER_DRAIN = false;
    bf16_t* proj; bf16_t* ks; bf16_t* vs; float* outk_p; float* outv_p; float* outk_s; float* outv_s; const float* qg; const float* kg;
    __device__ __forceinline__ void operator()(const f32x4 (&acc)[2][2][4][2], const Unit& u, int wr, int wc, int fr, int fq) const {
        const int pn = u.pn; const bool samp = (u.pm == E_MP / 256);
        const int nai = samp ? 1 : 2;
        if (pn >= 2 && pn <= 5) {
            const bool isq = pn < 4; const int head = (pn & 1) * 4 + wc;
            const float* g = isq ? qg : kg;
            f32x4 gv[2][2];
#pragma unroll
            for (int bj = 0; bj < 2; ++bj)
#pragma unroll
                for (int n = 0; n < 2; ++n) gv[bj][n] = *(const f32x4*)(g + 32 * bj + 8 * fq + 4 * n);
#pragma unroll
            for (int ai = 0; ai < 2; ++ai) if (ai < nai)
#pragma unroll
                for (int m = 0; m < 4; ++m) {
                    const int row = u.pm * BM + ai * HALF + wr * 64 + m * 16 + fr;
                    float ss = 0.f;
#pragma unroll
                    for (int bj = 0; bj < 2; ++bj)
#pragma unroll
                        for (int n = 0; n < 2; ++n) { const f32x4 x = acc[ai][bj][m][n]; ss += (x[0] * x[0] + x[1] * x[1]) + (x[2] * x[2] + x[3] * x[3]); }
                    { const int ln = fr + 16 * fq; ss += __int_as_float(__builtin_amdgcn_ds_bpermute((ln ^ 16) << 2, __float_as_int(ss))); ss += __int_as_float(__builtin_amdgcn_ds_bpermute((ln ^ 32) << 2, __float_as_int(ss))); }
                    float rs = 1.0f / sqrtf(ss * (1.0f / 64.0f) + 1e-6f);
                    const float rq = rs * E_C2;
#pragma unroll
                    for (int bj = 0; bj < 2; ++bj) {
                        const f32x4 k0 = acc[ai][bj][m][0] * rs * gv[bj][0], k1 = acc[ai][bj][m][1] * rs * gv[bj][1];
                        const int col = head * 64 + 32 * bj + 8 * fq;
                        if (isq) { const f32x4 v0 = acc[ai][bj][m][0] * rq * gv[bj][0], v1 = acc[ai][bj][m][1] * rq * gv[bj][1];
                            u32x4 w; w.x = cvt_pk_bf16(v0[0], v0[1]); w.y = cvt_pk_bf16(v0[2], v0[3]); w.z = cvt_pk_bf16(v1[0], v1[1]); w.w = cvt_pk_bf16(v1[2], v1[3]);
                            *(u32x4*)(proj + (size_t)row * E_PP + 512 + col) = w; }
                        else { u32x4 w; w.x = cvt_pk_bf16(k0[0], k0[1]); w.y = cvt_pk_bf16(k0[2], k0[3]); w.z = cvt_pk_bf16(k1[0], k1[1]); w.w = cvt_pk_bf16(k1[2], k1[3]);
                            if (!samp) { *(u32x4*)(proj + (size_t)row * E_PP + 1024 + col) = w; float* o = outk_p + (size_t)row * 512 + col; *(f32x4*)o = k0; *(f32x4*)(o + 4) = k1; }
                            else { const int lr = row - E_MP, b = lr >> 4, t = lr & 15; *(u32x4*)(ks + ((size_t)b * E_KSROWS + E_PAST + t) * 512 + col) = w; float* o = outk_s + (size_t)lr * 512 + col; *(f32x4*)o = k0; *(f32x4*)(o + 4) = k1; } }
                    }
                }
        } else if (pn == 6 || pn == 7) {
#pragma unroll
            for (int ai = 0; ai < 2; ++ai) if (ai < nai)
#pragma unroll
                for (int m = 0; m < 4; ++m) {
                    const int row = u.pm * BM + ai * HALF + wr * 64 + m * 16 + fr;
#pragma unroll
                    for (int bj = 0; bj < 2; ++bj) {
                        const f32x4 v0 = acc[ai][bj][m][0], v1 = acc[ai][bj][m][1];
                        const int col = (pn - 6) * 256 + 128 * bj + 32 * wc + 8 * fq;
                        u32x4 w; w.x = cvt_pk_bf16(v0[0], v0[1]); w.y = cvt_pk_bf16(v0[2], v0[3]); w.z = cvt_pk_bf16(v1[0], v1[1]); w.w = cvt_pk_bf16(v1[2], v1[3]);
                        if (!samp) { *(u32x4*)(proj + (size_t)row * E_PP + 1536 + col) = w; float* o = outv_p + (size_t)row * 512 + col; *(f32x4*)o = v0; *(f32x4*)(o + 4) = v1; }
                        else { const int lr = row - E_MP, b = lr >> 4, t = lr & 15; *(u32x4*)(vs + ((size_t)b * E_KSROWS + E_PAST + t) * 512 + col) = w; float* o = outv_s + (size_t)lr * 512 + col; *(f32x4*)o = v0; *(f32x4*)(o + 4) = v1; }
                    }
                }
        } else {
#pragma unroll
            for (int ai = 0; ai < 2; ++ai) if (ai < nai)
#pragma unroll
                for (int m = 0; m < 4; ++m) {
                    bf16_t* rowp = proj + (size_t)(u.pm * BM + ai * HALF + wr * 64 + m * 16 + fr) * E_PP + pn * BM + wc * 32 + 8 * fq;
#pragma unroll
                    for (int bj = 0; bj < 2; ++bj) { const f32x4 v0 = acc[ai][bj][m][0], v1 = acc[ai][bj][m][1];
                        u32x4 w; w.x = cvt_pk_bf16(v0[0], v0[1]); w.y = cvt_pk_bf16(v0[2], v0[3]); w.z = cvt_pk_bf16(v1[0], v1[1]); w.w = cvt_pk_bf16(v1[2], v1[3]);
                        *(u32x4*)(rowp + bj * HALF) = w; }
                }
        }
    }
};
struct EpiOut {
    static constexpr bool PERM = false, AFTER_DRAIN = false;
    const float* base_p; const float* base_s; float* out_p; float* out_s;
    __device__ __forceinline__ void operator()(const f32x4 (&acc)[2][2][4][2], const Unit& u, int wr, int wc, int fr, int fq) const {
        const bool samp = (u.pm == E_MP / 256);
        const int nai = samp ? 1 : 2;
        const int col0 = u.pn * BM + wc * 32 + 4 * fq;
#pragma unroll
        for (int ai = 0; ai < 2; ++ai) if (ai < nai)
#pragma unroll
            for (int m = 0; m < 4; ++m) {
                const int row = u.pm * BM + ai * HALF + wr * 64 + m * 16 + fr;
                const size_t off = samp ? (size_t)(row - E_MP) * 1024 + col0 : (size_t)row * 1024 + col0;
                const float* bp = (samp ? base_s : base_p) + off; float* op = (samp ? out_s : out_p) + off;
#pragma unroll
                for (int bj = 0; bj < 2; ++bj)
#pragma unroll
                    for (int n = 0; n < 2; ++n) { const f32x4 bs = *(const f32x4*)(bp + bj * HALF + n * 16); *(f32x4*)(op + bj * HALF + n * 16) = bs + acc[ai][bj][m][n]; }
            }
    }
};
template <class Epi, class Sched, bool ALIGN_EPI = false, bool SP2 = false>
__device__ __forceinline__ void gemm_phase(PG8_LAS unsigned char* lds, const Gemm g, const Sched& S, const Epi& E, int tid_in) {
    int tid_ = tid_in; asm volatile("" : "+v"(tid_));
    const int tid = tid_, wid = __builtin_amdgcn_readfirstlane(tid >> 6), lane = tid & 63, wr = wid >> 2, wc = wid & 3, fr = lane & 15, fq = lane >> 4;
    const int K = g.K, nt = K / BK;
    unsigned voffA[2], voffB[2];
#pragma unroll
    for (int i = 0; i < 2; ++i) { int R, C; stage_rc(tid * 16 + i * 8192, R, C); const int Rb = Epi::PERM ? ((R & ~31) + perm32(R & 31)) : R;
        voffA[i] = (unsigned)(R * K + C) * 2u; voffB[i] = (unsigned)(Rb * K + C) * 2u; }
    const size_t kstep = (size_t)(BK * 2);
    const size_t hstep = (size_t)HALF * K * 2;
    const size_t tstep = 2 * hstep;
    const unsigned ldsw = (unsigned)wid * 1024u;
    const int aoff = lds_byte(wr * 64 + fr, fq * 8), boff = lds_byte(wc * 32 + fr, fq * 8);
#define PG8_SA(b, h) (((b) * 2 + (h)) * HTB)
#define PG8_SB(b, h) ((4 + (b) * 2 + (h)) * HTB)
#define PG8_STAGE(bufoff, gbase, voff) do { _Pragma("unroll") for (int _i = 0; _i < 2; ++_i) \
        __builtin_amdgcn_global_load_lds((const unsigned*)((const char*)(gbase) + (voff)[_i]), (PG8_LAS unsigned*)(lds + (bufoff) + ldsw + _i * 8192), 16, 0, 0); } while (0)
#define PG8_LDA(dst, b, h) do { _Pragma("unroll") for (int m = 0; m < 4; ++m) _Pragma("unroll") for (int k = 0; k < 2; ++k) dst[m][k] = *(const PG8_LAS bf16x8*)(lds + PG8_SA(b, h) + aoff + m * 2048 + k * 1024); } while (0)
#define PG8_LDB(dst, b, h) do { _Pragma("unroll") for (int n = 0; n < 2; ++n) _Pragma("unroll") for (int k = 0; k < 2; ++k) dst[n][k] = *(const PG8_LAS bf16x8*)(lds + PG8_SB(b, h) + boff + n * 2048 + k * 1024); } while (0)
#define PG8_MMA(ai, bj, At, Bt) do { __builtin_amdgcn_s_setprio(1); _Pragma("unroll") for (int m = 0; m < 4; ++m) _Pragma("unroll") for (int n = 0; n < 2; ++n) _Pragma("unroll") for (int k = 0; k < 2; ++k) \
        acc[ai][bj][m][n] = __builtin_amdgcn_mfma_f32_16x16x32_bf16(Bt[n][k], At[m][k], acc[ai][bj][m][n], 0, 0, 0); __builtin_amdgcn_s_setprio(0); } while (0)
#define PG8_WAIT_V(n) asm volatile("s_waitcnt vmcnt(" #n ")" ::: "memory")
#define PG8_WAIT_L(n) asm volatile("s_waitcnt lgkmcnt(" #n ")" ::: "memory")
#define PG8_BAR __builtin_amdgcn_s_barrier()
#define PG8_SCHED __builtin_amdgcn_sched_barrier(0)
    Unit cur, nxt; int ui = 0;
    if (!S.next(0, cur)) return;
    f32x4 acc[2][2][4][2];
#pragma unroll
    for (int a = 0; a < 2; ++a)
#pragma unroll
        for (int b = 0; b < 2; ++b)
#pragma unroll
            for (int m = 0; m < 4; ++m)
#pragma unroll
                for (int n = 0; n < 2; ++n) acc[a][b][m][n] = (f32x4){0.f, 0.f, 0.f, 0.f};
    bf16x8 At[4][2], B0[2][2], B1[2][2];
    const char* cA = (const char*)g.A + (size_t)cur.pm * tstep; const char* cB = (const char*)g.Bt + (size_t)cur.pn * tstep;
    S.a_ready(cur);
    if constexpr (SP2) {
        PG8_STAGE(PG8_SB(0, 0), cB, voffB); PG8_STAGE(PG8_SB(0, 1), cB + hstep, voffB); PG8_STAGE(PG8_SA(0, 0), cA, voffA); PG8_STAGE(PG8_SA(0, 1), cA + hstep, voffA);
        if (wr == 1) PG8_BAR;
        PG8_WAIT_V(2); PG8_BAR;
        PG8_STAGE(PG8_SB(1, 0), cB + kstep, voffB); PG8_STAGE(PG8_SA(1, 0), cA + kstep, voffA); PG8_STAGE(PG8_SB(1, 1), cB + hstep + kstep, voffB);
        PG8_WAIT_V(6); PG8_BAR;
    } else {
        PG8_STAGE(PG8_SB(0, 0), cB, voffB); PG8_STAGE(PG8_SA(0, 0), cA, voffA); PG8_STAGE(PG8_SB(0, 1), cB + hstep, voffB); PG8_STAGE(PG8_SA(0, 1), cA + hstep, voffA);
        if (wr == 1) PG8_BAR;
        PG8_WAIT_V(4); PG8_BAR;
        PG8_STAGE(PG8_SB(1, 0), cB + kstep, voffB); PG8_STAGE(PG8_SA(1, 0), cA + kstep, voffA); PG8_STAGE(PG8_SB(1, 1), cB + hstep + kstep, voffB);
        PG8_WAIT_V(6); PG8_BAR;
    }
    for (;;) {
        const bool has_next = S.next(ui + 1, nxt);
        const char* nA = has_next ? (const char*)g.A + (size_t)nxt.pm * tstep : cA; const char* nB = has_next ? (const char*)g.Bt + (size_t)nxt.pn * tstep : cB;
        for (int t = 0; t < nt; t += 2) {
            const bool last = (t == nt - 2);
            const char* a1 = cA + (size_t)(t + 1) * kstep;
            const char* a2 = last ? nA : cA + (size_t)(t + 2) * kstep; const char* b2 = last ? nB : cB + (size_t)(t + 2) * kstep;
            const char* a3 = a2 + kstep; const char* b3 = b2 + kstep;
            if (last && has_next) S.a_ready(nxt);
            if constexpr (SP2) {
            PG8_LDB(B0, 0, 0); PG8_LDB(B1, 0, 1); PG8_SCHED; PG8_LDA(At, 0, 0); PG8_STAGE(PG8_SA(1, 1), a1 + hstep, voffA);
            PG8_WAIT_V(8); PG8_WAIT_L(0); PG8_BAR; PG8_MMA(0, 0, At, B0); PG8_MMA(0, 1, At, B1); PG8_BAR; PG8_SCHED;
            PG8_LDA(At, 0, 1); PG8_STAGE(PG8_SB(0, 0), b2, voffB); PG8_STAGE(PG8_SB(0, 1), b2 + hstep, voffB); PG8_STAGE(PG8_SA(0, 0), a2, voffA);
            PG8_WAIT_V(8); PG8_WAIT_L(0); PG8_BAR; PG8_MMA(1, 0, At, B0); PG8_MMA(1, 1, At, B1); PG8_BAR; PG8_SCHED;
            PG8_LDB(B0, 1, 0); PG8_LDB(B1, 1, 1); PG8_SCHED; PG8_LDA(At, 1, 0); PG8_STAGE(PG8_SA(0, 1), a2 + hstep, voffA);
            PG8_WAIT_V(8); PG8_WAIT_L(0); PG8_BAR; PG8_MMA(0, 0, At, B0); PG8_MMA(0, 1, At, B1); PG8_BAR; PG8_SCHED;
            PG8_LDA(At, 1, 1); PG8_STAGE(PG8_SB(1, 0), b3, voffB); PG8_STAGE(PG8_SB(1, 1), b3 + hstep, voffB); PG8_STAGE(PG8_SA(1, 0), a3, voffA);
            PG8_WAIT_V(8); PG8_WAIT_L(0); PG8_BAR; PG8_MMA(1, 0, At, B0); PG8_MMA(1, 1, At, B1); PG8_BAR; PG8_SCHED;
            } else {
            PG8_LDB(B0, 0, 0); PG8_SCHED; PG8_LDA(At, 0, 0); PG8_STAGE(PG8_SA(1, 1), a1 + hstep, voffA);
            PG8_WAIT_L(8); PG8_BAR; PG8_WAIT_L(0); PG8_MMA(0, 0, At, B0); PG8_BAR; PG8_SCHED;
            PG8_LDB(B1, 0, 1); PG8_STAGE(PG8_SB(0, 0), b2, voffB);
            PG8_BAR; PG8_WAIT_L(0); PG8_MMA(0, 1, At, B1); PG8_BAR;
            PG8_LDA(At, 0, 1); PG8_STAGE(PG8_SA(0, 0), a2, voffA);
            PG8_BAR; PG8_WAIT_L(0); PG8_MMA(1, 0, At, B0); PG8_BAR; PG8_SCHED;
            PG8_STAGE(PG8_SB(0, 1), b2 + hstep, voffB);
            PG8_WAIT_V(6); PG8_BAR; PG8_MMA(1, 1, At, B1); PG8_BAR;
            PG8_LDB(B0, 1, 0); PG8_SCHED; PG8_LDA(At, 1, 0); PG8_STAGE(PG8_SA(0, 1), a2 + hstep, voffA);
            PG8_WAIT_L(8); PG8_BAR; PG8_WAIT_L(0); PG8_MMA(0, 0, At, B0); PG8_BAR; PG8_SCHED;
            PG8_LDB(B1, 1, 1); PG8_STAGE(PG8_SB(1, 0), b3, voffB);
            PG8_BAR; PG8_WAIT_L(0); PG8_MMA(0, 1, At, B1); PG8_BAR;
            PG8_LDA(At, 1, 1); PG8_STAGE(PG8_SA(1, 0), a3, voffA);
            PG8_BAR; PG8_WAIT_L(0); PG8_MMA(1, 0, At, B0); PG8_BAR; PG8_SCHED;
            PG8_STAGE(PG8_SB(1, 1), b3 + hstep, voffB);
            PG8_WAIT_V(6); PG8_BAR; PG8_MMA(1, 1, At, B1); PG8_BAR;
            }
        }
        if constexpr (ALIGN_EPI) { if (wr == 0) PG8_BAR; }
        if constexpr (!Epi::AFTER_DRAIN) { E(acc, cur, wr, wc, fr, fq); S.done(cur); }
        if (!has_next) break;
#pragma unroll
        for (int a = 0; a < 2; ++a)
#pragma unroll
            for (int b = 0; b < 2; ++b)
#pragma unroll
                for (int m = 0; m < 4; ++m)
#pragma unroll
                    for (int n = 0; n < 2; ++n) acc[a][b][m][n] = (f32x4){0.f, 0.f, 0.f, 0.f};
        cur = nxt; cA = nA; cB = nB; ++ui;
        if constexpr (ALIGN_EPI) { if (wr == 1) PG8_BAR; }
    }
    PG8_WAIT_V(0);
    if constexpr (!ALIGN_EPI) { if (wr == 0) PG8_BAR; }
    PG8_BAR;
    if constexpr (Epi::AFTER_DRAIN) { E.fused(acc, cur, wr, wc, fr, fq, lds, wid, lane); S.done(cur); }
#undef PG8_SA
#undef PG8_SB
#undef PG8_STAGE
#undef PG8_LDA
#undef PG8_LDB
#undef PG8_MMA
#undef PG8_WAIT_V
#undef PG8_WAIT_L
#undef PG8_BAR
#undef PG8_SCHED
}
}
namespace attn_body {
using bf16=__hip_bfloat16;
using bf16x8=__attribute__((ext_vector_type(8)))short;
using s16x4=__attribute__((ext_vector_type(4)))short;
using f32x16=__attribute__((ext_vector_type(16)))float;
using f32x4a=__attribute__((ext_vector_type(4)))float;
using u32x4=__attribute__((ext_vector_type(4)))unsigned;
constexpr int D=64;
constexpr int NW=8,QBLK=32,QB=QBLK*NW,KVBLK=64;
constexpr int QP=3584, OP=1024, GP=3584;
__device__ __forceinline__ int crow(int r,int hi){return (r&3)+8*(r>>2)+4*hi;}
#define SBAR() __builtin_amdgcn_sched_barrier(0)
__device__ __forceinline__ void cmask(f32x16&p0,f32x16&p1,int koff,int qrel,int hi){
  const float NEG=-INFINITY; int kb=koff+4*hi;
  #pragma unroll
  for(int r=0;r<16;++r){int kv=kb+(r&3)+8*(r>>2); if(kv>qrel)p0[r]=NEG; if(kv+32>qrel)p1[r]=NEG;}
}
constexpr int NSLOT=3, SLOTB=8192;
constexpr int LDS_K=0, LDS_V=NSLOT*SLOTB, LDS_WS=2*NSLOT*SLOTB, LDS_OST=LDS_WS+NW*64*4, LDS_BIAS=LDS_OST+NW*4096, LDS_BYTES=LDS_BIAS+NW*NSLOT*256;
constexpr float C2=0.125f*1.4426950408889634f;
__device__ __forceinline__ void glds16(const void*gsrc,unsigned lds_dst){unsigned keep;
  asm volatile("s_mov_b32 %0, m0\n\ts_mov_b32 m0, %2\n\ts_nop 0\n\tglobal_load_lds_dwordx4 %1, off\n\ts_mov_b32 m0, %0":"=&s"(keep):"v"(gsrc),"s"(lds_dst):"memory");}
__device__ __forceinline__ void glds4(const void*gsrc,unsigned lds_dst){unsigned keep;
  asm volatile("s_mov_b32 %0, m0\n\ts_mov_b32 m0, %2\n\ts_nop 0\n\tglobal_load_lds_dword %1, off\n\ts_mov_b32 m0, %0":"=&s"(keep):"v"(gsrc),"s"(lds_dst):"memory");}
typedef float f32x2_t __attribute__((ext_vector_type(2))); typedef __bf16 bf16x2_t __attribute__((ext_vector_type(2)));
__device__ __forceinline__ unsigned cvtpk_s(float lo,float hi){f32x2_t v={lo,hi};bf16x2_t b=__builtin_convertvector(v,bf16x2_t);return __builtin_bit_cast(unsigned,b);}
#define WAIT_BAR(N) asm volatile("s_waitcnt vmcnt(" #N ") lgkmcnt(0)\n\ts_barrier":::"memory")
typedef __attribute__((address_space(3))) const char* lds_cptr;
typedef short v4i16_t __attribute__((ext_vector_type(4)));
#define LDSV(T,p) (*(const __attribute__((address_space(3))) T*)(p))
__device__ __forceinline__ void kload8(bf16x8*kf,lds_cptr kp){
  kf[0]=LDSV(bf16x8,kp);      kf[1]=LDSV(bf16x8,kp+512);
  kf[2]=LDSV(bf16x8,kp+2048); kf[3]=LDSV(bf16x8,kp+2560);
  kf[4]=LDSV(bf16x8,kp+4096); kf[5]=LDSV(bf16x8,kp+4608);
  kf[6]=LDSV(bf16x8,kp+6144); kf[7]=LDSV(bf16x8,kp+6656);
}
__device__ __forceinline__ void kload2(bf16x8*kf,lds_cptr kp,int j){ kf[2*j]=LDSV(bf16x8,kp+j*2048); kf[2*j+1]=LDSV(bf16x8,kp+j*2048+512); }
__device__ __forceinline__ s16x4 vtr(lds_cptr p){ return __builtin_bit_cast(s16x4,__builtin_amdgcn_ds_read_tr16_b64_v4i16((__attribute__((address_space(3))) v4i16_t*)p)); }
#define MX3(a,b,c) __builtin_fmaxf(__builtin_fmaxf((a),(b)),(c))
__device__ __forceinline__ float rowmax(const f32x16&p0,const f32x16&p1){
  float a=MX3(p0[0],p0[1],p1[0]),b=MX3(p0[2],p0[3],p1[1]);a=MX3(a,p1[2],p1[3]);
  #pragma unroll
  for(int r=4;r<16;r+=4){a=MX3(a,p0[r],p0[r+1]);b=MX3(b,p0[r+2],p0[r+3]);a=MX3(a,p1[r],p1[r+1]);b=MX3(b,p1[r+2],p1[r+3]);}
  float m=__builtin_fmaxf(a,b);
  auto rr=__builtin_amdgcn_permlane32_swap(__float_as_uint(m),__float_as_uint(m),false,false);
  return __builtin_fmaxf(__uint_as_float(rr[0]),__uint_as_float(rr[1]));
}
__device__ __forceinline__ void pv(f32x16*o,int vb,bf16x8 pa0,bf16x8 pa1,bf16x8 pa2,bf16x8 pa3){
  #pragma unroll
  for(int d0=0;d0<2;++d0){s16x4 lo[4],hi[4];
    #pragma unroll
    for(int ks=0;ks<4;++ks){
      asm volatile("ds_read_b64_tr_b16 %0,%1 offset:%c2":"=&v"(lo[ks]):"v"(vb),"i"(d0*4096+ks*1024):"memory");
      asm volatile("ds_read_b64_tr_b16 %0,%1 offset:%c2":"=&v"(hi[ks]):"v"(vb),"i"(d0*4096+ks*1024+512):"memory");}
    asm volatile("s_waitcnt lgkmcnt(0)":::"memory");SBAR();
    #define PK(k) (bf16x8){lo[k][0],lo[k][1],lo[k][2],lo[k][3],hi[k][0],hi[k][1],hi[k][2],hi[k][3]}
    o[d0]=__builtin_amdgcn_mfma_f32_32x32x16_bf16(pa0,PK(0),o[d0],0,0,0);
    o[d0]=__builtin_amdgcn_mfma_f32_32x32x16_bf16(pa1,PK(1),o[d0],0,0,0);
    o[d0]=__builtin_amdgcn_mfma_f32_32x32x16_bf16(pa2,PK(2),o[d0],0,0,0);
    o[d0]=__builtin_amdgcn_mfma_f32_32x32x16_bf16(pa3,PK(3),o[d0],0,0,0);
    #undef PK
  }
}
struct AUnit {
  const bf16* Q;
  const bf16* K;
  const bf16* V;
  const float* nbk;
  bf16* O;
  const bf16* G;
  int kp;
  int NT, qoff, nvalid;
};
#define FLOORZ (-8.0f)
template<int THRL> __device__ __forceinline__ void attn_unit(const AUnit&U,char*shm,int wave0){
  int l__; asm volatile("v_mbcnt_lo_u32_b32 %0, -1, 0\n\tv_mbcnt_hi_u32_b32 %0, -1, %0":"=v"(l__)); int tid_=wave0*64+l__; const int tid=tid_,lane=tid&63,r32=lane&31,hi=lane>>5; const int wid=__builtin_amdgcn_readfirstlane(tid>>6);
  const int KP=U.kp;
  const bf16*Qw=U.Q+(long)(wid*QBLK)*QP;
  const bf16*Kh=U.K,*Vh=U.V;
  const unsigned lds0=(unsigned)(uintptr_t)shm;
  float*wsf=(float*)(shm+LDS_WS)+wid*64;
  const bf16*ksrc=Kh+(long)lane*KP+wid*8;
  const bf16*vsrc=Vh+(long)(16*(wid&3)+(lane>>2))*KP+(wid>>2)*32+(lane&3)*8;
  const float*bsrc=U.nbk+lane;
  const unsigned kdst=lds0+LDS_K+wid*1024, vdst=lds0+LDS_V+wid*1024, bdst=lds0+LDS_BIAS+wid*(NSLOT*256);
  #define DMA_K(t,slot) do{ glds16(ksrc+(long)(t)*KVBLK*KP,(unsigned)__builtin_amdgcn_readfirstlane(kdst+(slot))); glds4(bsrc+(t)*KVBLK,(unsigned)__builtin_amdgcn_readfirstlane(bdst+((slot)>>5))); }while(0)
  #define DMA_V(t,slot) glds16(vsrc+(long)(t)*KVBLK*KP,(unsigned)__builtin_amdgcn_readfirstlane(vdst+(slot)))
  const int vb0=(int)(lds0+LDS_V)+((lane>>4)&1)*32+(lane&3)*8+(4*hi+((lane&15)>>2))*64;
  const char*Kbase=shm+LDS_K; bf16x8 kf[8];
  const lds_cptr shm3=(lds_cptr)shm; const lds_cptr kp0=shm3+LDS_K+hi*1024+r32*16; const lds_cptr vp0=shm3+LDS_V+((lane>>4)&1)*32+(lane&3)*8+(4*hi+((lane&15)>>2))*64;
  const lds_cptr bp0=shm3+LDS_BIAS+wid*(NSLOT*256)+hi*16;
  const int NT=U.NT;
  DMA_K(0,0);DMA_V(0,0);DMA_K(1,SLOTB);
  bf16x8 qr[4];
  #pragma unroll
  for(int d0=0;d0<4;++d0)qr[d0]=*reinterpret_cast<const bf16x8*>(&Qw[(long)r32*QP+d0*16+hi*8]);
  const int qrel=wid*QBLK+r32;
  const float bq=-U.nbk[U.qoff+qrel];
  float nm=0.f,l_reg=0.f;f32x16 o[2];o[0]=f32x16{};o[1]=f32x16{};
  const int qoff=U.qoff;
  #define CMASK(P0,P1,t) do{ if((t)>=NT-4)cmask(P0,P1,64*(t)-qoff,qrel,hi);}while(0)
  #define BLD1(P0,P1,bp,g) do{ const f32x4a a_=LDSV(f32x4a,(bp)+(g)*32); const f32x4a b_=LDSV(f32x4a,(bp)+128+(g)*32); \
      P0[4*(g)]=a_[0];P0[4*(g)+1]=a_[1];P0[4*(g)+2]=a_[2];P0[4*(g)+3]=a_[3]; P1[4*(g)]=b_[0];P1[4*(g)+1]=b_[1];P1[4*(g)+2]=b_[2];P1[4*(g)+3]=b_[3]; }while(0)
  bool resc=false;
  #define RESC() do{ if(resc){ asm volatile("s_waitcnt lgkmcnt(0)":::"memory"); \
      _Pragma("unroll") for(int d_=0;d_<2;++d_) _Pragma("unroll") for(int r=0;r<16;++r)o[d_][r]*=wsf[crow(r,hi)]; } }while(0)
  f32x16 pA0,pA1,pB0,pB1;
  int sl_prev=0,sl_cur=0,sl_next=SLOTB;
  #define ROT() do{sl_prev=sl_cur;sl_cur=sl_next;sl_next=(sl_next==(NSLOT-1)*SLOTB)?0:sl_next+SLOTB;}while(0)
  DMA_K(2,2*SLOTB);
  WAIT_BAR(2);
  { BLD1(pA0,pA1,bp0,0);BLD1(pA0,pA1,bp0,1);BLD1(pA0,pA1,bp0,2);BLD1(pA0,pA1,bp0,3);
    const char*kb=Kbase+hi*1024+r32*16;
    #pragma unroll
    for(int d0=0;d0<4;++d0){
      const bf16x8 b0=*reinterpret_cast<const bf16x8*>(kb+d0*2048);
      const bf16x8 b1=*reinterpret_cast<const bf16x8*>(kb+d0*2048+512);
      pA0=__builtin_amdgcn_mfma_f32_32x32x16_bf16(b0,qr[d0],pA0,0,0,0);pA1=__builtin_amdgcn_mfma_f32_32x32x16_bf16(b1,qr[d0],pA1,0,0,0);}
  }
  CMASK(pA0,pA1,0);
  { const float rm=rowmax(pA0,pA1); const float z=rm+bq; const float mh=__builtin_fmaxf(z,FLOORZ); nm=bq-mh;
    _Pragma("unroll") for(int r=0;r<16;++r){pA0[r]=__builtin_amdgcn_exp2f(pA0[r]+nm);pA1[r]=__builtin_amdgcn_exp2f(pA1[r]+nm);} }
  WAIT_BAR(0);
  DMA_K(3,0);DMA_V(1,SLOTB);
  ROT();
  kload8(kf,kp0+sl_cur);
  { const lds_cptr bp_=bp0+(sl_cur>>5); BLD1(pB0,pB1,bp_,0);BLD1(pB0,pB1,bp_,1);BLD1(pB0,pB1,bp_,2);BLD1(pB0,pB1,bp_,3); }
  WAIT_BAR(3);
  s16x4 vlo[8],vhi[8]; u32x4 pw0,pw1,pw2,pw3;
  #define PKW(P,B) cvtpk_s(P[B],P[B+1])
  #define PAF(k) __builtin_bit_cast(bf16x8,pw##k)
  #define VFR(i) (bf16x8){vlo[i][0],vlo[i][1],vlo[i][2],vlo[i][3],vhi[i][0],vhi[i][1],vhi[i][2],vhi[i][3]}
  #define PIN(x) asm volatile("":"+v"(x))
  #define GAPA(MF,A0,A1,A2,A3,W0,W1,PW) do{ MF; sacc+=A0; sacc+=A1; sacc+=A2; sacc+=A3; PIN(sacc); W0; W1; PIN(PW); SBAR(); }while(0)
  #define EX(v) __builtin_amdgcn_exp2f((v)+nm)
  #define GAPB(MF,X,B) do{ MF; X[B]=EX(X[B]); X[B+1]=EX(X[B+1]); X[B+2]=EX(X[B+2]); X[B+3]=EX(X[B+3]); PIN(X); SBAR(); }while(0)
  #define VRD(i) do{ vlo[i]=vtr(vp_+(((i)>>2)*4096+((i)&3)*1024)); vhi[i]=vtr(vp_+(((i)>>2)*4096+((i)&3)*1024+512)); }while(0)
  #define KRD(G,j) do{ if(G){ kload2(kf,kp0+sl_next,j); SBAR(); } }while(0)
  #define BRD(G,P0,P1,g) do{ if(G){ BLD1(P0,P1,bpn_,g); SBAR(); } }while(0)
  #define STEP(C0,C1,P0,P1,t,GK,GV,GL) do{ SBAR(); \
    const lds_cptr vp_=vp0+sl_prev; const lds_cptr bpn_=bp0+(sl_next>>5); \
    VRD(0); SBAR(); float sacc=(P0[0]+P0[1]); \
    GAPA(C0=__builtin_amdgcn_mfma_f32_32x32x16_bf16(kf[0],qr[0],C0,0,0,0), P0[2],P0[3],P0[4],P0[5],     pw0[0]=PKW(P0,0), pw0[1]=PKW(P0,2), pw0); \
    VRD(4); SBAR(); GAPA(C1=__builtin_amdgcn_mfma_f32_32x32x16_bf16(kf[1],qr[0],C1,0,0,0), P0[6],P0[7],P0[8],P0[9],     pw0[2]=PKW(P0,4), pw0[3]=PKW(P0,6), pw0); \
    VRD(1); SBAR(); GAPA(C0=__builtin_amdgcn_mfma_f32_32x32x16_bf16(kf[2],qr[1],C0,0,0,0),   P0[10],P0[11],P0[12],P0[13], pw1[0]=PKW(P0,8), pw1[1]=PKW(P0,10), pw1); \
    VRD(5); SBAR(); GAPA(C1=__builtin_amdgcn_mfma_f32_32x32x16_bf16(kf[3],qr[1],C1,0,0,0),   P0[14],P0[15],P1[0],P1[1],   pw1[2]=PKW(P0,12),pw1[3]=PKW(P0,14), pw1); \
    VRD(2); SBAR(); GAPA(C0=__builtin_amdgcn_mfma_f32_32x32x16_bf16(kf[4],qr[2],C0,0,0,0),   P1[2],P1[3],P1[4],P1[5],     pw2[0]=PKW(P1,0), pw2[1]=PKW(P1,2), pw2); \
    VRD(6); SBAR(); GAPA(C1=__builtin_amdgcn_mfma_f32_32x32x16_bf16(kf[5],qr[2],C1,0,0,0),   P1[6],P1[7],P1[8],P1[9],     pw2[2]=PKW(P1,4), pw2[3]=PKW(P1,6), pw2); \
    VRD(3); SBAR(); GAPA(C0=__builtin_amdgcn_mfma_f32_32x32x16_bf16(kf[6],qr[3],C0,0,0,0),   P1[10],P1[11],P1[12],P1[13], pw3[0]=PKW(P1,8), pw3[1]=PKW(P1,10), pw3); \
    VRD(7); SBAR(); GAPA(C1=__builtin_amdgcn_mfma_f32_32x32x16_bf16(kf[7],qr[3],C1,0,0,0),   P1[14],P1[15],0.f,0.f,       pw3[2]=PKW(P1,12),pw3[3]=PKW(P1,14), pw3); \
    l_reg+=sacc; \
    if(GK){DMA_K((t)+3,sl_cur);} if(GV){DMA_V((t)+1,sl_next);} \
    CMASK(C0,C1,t); \
    { float a=MX3(C0[0],C0[1],C1[0]),b=MX3(C0[2],C0[3],C1[1]); a=MX3(a,C1[2],C1[3]); \
      _Pragma("unroll") for(int r=4;r<16;r+=4){a=MX3(a,C0[r],C0[r+1]);b=MX3(b,C0[r+2],C0[r+3]);a=MX3(a,C1[r],C1[r+1]);b=MX3(b,C1[r+2],C1[r+3]);} \
      float rm=__builtin_fmaxf(a,b); { auto rr=__builtin_amdgcn_permlane32_swap(__float_as_uint(rm),__float_as_uint(rm),false,false); rm=__builtin_fmaxf(__uint_as_float(rr[0]),__uint_as_float(rr[1])); } \
      rm+=nm; resc=false; \
      if(__builtin_expect(__any(rm>(float)THRL),0)){ const float dl=__builtin_fmaxf(rm,0.f); nm-=dl; \
        const float f=__builtin_amdgcn_exp2f(-dl); l_reg*=f; if(hi==0)wsf[r32]=f; resc=true; } } \
    SBAR(); \
    BRD(GL,P0,P1,0); GAPB(o[0]=__builtin_amdgcn_mfma_f32_32x32x16_bf16(PAF(0),VFR(0),o[0],0,0,0), C0,0); \
    BRD(GL,P0,P1,1); GAPB(o[1]=__builtin_amdgcn_mfma_f32_32x32x16_bf16(PAF(0),VFR(4),o[1],0,0,0), C0,4); \
    KRD(GL,0); GAPB(o[0]=__builtin_amdgcn_mfma_f32_32x32x16_bf16(PAF(1),VFR(1),o[0],0,0,0), C0,8); \
    KRD(GL,1); GAPB(o[1]=__builtin_amdgcn_mfma_f32_32x32x16_bf16(PAF(1),VFR(5),o[1],0,0,0), C0,12); \
    KRD(GL,2); GAPB(o[0]=__builtin_amdgcn_mfma_f32_32x32x16_bf16(PAF(2),VFR(2),o[0],0,0,0), C1,0); \
    KRD(GL,3); GAPB(o[1]=__builtin_amdgcn_mfma_f32_32x32x16_bf16(PAF(2),VFR(6),o[1],0,0,0), C1,4); \
    BRD(GL,P0,P1,2); GAPB(o[0]=__builtin_amdgcn_mfma_f32_32x32x16_bf16(PAF(3),VFR(3),o[0],0,0,0), C1,8); \
    BRD(GL,P0,P1,3); GAPB(o[1]=__builtin_amdgcn_mfma_f32_32x32x16_bf16(PAF(3),VFR(7),o[1],0,0,0), C1,12); \
    }while(0)
  int t=1;
  #undef CMASK
  #define CMASK(P0,P1,t) do{}while(0)
  for(;t+5<NT;t+=2){
    STEP(pB0,pB1,pA0,pA1,t,true,true,true);     WAIT_BAR(3); RESC(); ROT();
    STEP(pA0,pA1,pB0,pB1,t+1,true,true,true);   WAIT_BAR(3); RESC(); ROT();
  }
  #undef CMASK
  #define CMASK(P0,P1,t) do{ if((t)>=NT-4)cmask(P0,P1,64*(t)-qoff,qrel,hi);}while(0)
  #define ENDW(tt) do{ if((tt)+3<NT){WAIT_BAR(3);} else if((tt)+2<NT){WAIT_BAR(1);} else {WAIT_BAR(0);} }while(0)
  for(;t+1<NT;t+=2){
    STEP(pB0,pB1,pA0,pA1,t,(t+3<NT),(t+1<NT),(t+1<NT));       ENDW(t);   RESC(); ROT();
    STEP(pA0,pA1,pB0,pB1,t+1,(t+4<NT),(t+2<NT),(t+2<NT));     ENDW(t+1); RESC(); ROT();
  }
  STEP(pB0,pB1,pA0,pA1,NT-1,false,false,false); RESC();
  { float sacc=pB0[0]+pB0[1]; _Pragma("unroll") for(int r=2;r<16;++r)sacc+=pB0[r]; _Pragma("unroll") for(int r=0;r<16;++r)sacc+=pB1[r]; l_reg+=sacc;
    pw0=(u32x4){PKW(pB0,0),PKW(pB0,2),PKW(pB0,4),PKW(pB0,6)};pw1=(u32x4){PKW(pB0,8),PKW(pB0,10),PKW(pB0,12),PKW(pB0,14)};pw2=(u32x4){PKW(pB1,0),PKW(pB1,2),PKW(pB1,4),PKW(pB1,6)};pw3=(u32x4){PKW(pB1,8),PKW(pB1,10),PKW(pB1,12),PKW(pB1,14)};
    SBAR(); pv(o,vb0+sl_cur,PAF(0),PAF(1),PAF(2),PAF(3)); }
  #undef PKW
  #undef PAF
  #undef VFR
  #undef PIN
  #undef GAPA
  #undef GAPB
  #undef EX
  #undef VRD
  #undef KRD
  #undef BRD
  #undef STEP
  #undef ENDW
  {auto rr=__builtin_amdgcn_permlane32_swap(__float_as_uint(l_reg),__float_as_uint(l_reg),false,false);l_reg=__uint_as_float(rr[0])+__uint_as_float(rr[1]);}
  if(hi==0)wsf[32+r32]=l_reg;asm volatile("s_waitcnt lgkmcnt(0)":::"memory");
  float rli[16];
  #pragma unroll
  for(int r=0;r<16;++r)rli[r]=__builtin_amdgcn_rcpf(wsf[32+crow(r,hi)]);
  bf16*Ow=U.O+(long)(wid*QBLK)*OP; const bf16*Gw=U.G+(long)(wid*QBLK)*GP;
  { bf16*stg=(bf16*)(shm+LDS_OST)+wid*2048;
    #pragma unroll
    for(int r=0;r<16;++r){const int orow=crow(r,hi);
      #pragma unroll
      for(int d0=0;d0<2;++d0)stg[orow*64+d0*32+r32]=__float2bfloat16(o[d0][r]*rli[r]);}
    asm volatile("s_waitcnt lgkmcnt(0)":::"memory");
    #pragma unroll
    for(int i=0;i<4;++i){const int row=i*8+(lane>>3),ch=lane&7; const u32x4 v=*(const u32x4*)(stg+row*64+ch*8);
      if(wid*QBLK+row<U.nvalid){
        const u32x4 gv=*(const u32x4*)(Gw+(long)row*GP+ch*8); u32x4 ov;
        #pragma unroll
        for(int e=0;e<4;++e){
          const float o0=__uint_as_float(v[e]<<16), o1=__uint_as_float(v[e]&0xffff0000u);
          const float g0=__uint_as_float(gv[e]<<16), g1=__uint_as_float(gv[e]&0xffff0000u);
          const float s0=g0*__builtin_amdgcn_rcpf(1.f+__expf(-g0)), s1=g1*__builtin_amdgcn_rcpf(1.f+__expf(-g1));
          ov[e]=cvtpk_s(o0*s0,o1*s1); }
        *(u32x4*)(Ow+(long)row*OP+ch*8)=ov; } } }
  asm volatile("s_waitcnt lgkmcnt(0)\n\ts_barrier":::"memory");
  #undef DMA_K
  #undef DMA_V
  #undef CMASK
  #undef RESC
  #undef ROT
  #undef BLD1
}
constexpr int ATTN_LDS_BYTES=LDS_BYTES;
#undef SBAR
#undef WAIT_BAR
#undef MX3
#undef LDSV
#undef FLOORZ
}

namespace cg = cooperative_groups;
#define GAS __attribute__((address_space(1)))
#define LAS __attribute__((address_space(3)))
typedef unsigned short bf16;
typedef unsigned v4u __attribute__((ext_vector_type(4)));
typedef unsigned v2u __attribute__((ext_vector_type(2)));
typedef float f32x4 __attribute__((ext_vector_type(4)));
typedef short bf16x8 __attribute__((ext_vector_type(8)));
constexpr int NWAVES = 8;

constexpr int DM = 1024, NB = 16, SEQ = 4096, NL = 2, SB = 8, ST = 16, PAST = 2048, NH = 8, HD = 64;
constexpr int MP = NB * SEQ;
constexpr int MS = SB * ST;
constexpr int MV = MP + MS;
constexpr int MPAD = 257 * 256;
constexpr int INC = 3592;
constexpr int PP = 3584;
constexpr int C_PU = 0, C_PG = 256, C_Q = 512, C_K = 1024, C_V = 1536, C_AG = 2048, C_CB = 2560, C_CC = 2816, C_CX = 3072, C_CG = 3328;
constexpr int KSROWS = 2176;
constexpr int NBKS = 2432;
constexpr float EPS = 1e-6f;
constexpr float LOG2E = 1.4426950408889634f;

constexpr size_t O_YP = 0;
constexpr size_t O_YS = O_YP + (size_t)MP * DM;
constexpr size_t O_KP = O_YS + (size_t)MS * DM;
constexpr size_t O_VP = O_KP + (size_t)NL * MP * 512;
constexpr size_t O_FP = O_VP + (size_t)NL * MP * 512;
constexpr size_t O_PP = O_FP + (size_t)NL * MP * 8;
constexpr size_t O_CP = O_PP + (size_t)NL * NB * 15 * 256;
constexpr size_t O_KS = O_CP + (size_t)NL * NB * 2 * 256;
constexpr size_t O_VS = O_KS + (size_t)NL * MS * 512;
constexpr size_t O_FS = O_VS + (size_t)NL * MS * 512;
constexpr size_t O_PS = O_FS + (size_t)NL * MS * 8;
constexpr size_t O_CS = O_PS + (size_t)NL * SB * 15 * 256;
constexpr size_t O_END = O_CS + (size_t)NL * SB * 2 * 256;

constexpr size_t MiB = 1u << 20;
constexpr size_t WS_WIN = 0;
constexpr size_t WS_WOUT = 16 * MiB;
constexpr size_t WS_PWT = 20 * MiB;
constexpr size_t WS_NBKP = 21 * MiB;
constexpr size_t WS_NBKS = 23 * MiB;
constexpr size_t WS_KS = 24 * MiB;
constexpr size_t WS_VS = 60 * MiB;
constexpr size_t WS_XN = 96 * MiB;
constexpr size_t WS_PROJ = 226 * MiB;
constexpr size_t WS_END = WS_PROJ + (size_t)(MPAD + 512) * PP * 2;
static_assert(WS_KS + (size_t)NL * SB * KSROWS * 512 * 2 <= WS_VS && WS_VS + (size_t)NL * SB * KSROWS * 512 * 2 <= WS_XN && WS_XN + (size_t)(MPAD + 256) * DM * 2 <= WS_PROJ, "ws map");

constexpr int RING_BYTES = 131072;
constexpr int LDS_BYTES = 147456;

__device__ __forceinline__ unsigned f2bf(float f) { unsigned u = __builtin_bit_cast(unsigned, f); return (u + 0x7fffu + ((u >> 16) & 1u)) >> 16; }
__device__ __forceinline__ unsigned pk2(float lo, float hi) { return attn_body::cvtpk_s(lo, hi); }
__device__ __forceinline__ float bflo(unsigned w) { return __uint_as_float(w << 16); }
__device__ __forceinline__ float bfhi(unsigned w) { return __uint_as_float(w & 0xffff0000u); }
__device__ __forceinline__ float silu_f(float x) { return x * __builtin_amdgcn_rcpf(1.f + __expf(-x)); }
__device__ __forceinline__ float shx(float v, int m, int lane) { return __int_as_float(__builtin_amdgcn_ds_bpermute((lane ^ m) << 2, __float_as_int(v))); }
__device__ __forceinline__ float wave_sum(float v, int lane) {
#pragma unroll
    for (int o = 1; o < 64; o <<= 1) v += shx(v, o, lane);
    return v;
}

struct Args {
    const float* in[16]; float* out; unsigned char* ws; int ph_lo, ph_hi;
};

struct Frame {
    LAS unsigned char* lds;
    int tid, lane, wave, vcu, G, wave0;
};
#define FRAME_REFRESH(F) do { int l_; asm volatile("v_mbcnt_lo_u32_b32 %0, -1, 0\n\tv_mbcnt_hi_u32_b32 %0, -1, %0" : "=v"(l_)); int t_ = (F).wave0 * 64 + l_; (F).tid = t_; (F).lane = t_ & 63; (F).wave = __builtin_amdgcn_readfirstlane(t_ >> 6); } while (0)

__host__ __device__ __forceinline__ int win_logical_col(int p) {
    if (p < 512) return p;
    if (p < 1536) { const int reg = (p - 512) >> 8, q = (p - 512) & 255; return 512 + reg * 256 + 64 * ((q >> 5) & 3) + 32 * (q >> 7) + (q & 31); }
    if (p < 2560) return p;
    return p + 8;
}

__device__ __forceinline__ void transpose_item(const float* W, int K, int Nsrc, int srccol0, bf16* WT, int n0, int k0, LAS float* scr, int lane) {
#pragma unroll 8
    for (int i = 0; i < 32; ++i) { const int kk = 2 * i + (lane >> 5); scr[kk * 33 + (lane & 31)] = W[(size_t)(k0 + kk) * Nsrc + srccol0 + (lane & 31)]; }
    asm volatile("s_waitcnt lgkmcnt(0)" ::: "memory");
    const int c = lane & 7;
#pragma unroll
    for (int j = 0; j < 4; ++j) { const int n = (lane >> 3) + 8 * j; const LAS float* s = scr + (8 * c) * 33 + n;
        v4u o; o.x = pk2(s[0 * 33], s[1 * 33]); o.y = pk2(s[2 * 33], s[3 * 33]); o.z = pk2(s[4 * 33], s[5 * 33]); o.w = pk2(s[6 * 33], s[7 * 33]);
        *(v4u*)(WT + (size_t)(n0 + n) * K + k0 + 8 * c) = o; }
    asm volatile("s_waitcnt lgkmcnt(0)" ::: "memory");
}

__device__ __forceinline__ void p0_prologue(Frame& F, const Args& a) {
    LAS float* scr = (LAS float*)(F.lds + F.wave * 16384);
    const int gw = F.vcu * NWAVES + F.wave, NGW = F.G * NWAVES;
    unsigned char* ws = a.ws;
    constexpr int I_IN = (DM / 64) * (PP / 32), I_OUT = (DM / 64) * (DM / 32);
    for (int it = gw; it < NL * (I_IN + I_OUT); it += NGW) {
        const int l = it / (I_IN + I_OUT); int r = it % (I_IN + I_OUT);
        if (r < I_IN) { const int kb = r / (PP / 32), nb = r % (PP / 32);
            transpose_item(a.in[8] + (size_t)l * DM * INC, DM, INC, win_logical_col(32 * nb), (bf16*)(ws + WS_WIN) + (size_t)l * PP * DM, 32 * nb, 64 * kb, scr, F.lane); }
        else { r -= I_IN; const int kb = r / (DM / 32), nb = r % (DM / 32);
            transpose_item(a.in[15] + (size_t)l * DM * DM, DM, DM, 32 * nb, (bf16*)(ws + WS_WOUT) + (size_t)l * DM * DM, 32 * nb, 64 * kb, scr, F.lane); }
    }
    { const int gt = F.vcu * 512 + F.tid, NT_ = F.G * 512; bf16* pwt = (bf16*)(ws + WS_PWT);
      for (int i = gt; i < NL * 4 * 64 * 64; i += NT_) { const int c = i & 63, d = (i >> 6) & 63, lg = i >> 12; pwt[i] = (bf16)f2bf(a.in[12][(size_t)lg * 4096 + c * 64 + d]); } }
    { const size_t gt = (size_t)F.vcu * 512 + F.tid, NT_ = (size_t)F.G * 512;
      const size_t nchunk = (size_t)NL * SB * PAST * 64;
      for (size_t i = gt; i < 2 * nchunk; i += NT_) {
          const int which = i >= nchunk; const size_t j = which ? i - nchunk : i;
          const size_t rowg = j >> 6; const int c8 = (int)(j & 63) * 8; const size_t lb = rowg / PAST; const int r = (int)(rowg % PAST);
          const float* src = a.in[2 + which] + rowg * 512 + c8;
          const f32x4 x0 = *(const f32x4*)src, x1 = *(const f32x4*)(src + 4);
          v4u o; o.x = pk2(x0[0], x0[1]); o.y = pk2(x0[2], x0[3]); o.z = pk2(x1[0], x1[1]); o.w = pk2(x1[2], x1[3]);
          bf16* dst = (bf16*)(ws + (which ? WS_VS : WS_KS)) + (lb * KSROWS + r) * 512 + c8;
          *(v4u*)dst = o; }
      const size_t nz = (size_t)NL * SB * (KSROWS - PAST - ST) * 64;
      for (size_t i = gt; i < 2 * nz; i += NT_) {
          const int which = i >= nz; const size_t j = which ? i - nz : i;
          const size_t rowg = j >> 6; const int c8 = (int)(j & 63) * 8; const size_t lb = rowg / (KSROWS - PAST - ST); const int r = (int)(rowg % (KSROWS - PAST - ST)) + PAST + ST;
          bf16* dst = (bf16*)(ws + (which ? WS_VS : WS_KS)) + (lb * KSROWS + r) * 512 + c8;
          *(v4u*)dst = (v4u){0u, 0u, 0u, 0u}; } }
    { const int gt = F.vcu * 512 + F.tid, NT_ = F.G * 512; v4u* p = (v4u*)((bf16*)(ws + WS_XN) + (size_t)MV * DM);
      for (int i = gt; i < (MPAD - MV) * DM / 8; i += NT_) p[i] = (v4u){0u, 0u, 0u, 0u}; }
}

__device__ __forceinline__ void pa_phase(Frame& F, const Args& a, int l, const float* xp, const float* xs) {
    LAS float* wg = (LAS float*)F.lds;
    __syncthreads();
    const float* ng = a.in[7] + (size_t)l * DM;
    { const float* wf = a.in[8] + (size_t)l * DM * INC + 2560;
      for (int k = F.tid; k < DM; k += 512) { const f32x4 w0 = *(const f32x4*)(wf + (size_t)k * INC), w1 = *(const f32x4*)(wf + (size_t)k * INC + 4); const float g = ng[k];
          wg[0 * 1024 + k] = w0[0] * g; wg[1 * 1024 + k] = w0[1] * g; wg[2 * 1024 + k] = w0[2] * g; wg[3 * 1024 + k] = w0[3] * g;
          wg[4 * 1024 + k] = w1[0] * g; wg[5 * 1024 + k] = w1[1] * g; wg[6 * 1024 + k] = w1[2] * g; wg[7 * 1024 + k] = w1[3] * g; } }
    __syncthreads();
    const int lane = F.lane;
    f32x4 gv[4];
#pragma unroll
    for (int j = 0; j < 4; ++j) gv[j] = *(const f32x4*)(ng + 4 * lane + 256 * j);
    const float* bfp = a.in[9] + l * 8;
    bf16* XN = (bf16*)(a.ws + WS_XN);
    float* outfp = a.out + O_FP + (size_t)l * MP * 8; float* outfs = a.out + O_FS + (size_t)l * MS * 8;
    const int gw = F.vcu * NWAVES + F.wave, NGW = F.G * NWAVES;
    for (int rg = gw; rg < MV / 4; rg += NGW) {
        const int row0 = rg * 4;
        const float* src = row0 < MP ? xp + (size_t)row0 * DM : xs + (size_t)(row0 - MP) * DM;
        f32x4 v[4][4]; float rstd[4];
#pragma unroll
        for (int r = 0; r < 4; ++r)
#pragma unroll
            for (int j = 0; j < 4; ++j) v[r][j] = *(const f32x4*)(src + (size_t)r * DM + 4 * lane + 256 * j);
#pragma unroll
        for (int r = 0; r < 4; ++r) { float s = 0.f;
#pragma unroll
            for (int j = 0; j < 4; ++j) s += (v[r][j][0] * v[r][j][0] + v[r][j][1] * v[r][j][1]) + (v[r][j][2] * v[r][j][2] + v[r][j][3] * v[r][j][3]);
            rstd[r] = 1.0f / sqrtf(wave_sum(s, lane) * (1.f / DM) + EPS); }
        float acc[32];
#pragma unroll
        for (int i = 0; i < 32; ++i) acc[i] = 0.f;
#pragma unroll
        for (int h = 0; h < 8; ++h) {
#pragma unroll
            for (int j = 0; j < 4; ++j) { const f32x4 w = *(const LAS f32x4*)(wg + h * 1024 + 4 * lane + 256 * j);
#pragma unroll
                for (int r = 0; r < 4; ++r) acc[r * 8 + h] += (v[r][j][0] * w[0] + v[r][j][1] * w[1]) + (v[r][j][2] * w[2] + v[r][j][3] * w[3]); }
            asm volatile("" ::: "memory"); }
#define RS_STAGE(M_, N_) { const bool up = (lane & (M_)) != 0; _Pragma("unroll") for (int i = 0; i < (N_); ++i) { const float send = up ? acc[i] : acc[i + (N_)], keep = up ? acc[i + (N_)] : acc[i]; acc[i] = keep + shx(send, (M_), lane); } }
        RS_STAGE(32, 16) RS_STAGE(16, 8) RS_STAGE(8, 4) RS_STAGE(4, 2) RS_STAGE(2, 1)
#undef RS_STAGE
        acc[0] += shx(acc[0], 1, lane);
        { const int idx = lane >> 1, r = idx >> 3, h = idx & 7;
          const float rs = r == 0 ? rstd[0] : r == 1 ? rstd[1] : r == 2 ? rstd[2] : rstd[3];
          const float xx = acc[0] * rs + bfp[h];
          const float lf = fminf(xx, 0.f) - __logf(1.f + __expf(-fabsf(xx)));
          if ((lane & 1) == 0) { const int row = row0 + r; if (row < MP) outfp[(size_t)row * 8 + h] = lf; else outfs[(size_t)(row - MP) * 8 + h] = lf; } }
#pragma unroll
        for (int r = 0; r < 4; ++r) { unsigned long long* o8 = (unsigned long long*)(XN + (size_t)(row0 + r) * DM) + lane;
#pragma unroll
            for (int j = 0; j < 4; ++j) { const f32x4 y = v[r][j] * rstd[r] * gv[j];
                o8[64 * j] = (unsigned long long)pk2(y[0], y[1]) | ((unsigned long long)pk2(y[2], y[3]) << 32); } }
    }
    __syncthreads();
}

__device__ __forceinline__ void scan_phase(Frame& F, const Args& a, int l) {
    LAS float* sc = (LAS float*)F.lds;
    const float* lfp = a.out + O_FP + (size_t)l * MP * 8; const float* lfs = a.out + O_FS + (size_t)l * MS * 8;
    const float* clf = a.in[4] + (size_t)l * SB * PAST * 8;
    float* nbkp = (float*)(a.ws + WS_NBKP); float* nbks = (float*)(a.ws + WS_NBKS);
    for (int s = blockIdx.x; s < 192; s += F.G) {
        const bool samp = s >= 128; const int bh = samp ? s - 128 : s, b = bh >> 3, h = bh & 7;
        const int n = samp ? PAST + ST : SEQ;
        float v[8]; float run = 0.f;
#pragma unroll
        for (int j = 0; j < 8; ++j) { const int t = 8 * F.tid + j; float x = 0.f;
            if (t < n) x = samp ? (t < PAST ? clf[((size_t)b * PAST + t) * 8 + h] : lfs[((size_t)b * ST + (t - PAST)) * 8 + h]) : lfp[((size_t)b * SEQ + t) * 8 + h];
            run += x; v[j] = run; }
        float inc = run;
#pragma unroll
        for (int o = 1; o < 64; o <<= 1) { const int src = F.lane >= o ? F.lane - o : F.lane; const float y = __int_as_float(__builtin_amdgcn_ds_bpermute(src << 2, __float_as_int(inc))); if (F.lane >= o) inc += y; }
        if (F.lane == 63) sc[F.wave] = inc;
        __syncthreads();
        float base = inc - run;
        for (int w = 0; w < F.wave; ++w) base += sc[w];
        float* dst = samp ? nbks + (size_t)bh * NBKS : nbkp + (size_t)bh * SEQ;
        const int t0 = 8 * F.tid;
        if (t0 < n) {
            *(f32x4*)(dst + t0) = (f32x4){-(base + v[0]) * LOG2E, -(base + v[1]) * LOG2E, -(base + v[2]) * LOG2E, -(base + v[3]) * LOG2E};
            *(f32x4*)(dst + t0 + 4) = (f32x4){-(base + v[4]) * LOG2E, -(base + v[5]) * LOG2E, -(base + v[6]) * LOG2E, -(base + v[7]) * LOG2E};
        } else if (samp && t0 < NBKS) {
            *(f32x4*)(dst + t0) = (f32x4){0.f, 0.f, 0.f, 0.f}; *(f32x4*)(dst + t0 + 4) = (f32x4){0.f, 0.f, 0.f, 0.f};
        }
        __syncthreads();
    }
}

template <int W> __device__ __forceinline__ void pool_task(const Args& a, int l, int rt, int g, int lane) {
    const int fr = lane & 15, fq = lane >> 4;
    const bool samp = rt >= MP / 16;
    const int row = rt * 16 + fr;
    const int t = samp ? fr : (row & (SEQ - 1));
    const int b = samp ? (rt - MP / 16) : (row >> 12);
    const bf16* proj = (const bf16*)(a.ws + WS_PROJ);
    const bf16* pu = proj + (size_t)row * PP + C_PU + g * 64;
    const float* sp = a.in[5] + ((size_t)(l * SB + (samp ? b : 0)) * 15) * 256 + g * 64;
    const float inv = 1.0f / (float)(samp ? W : (t + 1 < W ? t + 1 : W));
    bf16x8 af[2];
    float* outp = samp ? a.out + O_PS + ((size_t)(l * SB + b) * 15) * 256 + g * 64 : a.out + O_PP + ((size_t)(l * NB + b) * 15) * 256 + g * 64;
#pragma unroll
    for (int kk = 0; kk < 2; ++kk) {
        const int ch = 32 * kk + 8 * fq;
        float s[8], u[8];
#pragma unroll
        for (int e = 0; e < 8; ++e) s[e] = 0.f;
#pragma unroll
        for (int j = 0; j < W; ++j) {
            const int tt = t - j;
            if (tt >= 0) { const v4u x = *(const v4u*)(pu - (size_t)j * PP + ch);
#pragma unroll
                for (int e = 0; e < 4; ++e) { const float lo = bflo(x[e]), hi = bfhi(x[e]); s[2 * e] += lo; s[2 * e + 1] += hi; if (j == 0) { u[2 * e] = lo; u[2 * e + 1] = hi; } } }
            else if (samp) { const float* q = sp + (size_t)(15 + tt) * 256 + ch; const f32x4 x0 = *(const f32x4*)q, x1 = *(const f32x4*)(q + 4);
                s[0] += x0[0]; s[1] += x0[1]; s[2] += x0[2]; s[3] += x0[3]; s[4] += x1[0]; s[5] += x1[1]; s[6] += x1[2]; s[7] += x1[3]; }
        }
        v4u pk; pk.x = pk2(s[0] * inv - u[0], s[1] * inv - u[1]); pk.y = pk2(s[2] * inv - u[2], s[3] * inv - u[3]); pk.z = pk2(s[4] * inv - u[4], s[5] * inv - u[5]); pk.w = pk2(s[6] * inv - u[6], s[7] * inv - u[7]);
        af[kk] = __builtin_bit_cast(bf16x8, pk);
        const int orow = samp ? t - 1 : t - (SEQ - 15);
        if (orow >= 0) { float* q = outp + (size_t)orow * 256 + ch; *(f32x4*)q = (f32x4){u[0], u[1], u[2], u[3]}; *(f32x4*)(q + 4) = (f32x4){u[4], u[5], u[6], u[7]}; }
    }
    const bf16* pwt = (const bf16*)(a.ws + WS_PWT) + (size_t)(l * 4 + g) * 4096;
    f32x4 acc[4];
#pragma unroll
    for (int n = 0; n < 4; ++n) { acc[n] = (f32x4){0.f, 0.f, 0.f, 0.f};
#pragma unroll
        for (int kk = 0; kk < 2; ++kk) { const bf16x8 bfr = *(const bf16x8*)(pwt + (16 * n + fr) * 64 + 32 * kk + 8 * fq);
            acc[n] = __builtin_amdgcn_mfma_f32_16x16x32_bf16(bfr, af[kk], acc[n], 0, 0, 0); } }
    const float* psc = a.in[13] + l * 256 + g * 64;
    const bf16* pg = proj + (size_t)row * PP + C_PG + g * 64;
    bf16* mix = (bf16*)(a.ws + WS_XN) + (size_t)row * DM + g * 64;
#pragma unroll
    for (int n = 0; n < 4; ++n) { const int d = 16 * n + 4 * fq;
        const f32x4 sc = *(const f32x4*)(psc + d); const v2u gg = *(const v2u*)(pg + d);
        const float o0 = acc[n][0] * sc[0] * silu_f(bflo(gg.x)), o1 = acc[n][1] * sc[1] * silu_f(bfhi(gg.x)), o2 = acc[n][2] * sc[2] * silu_f(bflo(gg.y)), o3 = acc[n][3] * sc[3] * silu_f(bfhi(gg.y));
        v2u o; o.x = pk2(o0, o1); o.y = pk2(o2, o3); *(v2u*)(mix + d) = o; }
}

__device__ __forceinline__ void conv_item(const Args& a, int l, int rb, int tid) {
    const int chunk = tid & 31, run = tid >> 5, ch = chunk * 8;
    const bool samp = rb == MP / 256;
    if (samp && run >= 8) return;
    const int row0 = rb * 256 + run * 16;
    const int t0 = samp ? 0 : (row0 & (SEQ - 1));
    const int b = samp ? run : (row0 >> 12);
    const bf16* proj = (const bf16*)(a.ws + WS_PROJ);
    bf16* mix = (bf16*)(a.ws + WS_XN);
    float zm2[8], zm1[8], w0[8], w1[8], w2[8];
    { const float* cw = a.in[14] + (size_t)l * 3 * 256 + ch;
#pragma unroll
      for (int e = 0; e < 8; ++e) { w0[e] = cw[e]; w1[e] = cw[256 + e]; w2[e] = cw[512 + e]; } }
    if (t0 == 0) {
        if (samp) { const float* sc = a.in[6] + ((size_t)(l * SB + b) * 2) * 256 + ch;
#pragma unroll
            for (int e = 0; e < 8; ++e) { zm2[e] = sc[e]; zm1[e] = sc[256 + e]; } }
        else {
#pragma unroll
            for (int e = 0; e < 8; ++e) { zm2[e] = 0.f; zm1[e] = 0.f; } }
    } else {
        const bf16* p2 = proj + (size_t)(row0 - 2) * PP; const bf16* p1 = proj + (size_t)(row0 - 1) * PP;
        const v4u c2 = *(const v4u*)(p2 + C_CC + ch), x2 = *(const v4u*)(p2 + C_CX + ch), c1 = *(const v4u*)(p1 + C_CC + ch), x1 = *(const v4u*)(p1 + C_CX + ch);
#pragma unroll
        for (int e = 0; e < 4; ++e) { zm2[2 * e] = bflo(c2[e]) * bflo(x2[e]); zm2[2 * e + 1] = bfhi(c2[e]) * bfhi(x2[e]); zm1[2 * e] = bflo(c1[e]) * bflo(x1[e]); zm1[2 * e + 1] = bfhi(c1[e]) * bfhi(x1[e]); }
    }
    float* outc = samp ? a.out + O_CS + ((size_t)(l * SB + b) * 2) * 256 + ch : a.out + O_CP + ((size_t)(l * NB + b) * 2) * 256 + ch;
    const int tlast = samp ? ST - 2 : SEQ - 2;
#pragma unroll 4
    for (int i = 0; i < 16; ++i) {
        const bf16* p = proj + (size_t)(row0 + i) * PP;
        const v4u cb = *(const v4u*)(p + C_CB + ch), cc = *(const v4u*)(p + C_CC + ch), cx = *(const v4u*)(p + C_CX + ch), cgt = *(const v4u*)(p + C_CG + ch);
        float z[8], o[8];
#pragma unroll
        for (int e = 0; e < 4; ++e) { z[2 * e] = bflo(cc[e]) * bflo(cx[e]); z[2 * e + 1] = bfhi(cc[e]) * bfhi(cx[e]); }
#pragma unroll
        for (int e = 0; e < 8; ++e) { const float y = w0[e] * zm2[e] + w1[e] * zm1[e] + w2[e] * z[e]; o[e] = y; zm2[e] = zm1[e]; zm1[e] = z[e]; }
#pragma unroll
        for (int e = 0; e < 4; ++e) { o[2 * e] *= bflo(cb[e]) * silu_f(bflo(cgt[e])); o[2 * e + 1] *= bfhi(cb[e]) * silu_f(bfhi(cgt[e])); }
        v4u ov; ov.x = pk2(o[0], o[1]); ov.y = pk2(o[2], o[3]); ov.z = pk2(o[4], o[5]); ov.w = pk2(o[6], o[7]);
        *(v4u*)(mix + (size_t)(row0 + i) * DM + 768 + ch) = ov;
        const int t = t0 + i;
        if (t >= tlast) { float* q = outc + (size_t)(t - tlast) * 256; *(f32x4*)q = (f32x4){z[0], z[1], z[2], z[3]}; *(f32x4*)(q + 4) = (f32x4){z[4], z[5], z[6], z[7]}; }
    }
}

__device__ __forceinline__ void mixer_phase(Frame& F, const Args& a, int l) {
    for (int it = F.vcu; it < MP / 256 + 1; it += F.G) conv_item(a, l, it, F.tid);
    const int gw = F.vcu * NWAVES + F.wave, NGW = F.G * NWAVES;
    constexpr int NTASK = (MP / 16 + SB) * 4;
    for (int k = gw; k < NTASK; k += NGW) { const int rt = k >> 2, g = k & 3;
        if (g == 0) pool_task<2>(a, l, rt, 0, F.lane); else if (g == 1) pool_task<4>(a, l, rt, 1, F.lane); else if (g == 2) pool_task<8>(a, l, rt, 2, F.lane); else pool_task<16>(a, l, rt, 3, F.lane); }
}

__device__ __forceinline__ void attention_phase(Frame& F, const Args& a, int l, char* lds) {
    using abf = attn_body::bf16;
    const abf* proj = (const abf*)(a.ws + WS_PROJ);
    abf* mix = (abf*)(a.ws + WS_XN);
    const float* nbkp = (const float*)(a.ws + WS_NBKP); const float* nbks = (const float*)(a.ws + WS_NBKS);
    for (int s = F.vcu; s < 256; s += F.G) {
#pragma unroll 1
        for (int i = 0; i < 9; ++i) {
            if (i == 8 && (s & 3) != 0) break;
            attn_body::AUnit U;
            if (i < 8) {
                const int bh = s >> 1, half = s & 1, b = bh >> 3, h = bh & 7;
                const int pr = i >> 1; int qb = (i & 1) ? 15 - 2 * pr : 2 * pr; if (half) qb = (i & 1) ? 14 - 2 * pr : 2 * pr + 1;
                const size_t r0 = (size_t)b * SEQ + (size_t)qb * 256;
                U.Q = proj + r0 * PP + C_Q + h * 64; U.K = proj + (size_t)b * SEQ * PP + C_K + h * 64; U.V = proj + (size_t)b * SEQ * PP + C_V + h * 64;
                U.nbk = nbkp + (size_t)bh * SEQ; U.O = mix + r0 * DM + 256 + h * 64; U.G = proj + r0 * PP + C_AG + h * 64;
                U.kp = PP; U.NT = 4 * qb + 4; U.qoff = qb * 256; U.nvalid = 256;
            } else {
                const int bh = s >> 2, b = bh >> 3, h = bh & 7;
                const size_t r0 = (size_t)MP + (size_t)b * ST;
                const size_t kb = ((size_t)(l * SB + b) * KSROWS) * 512 + h * 64;
                U.Q = proj + r0 * PP + C_Q + h * 64; U.K = (const abf*)(a.ws + WS_KS) + kb; U.V = (const abf*)(a.ws + WS_VS) + kb;
                U.nbk = nbks + (size_t)bh * NBKS; U.O = mix + r0 * DM + 256 + h * 64; U.G = proj + r0 * PP + C_AG + h * 64;
                U.kp = 512; U.NT = KSROWS / 64; U.qoff = PAST; U.nvalid = ST;
            }
            attn_body::attn_unit<8>(U, lds, F.wave0);
        }
    }
}

__global__ void __launch_bounds__(NWAVES * 64, 2) mega_fwd(Args args) {
    extern __shared__ __attribute__((aligned(16))) unsigned char lds[];
    cg::grid_group grid = cg::this_grid();
    Frame F;
    F.lds = (LAS unsigned char*)lds;
    F.wave0 = __builtin_amdgcn_readfirstlane((int)threadIdx.x >> 6); FRAME_REFRESH(F);
    F.G = gridDim.x; { const int bx = blockIdx.x; F.vcu = (F.G % 8 == 0) ? (bx % 8) * (F.G / 8) + bx / 8 : bx; }
    const int lo = args.ph_lo, hi = args.ph_hi;
#define IN(k) (lo <= (k) && (k) < hi)
#define SEAM(k) do { if (IN(k) && IN((k) + 1)) grid.sync(); } while (0)
    unsigned char* ws = args.ws;
    float* out = args.out;

    if (IN(0)) { p0_prologue(F, args); pa_phase(F, args, 0, args.in[0], args.in[1]); }
    SEAM(0);
#pragma unroll 1
    for (int l = 0; l < NL; ++l) {
        const int pb = 1 + 4 * l;
        if (IN(pb)) {
            FRAME_REFRESH(F);
            scan_phase(F, args, l);
            pg8::Gemm g{(const bf16*)(ws + WS_XN), (const bf16*)(ws + WS_WIN) + (size_t)l * PP * DM, MPAD, PP, DM};
            pg8::StaticOrder S; S.init(MPAD, PP, F.G, (int)blockIdx.x);
            pg8::EpiIn E;
            E.proj = (bf16*)(ws + WS_PROJ); E.ks = (bf16*)(ws + WS_KS) + (size_t)l * SB * KSROWS * 512; E.vs = (bf16*)(ws + WS_VS) + (size_t)l * SB * KSROWS * 512;
            E.outk_p = out + O_KP + (size_t)l * MP * 512; E.outv_p = out + O_VP + (size_t)l * MP * 512;
            E.outk_s = out + O_KS + (size_t)l * MS * 512; E.outv_s = out + O_VS + (size_t)l * MS * 512;
            E.qg = args.in[10] + l * 64; E.kg = args.in[11] + l * 64;
            pg8::gemm_phase<pg8::EpiIn, pg8::StaticOrder, true, true>(F.lds, g, S, E, F.tid);
        }
        SEAM(pb);
        if (IN(pb + 1)) {
            FRAME_REFRESH(F);
            mixer_phase(F, args, l);
            __syncthreads();
            attention_phase(F, args, l, (char*)lds);
        }
        SEAM(pb + 1);
        if (IN(pb + 2)) {
            FRAME_REFRESH(F);
            pg8::Gemm g{(const bf16*)(ws + WS_XN), (const bf16*)(ws + WS_WOUT) + (size_t)l * DM * DM, MPAD, DM, DM};
            pg8::StaticOrder S; S.init(MPAD, DM, F.G, (int)blockIdx.x);
            pg8::EpiOut E;
            E.base_p = l == 0 ? args.in[0] : out + O_YP; E.base_s = l == 0 ? args.in[1] : out + O_YS; E.out_p = out + O_YP; E.out_s = out + O_YS;
            pg8::gemm_phase<pg8::EpiOut, pg8::StaticOrder, true, true>(F.lds, g, S, E, F.tid);
        }
        SEAM(pb + 2);
        if (l + 1 < NL) {
            if (IN(pb + 3)) { FRAME_REFRESH(F); pa_phase(F, args, l + 1, out + O_YP, out + O_YS); }
            SEAM(pb + 3);
        }
    }
#undef IN
#undef SEAM
}

#ifndef MK_MULTI
#define MK_MULTI 0
#endif
constexpr int N_PHASES = 8;

extern "C" void kernel_launch(void* const* d_in, const int* in_sizes, int n_in, void* d_out, int out_size, void* d_ws, size_t ws_size, hipStream_t stream) {
    static int grid = 0;
    if (grid == 0) {
        if (n_in != 16 || (size_t)out_size != O_END || ws_size < WS_END) { fprintf(stderr, "kernel_launch: shape mismatch: n_in %d out %d (want %zu) ws %zu (want %zu)\n", n_in, out_size, (size_t)O_END, ws_size, (size_t)WS_END); grid = -1; return; }
        int dev = 0, cus = 0, per_cu = 0;
        if (hipGetDevice(&dev) != hipSuccess || hipDeviceGetAttribute(&cus, hipDeviceAttributeMultiprocessorCount, dev) != hipSuccess) { grid = -1; return; }
        if (hipFuncSetAttribute((const void*)mega_fwd, hipFuncAttributeMaxDynamicSharedMemorySize, LDS_BYTES) != hipSuccess) { fprintf(stderr, "kernel_launch: hipFuncSetAttribute failed\n"); grid = -1; return; }
        if (hipOccupancyMaxActiveBlocksPerMultiprocessor(&per_cu, (const void*)mega_fwd, NWAVES * 64, LDS_BYTES) != hipSuccess || per_cu < 1) { fprintf(stderr, "kernel_launch: occupancy query says %d\n", per_cu); per_cu = 1; }
        (void)hipGetLastError();
        grid = cus * 1;
    }
    if (grid < 0) return;
    Args a{};
    for (int i = 0; i < 16; ++i) a.in[i] = (const float*)d_in[i];
    a.out = (float*)d_out; a.ws = (unsigned char*)d_ws;
#if MK_MULTI
    for (int p = 0; p < N_PHASES; ++p) { a.ph_lo = p; a.ph_hi = p + 1; hipLaunchKernelGGL(mega_fwd, dim3(grid), dim3(NWAVES * 64), LDS_BYTES, stream, a); }
#else
    a.ph_lo = 0; a.ph_hi = N_PHASES;
    void* kargs[] = {&a};
    hipError_t e = hipLaunchCooperativeKernel((const void*)mega_fwd, dim3(grid), dim3(NWAVES * 64), kargs, LDS_BYTES, stream);
    if (e != hipSuccess) fprintf(stderr, "cooperative launch failed: %s (grid %d)\n", hipGetErrorString(e), grid);
#endif
}
```

```cpp
#include <hip/hip_runtime.h>
#include <hip/hip_cooperative_groups.h>
#include <hip/hip_bf16.h>
#include <cstdio>
#include <cstdint>
#include <cmath>
namespace pg8 {
#define PG8_LAS __attribute__((address_space(3)))
typedef unsigned short bf16_t;
typedef short bf16x8 __attribute__((ext_vector_type(8)));
typedef float f32x4 __attribute__((ext_vector_type(4)));
typedef unsigned u32x4 __attribute__((ext_vector_type(4)));
constexpr int BM = 256, BK = 64, HALF = 128, HTB = HALF * BK * 2  , STAGE_BYTES = 8 * HTB, NXCD = 8, WGM = 8;

__host__ __device__ __forceinline__ int lds_byte(int r, int c) { const int st = (r >> 4) * 2 + (c >> 5), rr = r & 15, cc = c & 31, ob = rr * 64 + cc * 2; return st * 1024 + (ob ^ (((ob >> 9) & 1) << 5)); }
__host__ __device__ __forceinline__ void stage_rc(int b, int& R, int& C) { const int st = b / 1024, sb = b % 1024, swz = sb ^ (((sb >> 9) & 1) << 5); R = (st >> 1) * 16 + swz / 64; C = (st & 1) * 32 + (swz % 64) / 2; }
__host__ __device__ __forceinline__ int perm32(int rho) { const int n = rho >> 4, i = rho & 15; return 8 * (i >> 2) + 4 * n + (i & 3); }

struct Unit { int pm, pn; };
struct Gemm { const bf16_t* A; const bf16_t* Bt; int M, N, K; };

struct StaticOrder {
    int nM, nN, nwg, G, c;
    __host__ __device__ void init(int M, int N, int G_, int c_) { nM = M / BM; nN = N / BM; nwg = nM * nN; G = G_; c = c_; }
    __host__ __device__ bool next(int i, Unit& u) const {
        const long L = (long)i * G + c; if (L >= nwg) return false;
        int wgid = (int)L; { const int q = nwg / NXCD, r = nwg % NXCD, xcd = wgid % NXCD, off = wgid / NXCD; wgid = (xcd < r ? xcd * (q + 1) : r * (q + 1) + (xcd - r) * q) + off; }
        const int nig = WGM * nN, gid = wgid / nig, fm = gid * WGM, gsz = (nM - fm) < WGM ? (nM - fm) : WGM;
        u.pm = fm + ((wgid % nig) % gsz); u.pn = (wgid % nig) / gsz; return true;
    }
    __device__ __forceinline__ void a_ready(const Unit&) const {}
    __device__ __forceinline__ void done(const Unit&) const {}
};

__device__ __forceinline__ unsigned cvt_pk_bf16(float lo, float hi) { unsigned r; asm volatile("v_cvt_pk_bf16_f32 %0, %1, %2" : "=v"(r) : "v"(lo), "v"(hi)); return r; }
typedef float f32x2 __attribute__((ext_vector_type(2)));
constexpr int E_MP = 65536, E_PP = 3584, E_KSROWS = 2176, E_PAST = 2048;
constexpr float E_C2 = 0.125f * 1.4426950408889634f;
struct EpiIn {
    static constexpr bool PERM = true, AFTER_DRAIN = false;
    bf16_t* proj; bf16_t* ks; bf16_t* vs; float* outk_p; float* outv_p; float* outk_s; float* outv_s; const float* qg; const float* kg;
    __device__ __forceinline__ void operator()(const f32x4 (&acc)[2][2][4][2], const Unit& u, int wr, int wc, int fr, int fq) const {
        const int pn = u.pn; const bool samp = (u.pm == E_MP / 256);
        const int nai = samp ? 1 : 2;
        if (pn >= 2 && pn <= 5) {
            const bool isq = pn < 4; const int head = (pn & 1) * 4 + wc;
            const float* g = isq ? qg : kg;
            f32x4 gv[2][2];
#pragma unroll
            for (int bj = 0; bj < 2; ++bj)
#pragma unroll
                for (int n = 0; n < 2; ++n) gv[bj][n] = *(const f32x4*)(g + 32 * bj + 8 * fq + 4 * n);
#pragma unroll
            for (int ai = 0; ai < 2; ++ai) if (ai < nai)
#pragma unroll
                for (int m = 0; m < 4; ++m) {
                    const int row = u.pm * BM + ai * HALF + wr * 64 + m * 16 + fr;
                    float ss = 0.f;
#pragma unroll
                    for (int bj = 0; bj < 2; ++bj)
#pragma unroll
                        for (int n = 0; n < 2; ++n) { const f32x4 x = acc[ai][bj][m][n]; ss += (x[0] * x[0] + x[1] * x[1]) + (x[2] * x[2] + x[3] * x[3]); }
                    { const int ln = fr + 16 * fq; ss += __int_as_float(__builtin_amdgcn_ds_bpermute((ln ^ 16) << 2, __float_as_int(ss))); ss += __int_as_float(__builtin_amdgcn_ds_bpermute((ln ^ 32) << 2, __float_as_int(ss))); }
                    float rs = 1.0f / sqrtf(ss * (1.0f / 64.0f) + 1e-6f);
                    const float rq = rs * E_C2;
#pragma unroll
                    for (int bj = 0; bj < 2; ++bj) {
                        const f32x4 k0 = acc[ai][bj][m][0] * rs * gv[bj][0], k1 = acc[ai][bj][m][1] * rs * gv[bj][1];
                        const int col = head * 64 + 32 * bj + 8 * fq;
                        if (isq) { const f32x4 v0 = acc[ai][bj][m][0] * rq * gv[bj][0], v1 = acc[ai][bj][m][1] * rq * gv[bj][1];
                            u32x4 w; w.x = cvt_pk_bf16(v0[0], v0[1]); w.y = cvt_pk_bf16(v0[2], v0[3]); w.z = cvt_pk_bf16(v1[0], v1[1]); w.w = cvt_pk_bf16(v1[2], v1[3]);
                            *(u32x4*)(proj + (size_t)row * E_PP + 512 + col) = w; }
                        else { u32x4 w; w.x = cvt_pk_bf16(k0[0], k0[1]); w.y = cvt_pk_bf16(k0[2], k0[3]); w.z = cvt_pk_bf16(k1[0], k1[1]); w.w = cvt_pk_bf16(k1[2], k1[3]);
                            if (!samp) { *(u32x4*)(proj + (size_t)row * E_PP + 1024 + col) = w; float* o = outk_p + (size_t)row * 512 + col; *(f32x4*)o = k0; *(f32x4*)(o + 4) = k1; }
                            else { const int lr = row - E_MP, b = lr >> 4, t = lr & 15; *(u32x4*)(ks + ((size_t)b * E_KSROWS + E_PAST + t) * 512 + col) = w; float* o = outk_s + (size_t)lr * 512 + col; *(f32x4*)o = k0; *(f32x4*)(o + 4) = k1; } }
                    }
                }
        } else if (pn == 6 || pn == 7) {
#pragma unroll
            for (int ai = 0; ai < 2; ++ai) if (ai < nai)
#pragma unroll
                for (int m = 0; m < 4; ++m) {
                    const int row = u.pm * BM + ai * HALF + wr * 64 + m * 16 + fr;
#pragma unroll
                    for (int bj = 0; bj < 2; ++bj) {
                        const f32x4 v0 = acc[ai][bj][m][0], v1 = acc[ai][bj][m][1];
                        const int col = (pn - 6) * 256 + 128 * bj + 32 * wc + 8 * fq;
                        u32x4 w; w.x = cvt_pk_bf16(v0[0], v0[1]); w.y = cvt_pk_bf16(v0[2], v0[3]); w.z = cvt_pk_bf16(v1[0], v1[1]); w.w = cvt_pk_bf16(v1[2], v1[3]);
                        if (!samp) { *(u32x4*)(proj + (size_t)row * E_PP + 1536 + col) = w; float* o = outv_p + (size_t)row * 512 + col; *(f32x4*)o = v0; *(f32x4*)(o + 4) = v1; }
                        else { const int lr = row - E_MP, b = lr >> 4, t = lr & 15; *(u32x4*)(vs + ((size_t)b * E_KSROWS + E_PAST + t) * 512 + col) = w; float* o = outv_s + (size_t)lr * 512 + col; *(f32x4*)o = v0; *(f32x4*)(o + 4) = v1; }
                    }
                }
        } else {
#pragma unroll
            for (int ai = 0; ai < 2; ++ai) if (ai < nai)
#pragma unroll
                for (int m = 0; m < 4; ++m) {
                    bf16_t* rowp = proj + (size_t)(u.pm * BM + ai * HALF + wr * 64 + m * 16 + fr) * E_PP + pn * BM + wc * 32 + 8 * fq;
#pragma unroll
                    for (int bj = 0; bj < 2; ++bj) { const f32x4 v0 = acc[ai][bj][m][0], v1 = acc[ai][bj][m][1];
                        u32x4 w; w.x = cvt_pk_bf16(v0[0], v0[1]); w.y = cvt_pk_bf16(v0[2], v0[3]); w.z = cvt_pk_bf16(v1[0], v1[1]); w.w = cvt_pk_bf16(v1[2], v1[3]);
                        *(u32x4*)(rowp + bj * HALF) = w; }
                }
        }
    }
};
struct EpiOut {
    static constexpr bool PERM = false, AFTER_DRAIN = false;
    const float* base_p; const float* base_s; float* out_p; float* out_s;
    __device__ __forceinline__ void operator()(const f32x4 (&acc)[2][2][4][2], const Unit& u, int wr, int wc, int fr, int fq) const {
        const bool samp = (u.pm == E_MP / 256);
        const int nai = samp ? 1 : 2;
        const int col0 = u.pn * BM + wc * 32 + 4 * fq;
#pragma unroll
        for (int ai = 0; ai < 2; ++ai) if (ai < nai)
#pragma unroll
            for (int m = 0; m < 4; ++m) {
                const int row = u.pm * BM + ai * HALF + wr * 64 + m * 16 + fr;
                const size_t off = samp ? (size_t)(row - E_MP) * 1024 + col0 : (size_t)row * 1024 + col0;
                const float* bp = (samp ? base_s : base_p) + off; float* op = (samp ? out_s : out_p) + off;
#pragma unroll
                for (int bj = 0; bj < 2; ++bj)
#pragma unroll
                    for (int n = 0; n < 2; ++n) { const f32x4 bs = *(const f32x4*)(bp + bj * HALF + n * 16); *(f32x4*)(op + bj * HALF + n * 16) = bs + acc[ai][bj][m][n]; }
            }
    }
};
template <class Epi, class Sched, bool ALIGN_EPI = false, bool SP2 = false>
__device__ __forceinline__ void gemm_phase(PG8_LAS unsigned char* lds, const Gemm g, const Sched& S, const Epi& E, int tid_in) {
    int tid_ = tid_in; asm volatile("" : "+v"(tid_));
    const int tid = tid_, wid = __builtin_amdgcn_readfirstlane(tid >> 6), lane = tid & 63, wr = wid >> 2, wc = wid & 3, fr = lane & 15, fq = lane >> 4;
    const int K = g.K, nt = K / BK;
    unsigned voffA[2], voffB[2];
#pragma unroll
    for (int i = 0; i < 2; ++i) { int R, C; stage_rc(tid * 16 + i * 8192, R, C); const int Rb = Epi::PERM ? ((R & ~31) + perm32(R & 31)) : R;
        voffA[i] = (unsigned)(R * K + C) * 2u; voffB[i] = (unsigned)(Rb * K + C) * 2u; }
    const size_t kstep = (size_t)(BK * 2);
    const size_t hstep = (size_t)HALF * K * 2;
    const size_t tstep = 2 * hstep;
    const unsigned ldsw = (unsigned)wid * 1024u;
    const int aoff = lds_byte(wr * 64 + fr, fq * 8), boff = lds_byte(wc * 32 + fr, fq * 8);
#define PG8_SA(b, h) (((b) * 2 + (h)) * HTB)
#define PG8_SB(b, h) ((4 + (b) * 2 + (h)) * HTB)
#define PG8_STAGE(bufoff, gbase, voff) do { _Pragma("unroll") for (int _i = 0; _i < 2; ++_i) \
        __builtin_amdgcn_global_load_lds((const unsigned*)((const char*)(gbase) + (voff)[_i]), (PG8_LAS unsigned*)(lds + (bufoff) + ldsw + _i * 8192), 16, 0, 0); } while (0)
#define PG8_LDA(dst, b, h) do { _Pragma("unroll") for (int m = 0; m < 4; ++m) _Pragma("unroll") for (int k = 0; k < 2; ++k) dst[m][k] = *(const PG8_LAS bf16x8*)(lds + PG8_SA(b, h) + aoff + m * 2048 + k * 1024); } while (0)
#define PG8_LDB(dst, b, h) do { _Pragma("unroll") for (int n = 0; n < 2; ++n) _Pragma("unroll") for (int k = 0; k < 2; ++k) dst[n][k] = *(const PG8_LAS bf16x8*)(lds + PG8_SB(b, h) + boff + n * 2048 + k * 1024); } while (0)
#define PG8_MMA(ai, bj, At, Bt) do { __builtin_amdgcn_s_setprio(1); _Pragma("unroll") for (int m = 0; m < 4; ++m) _Pragma("unroll") for (int n = 0; n < 2; ++n) _Pragma("unroll") for (int k = 0; k < 2; ++k) \
        acc[ai][bj][m][n] = __builtin_amdgcn_mfma_f32_16x16x32_bf16(Bt[n][k], At[m][k], acc[ai][bj][m][n], 0, 0, 0); __builtin_amdgcn_s_setprio(0); } while (0)
#define PG8_WAIT_V(n) asm volatile("s_waitcnt vmcnt(" #n ")" ::: "memory")
#define PG8_WAIT_L(n) asm volatile("s_waitcnt lgkmcnt(" #n ")" ::: "memory")
#define PG8_BAR __builtin_amdgcn_s_barrier()
#define PG8_SCHED __builtin_amdgcn_sched_barrier(0)
    Unit cur, nxt; int ui = 0;
    if (!S.next(0, cur)) return;
    f32x4 acc[2][2][4][2];
#pragma unroll
    for (int a = 0; a < 2; ++a)
#pragma unroll
        for (int b = 0; b < 2; ++b)
#pragma unroll
            for (int m = 0; m < 4; ++m)
#pragma unroll
                for (int n = 0; n < 2; ++n) acc[a][b][m][n] = (f32x4){0.f, 0.f, 0.f, 0.f};
    bf16x8 At[4][2], B0[2][2], B1[2][2];
    const char* cA = (const char*)g.A + (size_t)cur.pm * tstep; const char* cB = (const char*)g.Bt + (size_t)cur.pn * tstep;
    S.a_ready(cur);
    if constexpr (SP2) {
        PG8_STAGE(PG8_SB(0, 0), cB, voffB); PG8_STAGE(PG8_SB(0, 1), cB + hstep, voffB); PG8_STAGE(PG8_SA(0, 0), cA, voffA); PG8_STAGE(PG8_SA(0, 1), cA + hstep, voffA);
        if (wr == 1) PG8_BAR;
        PG8_WAIT_V(2); PG8_BAR;
        PG8_STAGE(PG8_SB(1, 0), cB + kstep, voffB); PG8_STAGE(PG8_SA(1, 0), cA + kstep, voffA); PG8_STAGE(PG8_SB(1, 1), cB + hstep + kstep, voffB);
        PG8_WAIT_V(6); PG8_BAR;
    } else {
        PG8_STAGE(PG8_SB(0, 0), cB, voffB); PG8_STAGE(PG8_SA(0, 0), cA, voffA); PG8_STAGE(PG8_SB(0, 1), cB + hstep, voffB); PG8_STAGE(PG8_SA(0, 1), cA + hstep, voffA);
        if (wr == 1) PG8_BAR;
        PG8_WAIT_V(4); PG8_BAR;
        PG8_STAGE(PG8_SB(1, 0), cB + kstep, voffB); PG8_STAGE(PG8_SA(1, 0), cA + kstep, voffA); PG8_STAGE(PG8_SB(1, 1), cB + hstep + kstep, voffB);
        PG8_WAIT_V(6); PG8_BAR;
    }
    for (;;) {
        const bool has_next = S.next(ui + 1, nxt);
        const char* nA = has_next ? (const char*)g.A + (size_t)nxt.pm * tstep : cA; const char* nB = has_next ? (const char*)g.Bt + (size_t)nxt.pn * tstep : cB;
        for (int t = 0; t < nt; t += 2) {
            const bool last = (t == nt - 2);
            const char* a1 = cA + (size_t)(t + 1) * kstep;
            const char* a2 = last ? nA : cA + (size_t)(t + 2) * kstep; const char* b2 = last ? nB : cB + (size_t)(t + 2) * kstep;
            const char* a3 = a2 + kstep; const char* b3 = b2 + kstep;
            if (last && has_next) S.a_ready(nxt);
            if constexpr (SP2) {
            PG8_LDB(B0, 0, 0); PG8_LDB(B1, 0, 1); PG8_SCHED; PG8_LDA(At, 0, 0); PG8_STAGE(PG8_SA(1, 1), a1 + hstep, voffA);
            PG8_WAIT_V(8); PG8_WAIT_L(0); PG8_BAR; PG8_MMA(0, 0, At, B0); PG8_MMA(0, 1, At, B1); PG8_BAR; PG8_SCHED;
            PG8_LDA(At, 0, 1); PG8_STAGE(PG8_SB(0, 0), b2, voffB); PG8_STAGE(PG8_SB(0, 1), b2 + hstep, voffB); PG8_STAGE(PG8_SA(0, 0), a2, voffA);
            PG8_WAIT_V(8); PG8_WAIT_L(0); PG8_BAR; PG8_MMA(1, 0, At, B0); PG8_MMA(1, 1, At, B1); PG8_BAR; PG8_SCHED;
            PG8_LDB(B0, 1, 0); PG8_LDB(B1, 1, 1); PG8_SCHED; PG8_LDA(At, 1, 0); PG8_STAGE(PG8_SA(0, 1), a2 + hstep, voffA);
            PG8_WAIT_V(8); PG8_WAIT_L(0); PG8_BAR; PG8_MMA(0, 0, At, B0); PG8_MMA(0, 1, At, B1); PG8_BAR; PG8_SCHED;
            PG8_LDA(At, 1, 1); PG8_STAGE(PG8_SB(1, 0), b3, voffB); PG8_STAGE(PG8_SB(1, 1), b3 + hstep, voffB); PG8_STAGE(PG8_SA(1, 0), a3, voffA);
            PG8_WAIT_V(8); PG8_WAIT_L(0); PG8_BAR; PG8_MMA(1, 0, At, B0); PG8_MMA(1, 1, At, B1); PG8_BAR; PG8_SCHED;
            } else {
            PG8_LDB(B0, 0, 0); PG8_SCHED; PG8_LDA(At, 0, 0); PG8_STAGE(PG8_SA(1, 1), a1 + hstep, voffA);
            PG8_WAIT_L(8); PG8_BAR; PG8_WAIT_L(0); PG8_MMA(0, 0, At, B0); PG8_BAR; PG8_SCHED;
            PG8_LDB(B1, 0, 1); PG8_STAGE(PG8_SB(0, 0), b2, voffB);
            PG8_BAR; PG8_WAIT_L(0); PG8_MMA(0, 1, At, B1); PG8_BAR;
            PG8_LDA(At, 0, 1); PG8_STAGE(PG8_SA(0, 0), a2, voffA);
            PG8_BAR; PG8_WAIT_L(0); PG8_MMA(1, 0, At, B0); PG8_BAR; PG8_SCHED;
            PG8_STAGE(PG8_SB(0, 1), b2 + hstep, voffB);
            PG8_WAIT_V(6); PG8_BAR; PG8_MMA(1, 1, At, B1); PG8_BAR;
            PG8_LDB(B0, 1, 0); PG8_SCHED; PG8_LDA(At, 1, 0); PG8_STAGE(PG8_SA(0, 1), a2 + hstep, voffA);
            PG8_WAIT_L(8); PG8_BAR; PG8_WAIT_L(0); PG8_MMA(0, 0, At, B0); PG8_BAR; PG8_SCHED;
            PG8_LDB(B1, 1, 1); PG8_STAGE(PG8_SB(1, 0), b3, voffB);
            PG8_BAR; PG8_WAIT_L(0); PG8_MMA(0, 1, At, B1); PG8_BAR;
            PG8_LDA(At, 1, 1); PG8_STAGE(PG8_SA(1, 0), a3, voffA);
            PG8_BAR; PG8_WAIT_L(0); PG8_MMA(1, 0, At, B0); PG8_BAR; PG8_SCHED;
            PG8_STAGE(PG8_SB(1, 1), b3 + hstep, voffB);
            PG8_WAIT_V(6); PG8_BAR; PG8_MMA(1, 1, At, B1); PG8_BAR;
            }
        }
        if constexpr (ALIGN_EPI) { if (wr == 0) PG8_BAR; }
        if constexpr (!Epi::AFTER_DRAIN) { E(acc, cur, wr, wc, fr, fq); S.done(cur); }
        if (!has_next) break;
#pragma unroll
        for (int a = 0; a < 2; ++a)
#pragma unroll
            for (int b = 0; b < 2; ++b)
#pragma unroll
                for (int m = 0; m < 4; ++m)
#pragma unroll
                    for (int n = 0; n < 2; ++n) acc[a][b][m][n] = (f32x4){0.f, 0.f, 0.f, 0.f};
        cur = nxt; cA = nA; cB = nB; ++ui;
        if constexpr (ALIGN_EPI) { if (wr == 1) PG8_BAR; }
    }
    PG8_WAIT_V(0);
    if constexpr (!ALIGN_EPI) { if (wr == 0) PG8_BAR; }
    PG8_BAR;
    if constexpr (Epi::AFTER_DRAIN) { E.fused(acc, cur, wr, wc, fr, fq, lds, wid, lane); S.done(cur); }
#undef PG8_SA
#undef PG8_SB
#undef PG8_STAGE
#undef PG8_LDA
#undef PG8_LDB
#undef PG8_MMA
#undef PG8_WAIT_V
#undef PG8_WAIT_L
#undef PG8_BAR
#undef PG8_SCHED
}
}
namespace attn_body {
using bf16=__hip_bfloat16;
using bf16x8=__attribute__((ext_vector_type(8)))short;
using s16x4=__attribute__((ext_vector_type(4)))short;
using f32x16=__attribute__((ext_vector_type(16)))float;
using f32x4a=__attribute__((ext_vector_type(4)))float;
using u32x4=__attribute__((ext_vector_type(4)))unsigned;
constexpr int D=64;
constexpr int NW=8,QBLK=32,QB=QBLK*NW,KVBLK=64;
constexpr int QP=3584, OP=1024, GP=3584;
__device__ __forceinline__ int crow(int r,int hi){return (r&3)+8*(r>>2)+4*hi;}
#define SBAR() __builtin_amdgcn_sched_barrier(0)
__device__ __forceinline__ void cmask(f32x16&p0,f32x16&p1,int koff,int qrel,int hi){
  const float NEG=-INFINITY; int kb=koff+4*hi;
  #pragma unroll
  for(int r=0;r<16;++r){int kv=kb+(r&3)+8*(r>>2); if(kv>qrel)p0[r]=NEG; if(kv+32>qrel)p1[r]=NEG;}
}
constexpr int NSLOT=3, SLOTB=8192;
constexpr int LDS_K=0, LDS_V=NSLOT*SLOTB, LDS_WS=2*NSLOT*SLOTB, LDS_OST=LDS_WS+NW*64*4, LDS_BIAS=LDS_OST+NW*4096, LDS_BYTES=LDS_BIAS+NW*NSLOT*256;
constexpr float C2=0.125f*1.4426950408889634f;
__device__ __forceinline__ void glds16(const void*gsrc,unsigned lds_dst){unsigned keep;
  asm volatile("s_mov_b32 %0, m0\n\ts_mov_b32 m0, %2\n\ts_nop 0\n\tglobal_load_lds_dwordx4 %1, off\n\ts_mov_b32 m0, %0":"=&s"(keep):"v"(gsrc),"s"(lds_dst):"memory");}
__device__ __forceinline__ void glds4(const void*gsrc,unsigned lds_dst){unsigned keep;
  asm volatile("s_mov_b32 %0, m0\n\ts_mov_b32 m0, %2\n\ts_nop 0\n\tglobal_load_lds_dword %1, off\n\ts_mov_b32 m0, %0":"=&s"(keep):"v"(gsrc),"s"(lds_dst):"memory");}
typedef float f32x2_t __attribute__((ext_vector_type(2))); typedef __bf16 bf16x2_t __attribute__((ext_vector_type(2)));
__device__ __forceinline__ unsigned cvtpk_s(float lo,float hi){f32x2_t v={lo,hi};bf16x2_t b=__builtin_convertvector(v,bf16x2_t);return __builtin_bit_cast(unsigned,b);}
#define WAIT_BAR(N) asm volatile("s_waitcnt vmcnt(" #N ") lgkmcnt(0)\n\ts_barrier":::"memory")
typedef __attribute__((address_space(3))) const char* lds_cptr;
typedef short v4i16_t __attribute__((ext_vector_type(4)));
#define LDSV(T,p) (*(const __attribute__((address_space(3))) T*)(p))
__device__ __forceinline__ void kload8(bf16x8*kf,lds_cptr kp){
  kf[0]=LDSV(bf16x8,kp);      kf[1]=LDSV(bf16x8,kp+512);
  kf[2]=LDSV(bf16x8,kp+2048); kf[3]=LDSV(bf16x8,kp+2560);
  kf[4]=LDSV(bf16x8,kp+4096); kf[5]=LDSV(bf16x8,kp+4608);
  kf[6]=LDSV(bf16x8,kp+6144); kf[7]=LDSV(bf16x8,kp+6656);
}
__device__ __forceinline__ void kload2(bf16x8*kf,lds_cptr kp,int j){ kf[2*j]=LDSV(bf16x8,kp+j*2048); kf[2*j+1]=LDSV(bf16x8,kp+j*2048+512); }
__device__ __forceinline__ s16x4 vtr(lds_cptr p){ return __builtin_bit_cast(s16x4,__builtin_amdgcn_ds_read_tr16_b64_v4i16((__attribute__((address_space(3))) v4i16_t*)p)); }
#define MX3(a,b,c) __builtin_fmaxf(__builtin_fmaxf((a),(b)),(c))
__device__ __forceinline__ float rowmax(const f32x16&p0,const f32x16&p1){
  float a=MX3(p0[0],p0[1],p1[0]),b=MX3(p0[2],p0[3],p1[1]);a=MX3(a,p1[2],p1[3]);
  #pragma unroll
  for(int r=4;r<16;r+=4){a=MX3(a,p0[r],p0[r+1]);b=MX3(b,p0[r+2],p0[r+3]);a=MX3(a,p1[r],p1[r+1]);b=MX3(b,p1[r+2],p1[r+3]);}
  float m=__builtin_fmaxf(a,b);
  auto rr=__builtin_amdgcn_permlane32_swap(__float_as_uint(m),__float_as_uint(m),false,false);
  return __builtin_fmaxf(__uint_as_float(rr[0]),__uint_as_float(rr[1]));
}
__device__ __forceinline__ void pv(f32x16*o,int vb,bf16x8 pa0,bf16x8 pa1,bf16x8 pa2,bf16x8 pa3){
  #pragma unroll
  for(int d0=0;d0<2;++d0){s16x4 lo[4],hi[4];
    #pragma unroll
    for(int ks=0;ks<4;++ks){
      asm volatile("ds_read_b64_tr_b16 %0,%1 offset:%c2":"=&v"(lo[ks]):"v"(vb),"i"(d0*4096+ks*1024):"memory");
      asm volatile("ds_read_b64_tr_b16 %0,%1 offset:%c2":"=&v"(hi[ks]):"v"(vb),"i"(d0*4096+ks*1024+512):"memory");}
    asm volatile("s_waitcnt lgkmcnt(0)":::"memory");SBAR();
    #define PK(k) (bf16x8){lo[k][0],lo[k][1],lo[k][2],lo[k][3],hi[k][0],hi[k][1],hi[k][2],hi[k][3]}
    o[d0]=__builtin_amdgcn_mfma_f32_32x32x16_bf16(pa0,PK(0),o[d0],0,0,0);
    o[d0]=__builtin_amdgcn_mfma_f32_32x32x16_bf16(pa1,PK(1),o[d0],0,0,0);
    o[d0]=__builtin_amdgcn_mfma_f32_32x32x16_bf16(pa2,PK(2),o[d0],0,0,0);
    o[d0]=__builtin_amdgcn_mfma_f32_32x32x16_bf16(pa3,PK(3),o[d0],0,0,0);
    #undef PK
  }
}
struct AUnit {
  const bf16* Q;
  const bf16* K;
  const bf16* V;
  const float* nbk;
  bf16* O;
  const bf16* G;
  int kp;
  int NT, qoff, nvalid;
};
#define FLOORZ (-8.0f)
template<int THRL> __device__ __forceinline__ void attn_unit(const AUnit&U,char*shm,int wave0){
  int l__; asm volatile("v_mbcnt_lo_u32_b32 %0, -1, 0\n\tv_mbcnt_hi_u32_b32 %0, -1, %0":"=v"(l__)); int tid_=wave0*64+l__; const int tid=tid_,lane=tid&63,r32=lane&31,hi=lane>>5; const int wid=__builtin_amdgcn_readfirstlane(tid>>6);
  const int KP=U.kp;
  const bf16*Qw=U.Q+(long)(wid*QBLK)*QP;
  const bf16*Kh=U.K,*Vh=U.V;
  const unsigned lds0=(unsigned)(uintptr_t)shm;
  float*wsf=(float*)(shm+LDS_WS)+wid*64;
  const bf16*ksrc=Kh+(long)lane*KP+wid*8;
  const bf16*vsrc=Vh+(long)(16*(wid&3)+(lane>>2))*KP+(wid>>2)*32+(lane&3)*8;
  const float*bsrc=U.nbk+lane;
  const unsigned kdst=lds0+LDS_K+wid*1024, vdst=lds0+LDS_V+wid*1024, bdst=lds0+LDS_BIAS+wid*(NSLOT*256);
  #define DMA_K(t,slot) do{ glds16(ksrc+(long)(t)*KVBLK*KP,(unsigned)__builtin_amdgcn_readfirstlane(kdst+(slot))); glds4(bsrc+(t)*KVBLK,(unsigned)__builtin_amdgcn_readfirstlane(bdst+((slot)>>5))); }while(0)
  #define DMA_V(t,slot) glds16(vsrc+(long)(t)*KVBLK*KP,(unsigned)__builtin_amdgcn_readfirstlane(vdst+(slot)))
  const int vb0=(int)(lds0+LDS_V)+((lane>>4)&1)*32+(lane&3)*8+(4*hi+((lane&15)>>2))*64;
  const char*Kbase=shm+LDS_K; bf16x8 kf[8];
  const lds_cptr shm3=(lds_cptr)shm; const lds_cptr kp0=shm3+LDS_K+hi*1024+r32*16; const lds_cptr vp0=shm3+LDS_V+((lane>>4)&1)*32+(lane&3)*8+(4*hi+((lane&15)>>2))*64;
  const lds_cptr bp0=shm3+LDS_BIAS+wid*(NSLOT*256)+hi*16;
  const int NT=U.NT;
  DMA_K(0,0);DMA_V(0,0);DMA_K(1,SLOTB);
  bf16x8 qr[4];
  #pragma unroll
  for(int d0=0;d0<4;++d0)qr[d0]=*reinterpret_cast<const bf16x8*>(&Qw[(long)r32*QP+d0*16+hi*8]);
  const int qrel=wid*QBLK+r32;
  const float bq=-U.nbk[U.qoff+qrel];
  float nm=0.f,l_reg=0.f;f32x16 o[2];o[0]=f32x16{};o[1]=f32x16{};
  const int qoff=U.qoff;
  #define CMASK(P0,P1,t) do{ if((t)>=NT-4)cmask(P0,P1,64*(t)-qoff,qrel,hi);}while(0)
  #define BLD1(P0,P1,bp,g) do{ const f32x4a a_=LDSV(f32x4a,(bp)+(g)*32); const f32x4a b_=LDSV(f32x4a,(bp)+128+(g)*32); \
      P0[4*(g)]=a_[0];P0[4*(g)+1]=a_[1];P0[4*(g)+2]=a_[2];P0[4*(g)+3]=a_[3]; P1[4*(g)]=b_[0];P1[4*(g)+1]=b_[1];P1[4*(g)+2]=b_[2];P1[4*(g)+3]=b_[3]; }while(0)
  bool resc=false;
  #define RESC() do{ if(resc){ asm volatile("s_waitcnt lgkmcnt(0)":::"memory"); \
      _Pragma("unroll") for(int d_=0;d_<2;++d_) _Pragma("unroll") for(int r=0;r<16;++r)o[d_][r]*=wsf[crow(r,hi)]; } }while(0)
  f32x16 pA0,pA1,pB0,pB1;
  int sl_prev=0,sl_cur=0,sl_next=SLOTB;
  #define ROT() do{sl_prev=sl_cur;sl_cur=sl_next;sl_next=(sl_next==(NSLOT-1)*SLOTB)?0:sl_next+SLOTB;}while(0)
  DMA_K(2,2*SLOTB);
  WAIT_BAR(2);
  { BLD1(pA0,pA1,bp0,0);BLD1(pA0,pA1,bp0,1);BLD1(pA0,pA1,bp0,2);BLD1(pA0,pA1,bp0,3);
    const char*kb=Kbase+hi*1024+r32*16;
    #pragma unroll
    for(int d0=0;d0<4;++d0){
      const bf16x8 b0=*reinterpret_cast<const bf16x8*>(kb+d0*2048);
      const bf16x8 b1=*reinterpret_cast<const bf16x8*>(kb+d0*2048+512);
      pA0=__builtin_amdgcn_mfma_f32_32x32x16_bf16(b0,qr[d0],pA0,0,0,0);pA1=__builtin_amdgcn_mfma_f32_32x32x16_bf16(b1,qr[d0],pA1,0,0,0);}
  }
  CMASK(pA0,pA1,0);
  { const float rm=rowmax(pA0,pA1); const float z=rm+bq; const float mh=__builtin_fmaxf(z,FLOORZ); nm=bq-mh;
    _Pragma("unroll") for(int r=0;r<16;++r){pA0[r]=__builtin_amdgcn_exp2f(pA0[r]+nm);pA1[r]=__builtin_amdgcn_exp2f(pA1[r]+nm);} }
  WAIT_BAR(0);
  DMA_K(3,0);DMA_V(1,SLOTB);
  ROT();
  kload8(kf,kp0+sl_cur);
  { const lds_cptr bp_=bp0+(sl_cur>>5); BLD1(pB0,pB1,bp_,0);BLD1(pB0,pB1,bp_,1);BLD1(pB0,pB1,bp_,2);BLD1(pB0,pB1,bp_,3); }
  WAIT_BAR(3);
  s16x4 vlo[8],vhi[8]; u32x4 pw0,pw1,pw2,pw3;
  #define PKW(P,B) cvtpk_s(P[B],P[B+1])
  #define PAF(k) __builtin_bit_cast(bf16x8,pw##k)
  #define VFR(i) (bf16x8){vlo[i][0],vlo[i][1],vlo[i][2],vlo[i][3],vhi[i][0],vhi[i][1],vhi[i][2],vhi[i][3]}
  #define PIN(x) asm volatile("":"+v"(x))
  #define GAPA(MF,A0,A1,A2,A3,W0,W1,PW) do{ MF; sacc+=A0; sacc+=A1; sacc+=A2; sacc+=A3; PIN(sacc); W0; W1; PIN(PW); SBAR(); }while(0)
  #define EX(v) __builtin_amdgcn_exp2f((v)+nm)
  #define GAPB(MF,X,B) do{ MF; X[B]=EX(X[B]); X[B+1]=EX(X[B+1]); X[B+2]=EX(X[B+2]); X[B+3]=EX(X[B+3]); PIN(X); SBAR(); }while(0)
  #define VRD(i) do{ vlo[i]=vtr(vp_+(((i)>>2)*4096+((i)&3)*1024)); vhi[i]=vtr(vp_+(((i)>>2)*4096+((i)&3)*1024+512)); }while(0)
  #define KRD(G,j) do{ if(G){ kload2(kf,kp0+sl_next,j); SBAR(); } }while(0)
  #define BRD(G,P0,P1,g) do{ if(G){ BLD1(P0,P1,bpn_,g); SBAR(); } }while(0)
  #define STEP(C0,C1,P0,P1,t,GK,GV,GL) do{ SBAR(); \
    const lds_cptr vp_=vp0+sl_prev; const lds_cptr bpn_=bp0+(sl_next>>5); \
    VRD(0); SBAR(); float sacc=(P0[0]+P0[1]); \
    GAPA(C0=__builtin_amdgcn_mfma_f32_32x32x16_bf16(kf[0],qr[0],C0,0,0,0), P0[2],P0[3],P0[4],P0[5],     pw0[0]=PKW(P0,0), pw0[1]=PKW(P0,2), pw0); \
    VRD(4); SBAR(); GAPA(C1=__builtin_amdgcn_mfma_f32_32x32x16_bf16(kf[1],qr[0],C1,0,0,0), P0[6],P0[7],P0[8],P0[9],     pw0[2]=PKW(P0,4), pw0[3]=PKW(P0,6), pw0); \
    VRD(1); SBAR(); GAPA(C0=__builtin_amdgcn_mfma_f32_32x32x16_bf16(kf[2],qr[1],C0,0,0,0),   P0[10],P0[11],P0[12],P0[13], pw1[0]=PKW(P0,8), pw1[1]=PKW(P0,10), pw1); \
    VRD(5); SBAR(); GAPA(C1=__builtin_amdgcn_mfma_f32_32x32x16_bf16(kf[3],qr[1],C1,0,0,0),   P0[14],P0[15],P1[0],P1[1],   pw1[2]=PKW(P0,12),pw1[3]=PKW(P0,14), pw1); \
    VRD(2); SBAR(); GAPA(C0=__builtin_amdgcn_mfma_f32_32x32x16_bf16(kf[4],qr[2],C0,0,0,0),   P1[2],P1[3],P1[4],P1[5],     pw2[0]=PKW(P1,0), pw2[1]=PKW(P1,2), pw2); \
    VRD(6); SBAR(); GAPA(C1=__builtin_amdgcn_mfma_f32_32x32x16_bf16(kf[5],qr[2],C1,0,0,0),   P1[6],P1[7],P1[8],P1[9],     pw2[2]=PKW(P1,4), pw2[3]=PKW(P1,6), pw2); \
    VRD(3); SBAR(); GAPA(C0=__builtin_amdgcn_mfma_f32_32x32x16_bf16(kf[6],qr[3],C0,0,0,0),   P1[10],P1[11],P1[12],P1[13], pw3[0]=PKW(P1,8), pw3[1]=PKW(P1,10), pw3); \
    VRD(7); SBAR(); GAPA(C1=__builtin_amdgcn_mfma_f32_32x32x16_bf16(kf[7],qr[3],C1,0,0,0),   P1[14],P1[15],0.f,0.f,       pw3[2]=PKW(P1,12),pw3[3]=PKW(P1,14), pw3); \
    l_reg+=sacc; \
    if(GK){DMA_K((t)+3,sl_cur);} if(GV){DMA_V((t)+1,sl_next);} \
    CMASK(C0,C1,t); \
    { float a=MX3(C0[0],C0[1],C1[0]),b=MX3(C0[2],C0[3],C1[1]); a=MX3(a,C1[2],C1[3]); \
      _Pragma("unroll") for(int r=4;r<16;r+=4){a=MX3(a,C0[r],C0[r+1]);b=MX3(b,C0[r+2],C0[r+3]);a=MX3(a,C1[r],C1[r+1]);b=MX3(b,C1[r+2],C1[r+3]);} \
      float rm=__builtin_fmaxf(a,b); { auto rr=__builtin_amdgcn_permlane32_swap(__float_as_uint(rm),__float_as_uint(rm),false,false); rm=__builtin_fmaxf(__uint_as_float(rr[0]),__uint_as_float(rr[1])); } \
      rm+=nm; resc=false; \
      if(__builtin_expect(__any(rm>(float)THRL),0)){ const float dl=__builtin_fmaxf(rm,0.f); nm-=dl; \
        const float f=__builtin_amdgcn_exp2f(-dl); l_reg*=f; if(hi==0)wsf[r32]=f; resc=true; } } \
    SBAR(); \
    BRD(GL,P0,P1,0); GAPB(o[0]=__builtin_amdgcn_mfma_f32_32x32x16_bf16(PAF(0),VFR(0),o[0],0,0,0), C0,0); \
    BRD(GL,P0,P1,1); GAPB(o[1]=__builtin_amdgcn_mfma_f32_32x32x16_bf16(PAF(0),VFR(4),o[1],0,0,0), C0,4); \
    KRD(GL,0); GAPB(o[0]=__builtin_amdgcn_mfma_f32_32x32x16_bf16(PAF(1),VFR(1),o[0],0,0,0), C0,8); \
    KRD(GL,1); GAPB(o[1]=__builtin_amdgcn_mfma_f32_32x32x16_bf16(PAF(1),VFR(5),o[1],0,0,0), C0,12); \
    KRD(GL,2); GAPB(o[0]=__builtin_amdgcn_mfma_f32_32x32x16_bf16(PAF(2),VFR(2),o[0],0,0,0), C1,0); \
    KRD(GL,3); GAPB(o[1]=__builtin_amdgcn_mfma_f32_32x32x16_bf16(PAF(2),VFR(6),o[1],0,0,0), C1,4); \
    BRD(GL,P0,P1,2); GAPB(o[0]=__builtin_amdgcn_mfma_f32_32x32x16_bf16(PAF(3),VFR(3),o[0],0,0,0), C1,8); \
    BRD(GL,P0,P1,3); GAPB(o[1]=__builtin_amdgcn_mfma_f32_32x32x16_bf16(PAF(3),VFR(7),o[1],0,0,0), C1,12); \
    }while(0)
  int t=1;
  #undef CMASK
  #define CMASK(P0,P1,t) do{}while(0)
  for(;t+5<NT;t+=2){
    STEP(pB0,pB1,pA0,pA1,t,true,true,true);     WAIT_BAR(3); RESC(); ROT();
    STEP(pA0,pA1,pB0,pB1,t+1,true,true,true);   WAIT_BAR(3); RESC(); ROT();
  }
  #undef CMASK
  #define CMASK(P0,P1,t) do{ if((t)>=NT-4)cmask(P0,P1,64*(t)-qoff,qrel,hi);}while(0)
  #define ENDW(tt) do{ if((tt)+3<NT){WAIT_BAR(3);} else if((tt)+2<NT){WAIT_BAR(1);} else {WAIT_BAR(0);} }while(0)
  for(;t+1<NT;t+=2){
    STEP(pB0,pB1,pA0,pA1,t,(t+3<NT),(t+1<NT),(t+1<NT));       ENDW(t);   RESC(); ROT();
    STEP(pA0,pA1,pB0,pB1,t+1,(t+4<NT),(t+2<NT),(t+2<NT));     ENDW(t+1); RESC(); ROT();
  }
  STEP(pB0,pB1,pA0,pA1,NT-1,false,false,false); RESC();
  { float sacc=pB0[0]+pB0[1]; _Pragma("unroll") for(int r=2;r<16;++r)sacc+=pB0[r]; _Pragma("unroll") for(int r=0;r<16;++r)sacc+=pB1[r]; l_reg+=sacc;
    pw0=(u32x4){PKW(pB0,0),PKW(pB0,2),PKW(pB0,4),PKW(pB0,6)};pw1=(u32x4){PKW(pB0,8),PKW(pB0,10),PKW(pB0,12),PKW(pB0,14)};pw2=(u32x4){PKW(pB1,0),PKW(pB1,2),PKW(pB1,4),PKW(pB1,6)};pw3=(u32x4){PKW(pB1,8),PKW(pB1,10),PKW(pB1,12),PKW(pB1,14)};
    SBAR(); pv(o,vb0+sl_cur,PAF(0),PAF(1),PAF(2),PAF(3)); }
  #undef PKW
  #undef PAF
  #undef VFR
  #undef PIN
  #undef GAPA
  #undef GAPB
  #undef EX
  #undef VRD
  #undef KRD
  #undef BRD
  #undef STEP
  #undef ENDW
  {auto rr=__builtin_amdgcn_permlane32_swap(__float_as_uint(l_reg),__float_as_uint(l_reg),false,false);l_reg=__uint_as_float(rr[0])+__uint_as_float(rr[1]);}
  if(hi==0)wsf[32+r32]=l_reg;asm volatile("s_waitcnt lgkmcnt(0)":::"memory");
  float rli[16];
  #pragma unroll
  for(int r=0;r<16;++r)rli[r]=__builtin_amdgcn_rcpf(wsf[32+crow(r,hi)]);
  bf16*Ow=U.O+(long)(wid*QBLK)*OP; const bf16*Gw=U.G+(long)(wid*QBLK)*GP;
  { bf16*stg=(bf16*)(shm+LDS_OST)+wid*2048;
    #pragma unroll
    for(int r=0;r<16;++r){const int orow=crow(r,hi);
      #pragma unroll
      for(int d0=0;d0<2;++d0)stg[orow*64+d0*32+r32]=__float2bfloat16(o[d0][r]*rli[r]);}
    asm volatile("s_waitcnt lgkmcnt(0)":::"memory");
    #pragma unroll
    for(int i=0;i<4;++i){const int row=i*8+(lane>>3),ch=lane&7; const u32x4 v=*(const u32x4*)(stg+row*64+ch*8);
      if(wid*QBLK+row<U.nvalid){
        const u32x4 gv=*(const u32x4*)(Gw+(long)row*GP+ch*8); u32x4 ov;
        #pragma unroll
        for(int e=0;e<4;++e){
          const float o0=__uint_as_float(v[e]<<16), o1=__uint_as_float(v[e]&0xffff0000u);
          const float g0=__uint_as_float(gv[e]<<16), g1=__uint_as_float(gv[e]&0xffff0000u);
          const float s0=g0*__builtin_amdgcn_rcpf(1.f+__expf(-g0)), s1=g1*__builtin_amdgcn_rcpf(1.f+__expf(-g1));
          ov[e]=cvtpk_s(o0*s0,o1*s1); }
        *(u32x4*)(Ow+(long)row*OP+ch*8)=ov; } } }
  asm volatile("s_waitcnt lgkmcnt(0)\n\ts_barrier":::"memory");
  #undef DMA_K
  #undef DMA_V
  #undef CMASK
  #undef RESC
  #undef ROT
  #undef BLD1
}
constexpr int ATTN_LDS_BYTES=LDS_BYTES;
#undef SBAR
#undef WAIT_BAR
#undef MX3
#undef LDSV
#undef FLOORZ
}

namespace cg = cooperative_groups;
#define GAS __attribute__((address_space(1)))
#define LAS __attribute__((address_space(3)))
typedef unsigned short bf16;
typedef unsigned v4u __attribute__((ext_vector_type(4)));
typedef unsigned v2u __attribute__((ext_vector_type(2)));
typedef float f32x4 __attribute__((ext_vector_type(4)));
typedef short bf16x8 __attribute__((ext_vector_type(8)));
constexpr int NWAVES = 8;

constexpr int DM = 1024, NB = 16, SEQ = 4096, NL = 2, SB = 8, ST = 16, PAST = 2048, NH = 8, HD = 64;
constexpr int MP = NB * SEQ;
constexpr int MS = SB * ST;
constexpr int MV = MP + MS;
constexpr int MPAD = 257 * 256;
constexpr int INC = 3592;
constexpr int PP = 3584;
constexpr int C_PU = 0, C_PG = 256, C_Q = 512, C_K = 1024, C_V = 1536, C_AG = 2048, C_CB = 2560, C_CC = 2816, C_CX = 3072, C_CG = 3328;
constexpr int KSROWS = 2176;
constexpr int NBKS = 2432;
constexpr float EPS = 1e-6f;
constexpr float LOG2E = 1.4426950408889634f;

constexpr size_t O_YP = 0;
constexpr size_t O_YS = O_YP + (size_t)MP * DM;
constexpr size_t O_KP = O_YS + (size_t)MS * DM;
constexpr size_t O_VP = O_KP + (size_t)NL * MP * 512;
constexpr size_t O_FP = O_VP + (size_t)NL * MP * 512;
constexpr size_t O_PP = O_FP + (size_t)NL * MP * 8;
constexpr size_t O_CP = O_PP + (size_t)NL * NB * 15 * 256;
constexpr size_t O_KS = O_CP + (size_t)NL * NB * 2 * 256;
constexpr size_t O_VS = O_KS + (size_t)NL * MS * 512;
constexpr size_t O_FS = O_VS + (size_t)NL * MS * 512;
constexpr size_t O_PS = O_FS + (size_t)NL * MS * 8;
constexpr size_t O_CS = O_PS + (size_t)NL * SB * 15 * 256;
constexpr size_t O_END = O_CS + (size_t)NL * SB * 2 * 256;

constexpr size_t MiB = 1u << 20;
constexpr size_t WS_WIN = 0;
constexpr size_t WS_WOUT = 16 * MiB;
constexpr size_t WS_PWT = 20 * MiB;
constexpr size_t WS_NBKP = 21 * MiB;
constexpr size_t WS_NBKS = 23 * MiB;
constexpr size_t WS_KS = 24 * MiB;
constexpr size_t WS_VS = 60 * MiB;
constexpr size_t WS_XN = 96 * MiB;
constexpr size_t WS_PROJ = 226 * MiB;
constexpr size_t WS_END = WS_PROJ + (size_t)(MPAD + 512) * PP * 2;
static_assert(WS_KS + (size_t)NL * SB * KSROWS * 512 * 2 <= WS_VS && WS_VS + (size_t)NL * SB * KSROWS * 512 * 2 <= WS_XN && WS_XN + (size_t)(MPAD + 256) * DM * 2 <= WS_PROJ, "ws map");

constexpr int REP_P0 = 1, REP_PA = 1, REP_GIN = 1, REP_MIX = 1, REP_ATTN = 1, REP_GOUT0 = 1;
constexpr int RING_BYTES = 131072;
constexpr int LDS_BYTES = 147456;

__device__ __forceinline__ unsigned f2bf(float f) { unsigned u = __builtin_bit_cast(unsigned, f); return (u + 0x7fffu + ((u >> 16) & 1u)) >> 16; }
__device__ __forceinline__ unsigned pk2(float lo, float hi) { return attn_body::cvtpk_s(lo, hi); }
__device__ __forceinline__ float bflo(unsigned w) { return __uint_as_float(w << 16); }
__device__ __forceinline__ float bfhi(unsigned w) { return __uint_as_float(w & 0xffff0000u); }
__device__ __forceinline__ float silu_f(float x) { return x * __builtin_amdgcn_rcpf(1.f + __expf(-x)); }
__device__ __forceinline__ float shx(float v, int m, int lane) { return __int_as_float(__builtin_amdgcn_ds_bpermute((lane ^ m) << 2, __float_as_int(v))); }
__device__ __forceinline__ float wave_sum(float v, int lane) {
#pragma unroll
    for (int o = 1; o < 64; o <<= 1) v += shx(v, o, lane);
    return v;
}

struct Args {
    const float* in[16]; float* out; unsigned char* ws; int ph_lo, ph_hi;
};

struct Frame {
    LAS unsigned char* lds;
    int tid, lane, wave, vcu, G, wave0;
};
#define FRAME_REFRESH(F) do { int l_; asm volatile("v_mbcnt_lo_u32_b32 %0, -1, 0\n\tv_mbcnt_hi_u32_b32 %0, -1, %0" : "=v"(l_)); int t_ = (F).wave0 * 64 + l_; (F).tid = t_; (F).lane = t_ & 63; (F).wave = __builtin_amdgcn_readfirstlane(t_ >> 6); } while (0)

__host__ __device__ __forceinline__ int win_logical_col(int p) {
    if (p < 512) return p;
    if (p < 1536) { const int reg = (p - 512) >> 8, q = (p - 512) & 255; return 512 + reg * 256 + 64 * ((q >> 5) & 3) + 32 * (q >> 7) + (q & 31); }
    if (p < 2560) return p;
    return p + 8;
}

__device__ __forceinline__ void transpose_item(const float* W, int K, int Nsrc, int srccol0, bf16* WT, int n0, int k0, LAS float* scr, int lane) {
#pragma unroll 8
    for (int i = 0; i < 32; ++i) { const int kk = 2 * i + (lane >> 5); scr[kk * 33 + (lane & 31)] = W[(size_t)(k0 + kk) * Nsrc + srccol0 + (lane & 31)]; }
    asm volatile("s_waitcnt lgkmcnt(0)" ::: "memory");
    const int c = lane & 7;
#pragma unroll
    for (int j = 0; j < 4; ++j) { const int n = (lane >> 3) + 8 * j; const LAS float* s = scr + (8 * c) * 33 + n;
        v4u o; o.x = pk2(s[0 * 33], s[1 * 33]); o.y = pk2(s[2 * 33], s[3 * 33]); o.z = pk2(s[4 * 33], s[5 * 33]); o.w = pk2(s[6 * 33], s[7 * 33]);
        *(v4u*)(WT + (size_t)(n0 + n) * K + k0 + 8 * c) = o; }
    asm volatile("s_waitcnt lgkmcnt(0)" ::: "memory");
}

__device__ __forceinline__ void p0_prologue(Frame& F, const Args& a) {
    LAS float* scr = (LAS float*)(F.lds + F.wave * 16384);
    const int gw = F.vcu * NWAVES + F.wave, NGW = F.G * NWAVES;
    unsigned char* ws = a.ws;
    constexpr int I_IN = (DM / 64) * (PP / 32), I_OUT = (DM / 64) * (DM / 32);
    for (int it = gw; it < NL * (I_IN + I_OUT); it += NGW) {
        const int l = it / (I_IN + I_OUT); int r = it % (I_IN + I_OUT);
        if (r < I_IN) { const int kb = r / (PP / 32), nb = r % (PP / 32);
            transpose_item(a.in[8] + (size_t)l * DM * INC, DM, INC, win_logical_col(32 * nb), (bf16*)(ws + WS_WIN) + (size_t)l * PP * DM, 32 * nb, 64 * kb, scr, F.lane); }
        else { r -= I_IN; const int kb = r / (DM / 32), nb = r % (DM / 32);
            transpose_item(a.in[15] + (size_t)l * DM * DM, DM, DM, 32 * nb, (bf16*)(ws + WS_WOUT) + (size_t)l * DM * DM, 32 * nb, 64 * kb, scr, F.lane); }
    }
    { const int gt = F.vcu * 512 + F.tid, NT_ = F.G * 512; bf16* pwt = (bf16*)(ws + WS_PWT);
      for (int i = gt; i < NL * 4 * 64 * 64; i += NT_) { const int c = i & 63, d = (i >> 6) & 63, lg = i >> 12; pwt[i] = (bf16)f2bf(a.in[12][(size_t)lg * 4096 + c * 64 + d]); } }
    { const size_t gt = (size_t)F.vcu * 512 + F.tid, NT_ = (size_t)F.G * 512;
      const size_t nchunk = (size_t)NL * SB * PAST * 64;
      for (size_t i = gt; i < 2 * nchunk; i += NT_) {
          const int which = i >= nchunk; const size_t j = which ? i - nchunk : i;
          const size_t rowg = j >> 6; const int c8 = (int)(j & 63) * 8; const size_t lb = rowg / PAST; const int r = (int)(rowg % PAST);
          const float* src = a.in[2 + which] + rowg * 512 + c8;
          const f32x4 x0 = *(const f32x4*)src, x1 = *(const f32x4*)(src + 4);
          v4u o; o.x = pk2(x0[0], x0[1]); o.y = pk2(x0[2], x0[3]); o.z = pk2(x1[0], x1[1]); o.w = pk2(x1[2], x1[3]);
          bf16* dst = (bf16*)(ws + (which ? WS_VS : WS_KS)) + (lb * KSROWS + r) * 512 + c8;
          *(v4u*)dst = o; }
      const size_t nz = (size_t)NL * SB * (KSROWS - PAST - ST) * 64;
      for (size_t i = gt; i < 2 * nz; i += NT_) {
          const int which = i >= nz; const size_t j = which ? i - nz : i;
          const size_t rowg = j >> 6; const int c8 = (int)(j & 63) * 8; const size_t lb = rowg / (KSROWS - PAST - ST); const int r = (int)(rowg % (KSROWS - PAST - ST)) + PAST + ST;
          bf16* dst = (bf16*)(ws + (which ? WS_VS : WS_KS)) + (lb * KSROWS + r) * 512 + c8;
          *(v4u*)dst = (v4u){0u, 0u, 0u, 0u}; } }
    { const int gt = F.vcu * 512 + F.tid, NT_ = F.G * 512; v4u* p = (v4u*)((bf16*)(ws + WS_XN) + (size_t)MV * DM);
      for (int i = gt; i < (MPAD - MV) * DM / 8; i += NT_) p[i] = (v4u){0u, 0u, 0u, 0u}; }
}

__device__ __forceinline__ void pa_phase(Frame& F, const Args& a, int l, const float* xp, const float* xs) {
    LAS float* wg = (LAS float*)F.lds;
    __syncthreads();
    const float* ng = a.in[7] + (size_t)l * DM;
    { const float* wf = a.in[8] + (size_t)l * DM * INC + 2560;
      for (int k = F.tid; k < DM; k += 512) { const f32x4 w0 = *(const f32x4*)(wf + (size_t)k * INC), w1 = *(const f32x4*)(wf + (size_t)k * INC + 4); const float g = ng[k];
          wg[0 * 1024 + k] = w0[0] * g; wg[1 * 1024 + k] = w0[1] * g; wg[2 * 1024 + k] = w0[2] * g; wg[3 * 1024 + k] = w0[3] * g;
          wg[4 * 1024 + k] = w1[0] * g; wg[5 * 1024 + k] = w1[1] * g; wg[6 * 1024 + k] = w1[2] * g; wg[7 * 1024 + k] = w1[3] * g; } }
    __syncthreads();
    const int lane = F.lane;
    f32x4 gv[4];
#pragma unroll
    for (int j = 0; j < 4; ++j) gv[j] = *(const f32x4*)(ng + 4 * lane + 256 * j);
    const float* bfp = a.in[9] + l * 8;
    bf16* XN = (bf16*)(a.ws + WS_XN);
    float* outfp = a.out + O_FP + (size_t)l * MP * 8; float* outfs = a.out + O_FS + (size_t)l * MS * 8;
    const int gw = F.vcu * NWAVES + F.wave, NGW = F.G * NWAVES;
    for (int rg = gw; rg < MV / 4; rg += NGW) {
        const int row0 = rg * 4;
        const float* src = row0 < MP ? xp + (size_t)row0 * DM : xs + (size_t)(row0 - MP) * DM;
        f32x4 v[4][4]; float rstd[4];
#pragma unroll
        for (int r = 0; r < 4; ++r)
#pragma unroll
            for (int j = 0; j < 4; ++j) v[r][j] = *(const f32x4*)(src + (size_t)r * DM + 4 * lane + 256 * j);
#pragma unroll
        for (int r = 0; r < 4; ++r) { float s = 0.f;
#pragma unroll
            for (int j = 0; j < 4; ++j) s += (v[r][j][0] * v[r][j][0] + v[r][j][1] * v[r][j][1]) + (v[r][j][2] * v[r][j][2] + v[r][j][3] * v[r][j][3]);
            rstd[r] = 1.0f / sqrtf(wave_sum(s, lane) * (1.f / DM) + EPS); }
        float acc[32];
#pragma unroll
        for (int i = 0; i < 32; ++i) acc[i] = 0.f;
#pragma unroll
        for (int h = 0; h < 8; ++h) {
#pragma unroll
            for (int j = 0; j < 4; ++j) { const f32x4 w = *(const LAS f32x4*)(wg + h * 1024 + 4 * lane + 256 * j);
#pragma unroll
                for (int r = 0; r < 4; ++r) acc[r * 8 + h] += (v[r][j][0] * w[0] + v[r][j][1] * w[1]) + (v[r][j][2] * w[2] + v[r][j][3] * w[3]); }
            asm volatile("" ::: "memory"); }
#define RS_STAGE(M_, N_) { const bool up = (lane & (M_)) != 0; _Pragma("unroll") for (int i = 0; i < (N_); ++i) { const float send = up ? acc[i] : acc[i + (N_)], keep = up ? acc[i + (N_)] : acc[i]; acc[i] = keep + shx(send, (M_), lane); } }
        RS_STAGE(32, 16) RS_STAGE(16, 8) RS_STAGE(8, 4) RS_STAGE(4, 2) RS_STAGE(2, 1)
#undef RS_STAGE
        acc[0] += shx(acc[0], 1, lane);
        { const int idx = lane >> 1, r = idx >> 3, h = idx & 7;
          const float rs = r == 0 ? rstd[0] : r == 1 ? rstd[1] : r == 2 ? rstd[2] : rstd[3];
          const float xx = acc[0] * rs + bfp[h];
          const float lf = fminf(xx, 0.f) - __logf(1.f + __expf(-fabsf(xx)));
          if ((lane & 1) == 0) { const int row = row0 + r; if (row < MP) outfp[(size_t)row * 8 + h] = lf; else outfs[(size_t)(row - MP) * 8 + h] = lf; } }
#pragma unroll
        for (int r = 0; r < 4; ++r) { unsigned long long* o8 = (unsigned long long*)(XN + (size_t)(row0 + r) * DM) + lane;
#pragma unroll
            for (int j = 0; j < 4; ++j) { const f32x4 y = v[r][j] * rstd[r] * gv[j];
                o8[64 * j] = (unsigned long long)pk2(y[0], y[1]) | ((unsigned long long)pk2(y[2], y[3]) << 32); } }
    }
    __syncthreads();
}

__device__ __forceinline__ void scan_phase(Frame& F, const Args& a, int l) {
    LAS float* sc = (LAS float*)F.lds;
    const float* lfp = a.out + O_FP + (size_t)l * MP * 8; const float* lfs = a.out + O_FS + (size_t)l * MS * 8;
    const float* clf = a.in[4] + (size_t)l * SB * PAST * 8;
    float* nbkp = (float*)(a.ws + WS_NBKP); float* nbks = (float*)(a.ws + WS_NBKS);
    for (int s = blockIdx.x; s < 192; s += F.G) {
        const bool samp = s >= 128; const int bh = samp ? s - 128 : s, b = bh >> 3, h = bh & 7;
        const int n = samp ? PAST + ST : SEQ;
        float v[8]; float run = 0.f;
#pragma unroll
        for (int j = 0; j < 8; ++j) { const int t = 8 * F.tid + j; float x = 0.f;
            if (t < n) x = samp ? (t < PAST ? clf[((size_t)b * PAST + t) * 8 + h] : lfs[((size_t)b * ST + (t - PAST)) * 8 + h]) : lfp[((size_t)b * SEQ + t) * 8 + h];
            run += x; v[j] = run; }
        float inc = run;
#pragma unroll
        for (int o = 1; o < 64; o <<= 1) { const int src = F.lane >= o ? F.lane - o : F.lane; const float y = __int_as_float(__builtin_amdgcn_ds_bpermute(src << 2, __float_as_int(inc))); if (F.lane >= o) inc += y; }
        if (F.lane == 63) sc[F.wave] = inc;
        __syncthreads();
        float base = inc - run;
        for (int w = 0; w < F.wave; ++w) base += sc[w];
        float* dst = samp ? nbks + (size_t)bh * NBKS : nbkp + (size_t)bh * SEQ;
        const int t0 = 8 * F.tid;
        if (t0 < n) {
            *(f32x4*)(dst + t0) = (f32x4){-(base + v[0]) * LOG2E, -(base + v[1]) * LOG2E, -(base + v[2]) * LOG2E, -(base + v[3]) * LOG2E};
            *(f32x4*)(dst + t0 + 4) = (f32x4){-(base + v[4]) * LOG2E, -(base + v[5]) * LOG2E, -(base + v[6]) * LOG2E, -(base + v[7]) * LOG2E};
        } else if (samp && t0 < NBKS) {
            *(f32x4*)(dst + t0) = (f32x4){0.f, 0.f, 0.f, 0.f}; *(f32x4*)(dst + t0 + 4) = (f32x4){0.f, 0.f, 0.f, 0.f};
        }
        __syncthreads();
    }
}

template <int W> __device__ __forceinline__ void pool_task(const Args& a, int l, int rt, int g, int lane) {
    const int fr = lane & 15, fq = lane >> 4;
    const bool samp = rt >= MP / 16;
    const int row = rt * 16 + fr;
    const int t = samp ? fr : (row & (SEQ - 1));
    const int b = samp ? (rt - MP / 16) : (row >> 12);
    const bf16* proj = (const bf16*)(a.ws + WS_PROJ);
    const bf16* pu = proj + (size_t)row * PP + C_PU + g * 64;
    const float* sp = a.in[5] + ((size_t)(l * SB + (samp ? b : 0)) * 15) * 256 + g * 64;
    const float inv = 1.0f / (float)(samp ? W : (t + 1 < W ? t + 1 : W));
    bf16x8 af[2];
    float* outp = samp ? a.out + O_PS + ((size_t)(l * SB + b) * 15) * 256 + g * 64 : a.out + O_PP + ((size_t)(l * NB + b) * 15) * 256 + g * 64;
#pragma unroll
    for (int kk = 0; kk < 2; ++kk) {
        const int ch = 32 * kk + 8 * fq;
        float s[8], u[8];
#pragma unroll
        for (int e = 0; e < 8; ++e) s[e] = 0.f;
        v4u xs[W];
#pragma unroll
        for (int j = 0; j < W; ++j) { const int jj = (t - j >= 0) ? j : 0; xs[j] = *(const v4u*)(pu - (size_t)jj * PP + ch); }
#pragma unroll
        for (int e = 0; e < 4; ++e) { u[2 * e] = bflo(xs[0][e]); u[2 * e + 1] = bfhi(xs[0][e]); }
#pragma unroll
        for (int j = 0; j < W; ++j) { const bool ok = (t - j >= 0);
#pragma unroll
            for (int e = 0; e < 4; ++e) { s[2 * e] += ok ? bflo(xs[j][e]) : 0.f; s[2 * e + 1] += ok ? bfhi(xs[j][e]) : 0.f; } }
        if (samp) {
#pragma unroll 1
            for (int j = 1; j < W; ++j) { const int tt = t - j;
                if (tt < 0) { const float* q = sp + (size_t)(15 + tt) * 256 + ch; const f32x4 x0 = *(const f32x4*)q, x1 = *(const f32x4*)(q + 4);
                    s[0] += x0[0]; s[1] += x0[1]; s[2] += x0[2]; s[3] += x0[3]; s[4] += x1[0]; s[5] += x1[1]; s[6] += x1[2]; s[7] += x1[3]; } }
        }
        v4u pk; pk.x = pk2(s[0] * inv - u[0], s[1] * inv - u[1]); pk.y = pk2(s[2] * inv - u[2], s[3] * inv - u[3]); pk.z = pk2(s[4] * inv - u[4], s[5] * inv - u[5]); pk.w = pk2(s[6] * inv - u[6], s[7] * inv - u[7]);
        af[kk] = __builtin_bit_cast(bf16x8, pk);
        const int orow = samp ? t - 1 : t - (SEQ - 15);
        if (orow >= 0) { float* q = outp + (size_t)orow * 256 + ch; *(f32x4*)q = (f32x4){u[0], u[1], u[2], u[3]}; *(f32x4*)(q + 4) = (f32x4){u[4], u[5], u[6], u[7]}; }
    }
    const bf16* pwt = (const bf16*)(a.ws + WS_PWT) + (size_t)(l * 4 + g) * 4096;
    f32x4 acc[4];
#pragma unroll
    for (int n = 0; n < 4; ++n) { acc[n] = (f32x4){0.f, 0.f, 0.f, 0.f};
#pragma unroll
        for (int kk = 0; kk < 2; ++kk) { const bf16x8 bfr = *(const bf16x8*)(pwt + (16 * n + fr) * 64 + 32 * kk + 8 * fq);
            acc[n] = __builtin_amdgcn_mfma_f32_16x16x32_bf16(bfr, af[kk], acc[n], 0, 0, 0); } }
    const float* psc = a.in[13] + l * 256 + g * 64;
    const bf16* pg = proj + (size_t)row * PP + C_PG + g * 64;
    bf16* mix = (bf16*)(a.ws + WS_XN) + (size_t)row * DM + g * 64;
#pragma unroll
    for (int n = 0; n < 4; ++n) { const int d = 16 * n + 4 * fq;
        const f32x4 sc = *(const f32x4*)(psc + d); const v2u gg = *(const v2u*)(pg + d);
        const float o0 = acc[n][0] * sc[0] * silu_f(bflo(gg.x)), o1 = acc[n][1] * sc[1] * silu_f(bfhi(gg.x)), o2 = acc[n][2] * sc[2] * silu_f(bflo(gg.y)), o3 = acc[n][3] * sc[3] * silu_f(bfhi(gg.y));
        v2u o; o.x = pk2(o0, o1); o.y = pk2(o2, o3); *(v2u*)(mix + d) = o; }
}

__device__ __forceinline__ void conv_item(const Args& a, int l, int rb, int tid) {
    const int chunk = tid & 31, run = tid >> 5, ch = chunk * 8;
    const bool samp = rb == MP / 128;
    const int row0 = rb * 128 + run * 8;
    const int t0 = samp ? (run & 1) * 8 : (row0 & (SEQ - 1));
    const int b = samp ? (run >> 1) : (row0 >> 12);
    const bf16* proj = (const bf16*)(a.ws + WS_PROJ);
    bf16* mix = (bf16*)(a.ws + WS_XN);
    float zm2[8], zm1[8], w0[8], w1[8], w2[8];
    { const float* cw = a.in[14] + (size_t)l * 3 * 256 + ch;
#pragma unroll
      for (int e = 0; e < 8; ++e) { w0[e] = cw[e]; w1[e] = cw[256 + e]; w2[e] = cw[512 + e]; } }
    if (t0 == 0) {
        if (samp) { const float* sc = a.in[6] + ((size_t)(l * SB + b) * 2) * 256 + ch;
#pragma unroll
            for (int e = 0; e < 8; ++e) { zm2[e] = sc[e]; zm1[e] = sc[256 + e]; } }
        else {
#pragma unroll
            for (int e = 0; e < 8; ++e) { zm2[e] = 0.f; zm1[e] = 0.f; } }
    } else {
        const bf16* p2 = proj + (size_t)(row0 - 2) * PP; const bf16* p1 = proj + (size_t)(row0 - 1) * PP;
        const v4u c2 = *(const v4u*)(p2 + C_CC + ch), x2 = *(const v4u*)(p2 + C_CX + ch), c1 = *(const v4u*)(p1 + C_CC + ch), x1 = *(const v4u*)(p1 + C_CX + ch);
#pragma unroll
        for (int e = 0; e < 4; ++e) { zm2[2 * e] = bflo(c2[e]) * bflo(x2[e]); zm2[2 * e + 1] = bfhi(c2[e]) * bfhi(x2[e]); zm1[2 * e] = bflo(c1[e]) * bflo(x1[e]); zm1[2 * e + 1] = bfhi(c1[e]) * bfhi(x1[e]); }
    }
    float* outc = samp ? a.out + O_CS + ((size_t)(l * SB + b) * 2) * 256 + ch : a.out + O_CP + ((size_t)(l * NB + b) * 2) * 256 + ch;
    const int tlast = samp ? ST - 2 : SEQ - 2;
#pragma unroll
    for (int i = 0; i < 8; ++i) {
        const bf16* p = proj + (size_t)(row0 + i) * PP;
        const v4u cb = *(const v4u*)(p + C_CB + ch), cc = *(const v4u*)(p + C_CC + ch), cx = *(const v4u*)(p + C_CX + ch), cgt = *(const v4u*)(p + C_CG + ch);
        float z[8], o[8];
#pragma unroll
        for (int e = 0; e < 4; ++e) { z[2 * e] = bflo(cc[e]) * bflo(cx[e]); z[2 * e + 1] = bfhi(cc[e]) * bfhi(cx[e]); }
#pragma unroll
        for (int e = 0; e < 8; ++e) { const float y = w0[e] * zm2[e] + w1[e] * zm1[e] + w2[e] * z[e]; o[e] = y; zm2[e] = zm1[e]; zm1[e] = z[e]; }
#pragma unroll
        for (int e = 0; e < 4; ++e) { o[2 * e] *= bflo(cb[e]) * silu_f(bflo(cgt[e])); o[2 * e + 1] *= bfhi(cb[e]) * silu_f(bfhi(cgt[e])); }
        v4u ov; ov.x = pk2(o[0], o[1]); ov.y = pk2(o[2], o[3]); ov.z = pk2(o[4], o[5]); ov.w = pk2(o[6], o[7]);
        *(v4u*)(mix + (size_t)(row0 + i) * DM + 768 + ch) = ov;
        const int t = t0 + i;
        if (t >= tlast) { float* q = outc + (size_t)(t - tlast) * 256; *(f32x4*)q = (f32x4){z[0], z[1], z[2], z[3]}; *(f32x4*)(q + 4) = (f32x4){z[4], z[5], z[6], z[7]}; }
    }
}

__device__ __forceinline__ void mixer_phase(Frame& F, const Args& a, int l) {
    for (int it = F.vcu; it < MP / 128 + 1; it += F.G) conv_item(a, l, it, F.tid);
    const int gw = F.vcu * NWAVES + F.wave, NGW = F.G * NWAVES;
    constexpr int NTASK = (MP / 16 + SB) * 4;
    constexpr int NTILE = MP / 16 + SB;
    for (int k = gw; k < NTASK; k += NGW) { const int rt = k % NTILE, g = 3 - k / NTILE;
        if (g == 0) pool_task<2>(a, l, rt, 0, F.lane); else if (g == 1) pool_task<4>(a, l, rt, 1, F.lane); else if (g == 2) pool_task<8>(a, l, rt, 2, F.lane); else pool_task<16>(a, l, rt, 3, F.lane); }
}

__device__ __forceinline__ void attention_phase(Frame& F, const Args& a, int l, char* lds) {
    using abf = attn_body::bf16;
    const abf* proj = (const abf*)(a.ws + WS_PROJ);
    abf* mix = (abf*)(a.ws + WS_XN);
    const float* nbkp = (const float*)(a.ws + WS_NBKP); const float* nbks = (const float*)(a.ws + WS_NBKS);
    for (int s = F.vcu; s < 256; s += F.G) {
#pragma unroll 1
        for (int i = 0; i < 9; ++i) {
            if (i == 8 && (s & 3) != 0) break;
            attn_body::AUnit U;
            if (i < 8) {
                const int bh = s >> 1, half = s & 1, b = bh >> 3, h = bh & 7;
                const int pr = i >> 1; int qb = (i & 1) ? 15 - 2 * pr : 2 * pr; if (half) qb = (i & 1) ? 14 - 2 * pr : 2 * pr + 1;
                const size_t r0 = (size_t)b * SEQ + (size_t)qb * 256;
                U.Q = proj + r0 * PP + C_Q + h * 64; U.K = proj + (size_t)b * SEQ * PP + C_K + h * 64; U.V = proj + (size_t)b * SEQ * PP + C_V + h * 64;
                U.nbk = nbkp + (size_t)bh * SEQ; U.O = mix + r0 * DM + 256 + h * 64; U.G = proj + r0 * PP + C_AG + h * 64;
                U.kp = PP; U.NT = 4 * qb + 4; U.qoff = qb * 256; U.nvalid = 256;
            } else {
                const int bh = s >> 2, b = bh >> 3, h = bh & 7;
                const size_t r0 = (size_t)MP + (size_t)b * ST;
                const size_t kb = ((size_t)(l * SB + b) * KSROWS) * 512 + h * 64;
                U.Q = proj + r0 * PP + C_Q + h * 64; U.K = (const abf*)(a.ws + WS_KS) + kb; U.V = (const abf*)(a.ws + WS_VS) + kb;
                U.nbk = nbks + (size_t)bh * NBKS; U.O = mix + r0 * DM + 256 + h * 64; U.G = proj + r0 * PP + C_AG + h * 64;
                U.kp = 512; U.NT = KSROWS / 64; U.qoff = PAST; U.nvalid = ST;
            }
            attn_body::attn_unit<8>(U, lds, F.wave0);
        }
    }
}

__global__ void __launch_bounds__(NWAVES * 64, 2) mega_fwd(Args args) {
    extern __shared__ __attribute__((aligned(16))) unsigned char lds[];
    cg::grid_group grid = cg::this_grid();
    Frame F;
    F.lds = (LAS unsigned char*)lds;
    F.wave0 = __builtin_amdgcn_readfirstlane((int)threadIdx.x >> 6); FRAME_REFRESH(F);
    F.G = gridDim.x; { const int bx = blockIdx.x; F.vcu = (F.G % 8 == 0) ? (bx % 8) * (F.G / 8) + bx / 8 : bx; }
    const int lo = args.ph_lo, hi = args.ph_hi;
#define IN(k) (lo <= (k) && (k) < hi)
#define SEAM(k) do { if (IN(k) && IN((k) + 1)) grid.sync(); } while (0)
    unsigned char* ws = args.ws;
    float* out = args.out;

    if (IN(0)) { for (int r_ = 0; r_ < REP_P0; ++r_) { p0_prologue(F, args); __syncthreads(); } for (int r_ = 0; r_ < REP_PA; ++r_) pa_phase(F, args, 0, args.in[0], args.in[1]); }
    SEAM(0);
#pragma unroll 1
    for (int l = 0; l < NL; ++l) {
        const int pb = 1 + 4 * l;
        if (IN(pb)) {
            FRAME_REFRESH(F);
            scan_phase(F, args, l);
            pg8::Gemm g{(const bf16*)(ws + WS_XN), (const bf16*)(ws + WS_WIN) + (size_t)l * PP * DM, MPAD, PP, DM};
            pg8::StaticOrder S; S.init(MPAD, PP, F.G, (int)blockIdx.x);
            pg8::EpiIn E;
            E.proj = (bf16*)(ws + WS_PROJ); E.ks = (bf16*)(ws + WS_KS) + (size_t)l * SB * KSROWS * 512; E.vs = (bf16*)(ws + WS_VS) + (size_t)l * SB * KSROWS * 512;
            E.outk_p = out + O_KP + (size_t)l * MP * 512; E.outv_p = out + O_VP + (size_t)l * MP * 512;
            E.outk_s = out + O_KS + (size_t)l * MS * 512; E.outv_s = out + O_VS + (size_t)l * MS * 512;
            E.qg = args.in[10] + l * 64; E.kg = args.in[11] + l * 64;
            for (int r_ = 0; r_ < REP_GIN; ++r_) pg8::gemm_phase<pg8::EpiIn, pg8::StaticOrder, true, true>(F.lds, g, S, E, F.tid);
        }
        SEAM(pb);
        if (IN(pb + 1)) {
            FRAME_REFRESH(F);
            for (int r_ = 0; r_ < REP_MIX; ++r_) mixer_phase(F, args, l);
            __syncthreads();
            for (int r_ = 0; r_ < REP_ATTN; ++r_) attention_phase(F, args, l, (char*)lds);
        }
        SEAM(pb + 1);
        if (IN(pb + 2)) {
            FRAME_REFRESH(F);
            pg8::Gemm g{(const bf16*)(ws + WS_XN), (const bf16*)(ws + WS_WOUT) + (size_t)l * DM * DM, MPAD, DM, DM};
            pg8::StaticOrder S; S.init(MPAD, DM, F.G, (int)blockIdx.x);
            pg8::EpiOut E;
            E.base_p = l == 0 ? args.in[0] : out + O_YP; E.base_s = l == 0 ? args.in[1] : out + O_YS; E.out_p = out + O_YP; E.out_s = out + O_YS;
            for (int r_ = 0; r_ < (l == 0 ? REP_GOUT0 : 1); ++r_) pg8::gemm_phase<pg8::EpiOut, pg8::StaticOrder, true, true>(F.lds, g, S, E, F.tid);
        }
        SEAM(pb + 2);
        if (l + 1 < NL) {
            if (IN(pb + 3)) { FRAME_REFRESH(F); for (int r_ = 0; r_ < REP_PA; ++r_) pa_phase(F, args, l + 1, out + O_YP, out + O_YS); }
            SEAM(pb + 3);
        }
    }
#undef IN
#undef SEAM
}

#ifndef MK_MULTI
#define MK_MULTI 0
#endif
constexpr int N_PHASES = 8;

extern "C" void kernel_launch(void* const* d_in, const int* in_sizes, int n_in, void* d_out, int out_size, void* d_ws, size_t ws_size, hipStream_t stream) {
    static int grid = 0;
    if (grid == 0) {
        if (n_in != 16 || (size_t)out_size != O_END || ws_size < WS_END) { fprintf(stderr, "kernel_launch: shape mismatch: n_in %d out %d (want %zu) ws %zu (want %zu)\n", n_in, out_size, (size_t)O_END, ws_size, (size_t)WS_END); grid = -1; return; }
        int dev = 0, cus = 0, per_cu = 0;
        if (hipGetDevice(&dev) != hipSuccess || hipDeviceGetAttribute(&cus, hipDeviceAttributeMultiprocessorCount, dev) != hipSuccess) { grid = -1; return; }
        if (hipFuncSetAttribute((const void*)mega_fwd, hipFuncAttributeMaxDynamicSharedMemorySize, LDS_BYTES) != hipSuccess) { fprintf(stderr, "kernel_launch: hipFuncSetAttribute failed\n"); grid = -1; return; }
        if (hipOccupancyMaxActiveBlocksPerMultiprocessor(&per_cu, (const void*)mega_fwd, NWAVES * 64, LDS_BYTES) != hipSuccess || per_cu < 1) { fprintf(stderr, "kernel_launch: occupancy query says %d\n", per_cu); per_cu = 1; }
        (void)hipGetLastError();
        grid = cus * 1;
    }
    if (grid < 0) return;
    Args a{};
    for (int i = 0; i < 16; ++i) a.in[i] = (const float*)d_in[i];
    a.out = (float*)d_out; a.ws = (unsigned char*)d_ws;
#if MK_MULTI
    for (int p = 0; p < N_PHASES; ++p) { a.ph_lo = p; a.ph_hi = p + 1; hipLaunchKernelGGL(mega_fwd, dim3(grid), dim3(NWAVES * 64), LDS_BYTES, stream, a); }
#else
    a.ph_lo = 0; a.ph_hi = N_PHASES;
    void* kargs[] = {&a};
    hipError_t e = hipLaunchCooperativeKernel((const void*)mega_fwd, dim3(grid), dim3(NWAVES * 64), kargs, LDS_BYTES, stream);
    if (e != hipSuccess) fprintf(stderr, "cooperative launch failed: %s (grid %d)\n", hipGetErrorString(e), grid);
#endif
}
```

```cpp
#include <hip/hip_runtime.h>
#include <hip/hip_cooperative_groups.h>
#include <hip/hip_bf16.h>
#include <cstdio>
#include <cstdint>
#include <cmath>
namespace pg8 {
#define PG8_LAS __attribute__((address_space(3)))
typedef unsigned short bf16_t;
typedef short bf16x8 __attribute__((ext_vector_type(8)));
typedef float f32x4 __attribute__((ext_vector_type(4)));
typedef unsigned u32x4 __attribute__((ext_vector_type(4)));
constexpr int BM = 256, BK = 64, HALF = 128, HTB = HALF * BK * 2  , STAGE_BYTES = 8 * HTB, NXCD = 8, WGM = 8;

__host__ __device__ __forceinline__ int lds_byte(int r, int c) { const int st = (r >> 4) * 2 + (c >> 5), rr = r & 15, cc = c & 31, ob = rr * 64 + cc * 2; return st * 1024 + (ob ^ (((ob >> 9) & 1) << 5)); }
__host__ __device__ __forceinline__ void stage_rc(int b, int& R, int& C) { const int st = b / 1024, sb = b % 1024, swz = sb ^ (((sb >> 9) & 1) << 5); R = (st >> 1) * 16 + swz / 64; C = (st & 1) * 32 + (swz % 64) / 2; }
__host__ __device__ __forceinline__ int perm32(int rho) { const int n = rho >> 4, i = rho & 15; return 8 * (i >> 2) + 4 * n + (i & 3); }

struct Unit { int pm, pn; };
struct Gemm { const bf16_t* A; const bf16_t* Bt; int M, N, K; };

struct StaticOrder {
    int nM, nN, nwg, G, c;
    __host__ __device__ void init(int M, int N, int G_, int c_) { nM = M / BM; nN = N / BM; nwg = nM * nN; G = G_; c = c_; }
    __host__ __device__ bool next(int i, Unit& u) const {
        const long L = (long)i * G + c; if (L >= nwg) return false;
        int wgid = (int)L; { const int q = nwg / NXCD, r = nwg % NXCD, xcd = wgid % NXCD, off = wgid / NXCD; wgid = (xcd < r ? xcd * (q + 1) : r * (q + 1) + (xcd - r) * q) + off; }
        const int nig = WGM * nN, gid = wgid / nig, fm = gid * WGM, gsz = (nM - fm) < WGM ? (nM - fm) : WGM;
        u.pm = fm + ((wgid % nig) % gsz); u.pn = (wgid % nig) / gsz;
        if (nN == 14) u.pn = (int)((0xD7CBA598362140ULL >> (4 * u.pn)) & 15ULL);
        return true;
    }
    __device__ __forceinline__ void a_ready(const Unit&) const {}
    __device__ __forceinline__ void done(const Unit&) const {}
};

__device__ __forceinline__ unsigned cvt_pk_bf16(float lo, float hi) { unsigned r; asm volatile("v_cvt_pk_bf16_f32 %0, %1, %2" : "=v"(r) : "v"(lo), "v"(hi)); return r; }
typedef float f32x2 __attribute__((ext_vector_type(2)));
constexpr int E_MP = 65536, E_PP = 3584, E_KSROWS = 2176, E_PAST = 2048;
constexpr float E_C2 = 0.125f * 1.4426950408889634f;
struct EpiIn {
    static constexpr bool PERM = true, AFTER_DRAIN = false;
    bf16_t* proj; bf16_t* ks; bf16_t* vs; float* outk_p; float* outv_p; float* outk_s; float* outv_s; const float* qg; const float* kg; int row0;
    __device__ __forceinline__ void operator()(const f32x4 (&acc)[2][2][4][2], const Unit& u, int wr, int wc, int fr, int fq) const {
        const int pn = u.pn; const bool samp = false;
        const int nai = samp ? 1 : 2;
        if (pn >= 2 && pn <= 5) {
            const bool isq = pn < 4; const int head = (pn & 1) * 4 + wc;
            const float* g = isq ? qg : kg;
            f32x4 gv[2][2];
#pragma unroll
            for (int bj = 0; bj < 2; ++bj)
#pragma unroll
                for (int n = 0; n < 2; ++n) gv[bj][n] = *(const f32x4*)(g + 32 * bj + 8 * fq + 4 * n);
#pragma unroll
            for (int ai = 0; ai < 2; ++ai) if (ai < nai)
#pragma unroll
                for (int m = 0; m < 4; ++m) {
                    const int row = row0 + u.pm * BM + ai * HALF + wr * 64 + m * 16 + fr;
                    float ss = 0.f;
#pragma unroll
                    for (int bj = 0; bj < 2; ++bj)
#pragma unroll
                        for (int n = 0; n < 2; ++n) { const f32x4 x = acc[ai][bj][m][n]; ss += (x[0] * x[0] + x[1] * x[1]) + (x[2] * x[2] + x[3] * x[3]); }
                    { const int ln = fr + 16 * fq; ss += __int_as_float(__builtin_amdgcn_ds_bpermute((ln ^ 16) << 2, __float_as_int(ss))); ss += __int_as_float(__builtin_amdgcn_ds_bpermute((ln ^ 32) << 2, __float_as_int(ss))); }
                    float rs = 1.0f / sqrtf(ss * (1.0f / 64.0f) + 1e-6f);
                    const float rq = rs * E_C2;
#pragma unroll
                    for (int bj = 0; bj < 2; ++bj) {
                        const f32x4 k0 = acc[ai][bj][m][0] * rs * gv[bj][0], k1 = acc[ai][bj][m][1] * rs * gv[bj][1];
                        const int col = head * 64 + 32 * bj + 8 * fq;
                        if (isq) { const f32x4 v0 = acc[ai][bj][m][0] * rq * gv[bj][0], v1 = acc[ai][bj][m][1] * rq * gv[bj][1];
                            u32x4 w; w.x = cvt_pk_bf16(v0[0], v0[1]); w.y = cvt_pk_bf16(v0[2], v0[3]); w.z = cvt_pk_bf16(v1[0], v1[1]); w.w = cvt_pk_bf16(v1[2], v1[3]);
                            *(u32x4*)(proj + (size_t)row * E_PP + 512 + col) = w; }
                        else { u32x4 w; w.x = cvt_pk_bf16(k0[0], k0[1]); w.y = cvt_pk_bf16(k0[2], k0[3]); w.z = cvt_pk_bf16(k1[0], k1[1]); w.w = cvt_pk_bf16(k1[2], k1[3]);
                            if (!samp) { *(u32x4*)(proj + (size_t)row * E_PP + 1024 + col) = w; float* o = outk_p + (size_t)row * 512 + col; __builtin_nontemporal_store(k0, (f32x4*)o); __builtin_nontemporal_store(k1, (f32x4*)(o + 4)); }
                            else { const int lr = row - E_MP, b = lr >> 4, t = lr & 15; *(u32x4*)(ks + ((size_t)b * E_KSROWS + E_PAST + t) * 512 + col) = w; float* o = outk_s + (size_t)lr * 512 + col; *(f32x4*)o = k0; *(f32x4*)(o + 4) = k1; } }
                    }
                }
        } else if (pn == 6 || pn == 7) {
#pragma unroll
            for (int ai = 0; ai < 2; ++ai) if (ai < nai)
#pragma unroll
                for (int m = 0; m < 4; ++m) {
                    const int row = row0 + u.pm * BM + ai * HALF + wr * 64 + m * 16 + fr;
#pragma unroll
                    for (int bj = 0; bj < 2; ++bj) {
                        const f32x4 v0 = acc[ai][bj][m][0], v1 = acc[ai][bj][m][1];
                        const int col = (pn - 6) * 256 + 128 * bj + 32 * wc + 8 * fq;
                        u32x4 w; w.x = cvt_pk_bf16(v0[0], v0[1]); w.y = cvt_pk_bf16(v0[2], v0[3]); w.z = cvt_pk_bf16(v1[0], v1[1]); w.w = cvt_pk_bf16(v1[2], v1[3]);
                        if (!samp) { *(u32x4*)(proj + (size_t)row * E_PP + 1536 + col) = w; float* o = outv_p + (size_t)row * 512 + col; __builtin_nontemporal_store(v0, (f32x4*)o); __builtin_nontemporal_store(v1, (f32x4*)(o + 4)); }
                        else { const int lr = row - E_MP, b = lr >> 4, t = lr & 15; *(u32x4*)(vs + ((size_t)b * E_KSROWS + E_PAST + t) * 512 + col) = w; float* o = outv_s + (size_t)lr * 512 + col; *(f32x4*)o = v0; *(f32x4*)(o + 4) = v1; }
                    }
                }
        } else {
#pragma unroll
            for (int ai = 0; ai < 2; ++ai) if (ai < nai)
#pragma unroll
                for (int m = 0; m < 4; ++m) {
                    bf16_t* rowp = proj + (size_t)(row0 + u.pm * BM + ai * HALF + wr * 64 + m * 16 + fr) * E_PP + pn * BM + wc * 32 + 8 * fq;
#pragma unroll
                    for (int bj = 0; bj < 2; ++bj) { const f32x4 v0 = acc[ai][bj][m][0], v1 = acc[ai][bj][m][1];
                        u32x4 w; w.x = cvt_pk_bf16(v0[0], v0[1]); w.y = cvt_pk_bf16(v0[2], v0[3]); w.z = cvt_pk_bf16(v1[0], v1[1]); w.w = cvt_pk_bf16(v1[2], v1[3]);
                        *(u32x4*)(rowp + bj * HALF) = w; }
                }
        }
    }
};
struct EpiOut {
    static constexpr bool PERM = false, AFTER_DRAIN = false;
    const float* base_p; const float* base_s; float* out_p; float* out_s; int row0;
    __device__ __forceinline__ void operator()(const f32x4 (&acc)[2][2][4][2], const Unit& u, int wr, int wc, int fr, int fq) const {
        const int col0 = u.pn * BM + wc * 32 + 4 * fq;
#pragma unroll
        for (int ai = 0; ai < 2; ++ai) {
            f32x4 pre[4][2][2];
            const size_t off0 = (size_t)(row0 + u.pm * BM + ai * HALF + wr * 64 + fr) * 1024 + col0;
#pragma unroll
            for (int m = 0; m < 4; ++m)
#pragma unroll
                for (int bj = 0; bj < 2; ++bj)
#pragma unroll
                    for (int n = 0; n < 2; ++n) pre[m][bj][n] = *(const f32x4*)(base_p + off0 + (size_t)m * 16 * 1024 + bj * HALF + n * 16);
            asm volatile("" ::: "memory");
#pragma unroll
            for (int m = 0; m < 4; ++m)
#pragma unroll
                for (int bj = 0; bj < 2; ++bj)
#pragma unroll
                    for (int n = 0; n < 2; ++n) *(f32x4*)(out_p + off0 + (size_t)m * 16 * 1024 + bj * HALF + n * 16) = pre[m][bj][n] + acc[ai][bj][m][n];
            asm volatile("" ::: "memory");
        }
    }
};

struct EpiOutB {
    static constexpr bool PERM = true, AFTER_DRAIN = false;
    const float* base_p; bf16_t* out_b; int row0;
    __device__ __forceinline__ void operator()(const f32x4 (&acc)[2][2][4][2], const Unit& u, int wr, int wc, int fr, int fq) const {
        const int col0 = u.pn * BM + wc * 32 + 8 * fq;
#pragma unroll
        for (int ai = 0; ai < 2; ++ai) {
            f32x4 pre[4][2][2];
            const size_t off0 = (size_t)(row0 + u.pm * BM + ai * HALF + wr * 64 + fr) * 1024 + col0;
#pragma unroll
            for (int m = 0; m < 4; ++m)
#pragma unroll
                for (int bj = 0; bj < 2; ++bj)
#pragma unroll
                    for (int n = 0; n < 2; ++n) pre[m][bj][n] = *(const f32x4*)(base_p + off0 + (size_t)m * 16 * 1024 + bj * HALF + n * 4);
            asm volatile("" ::: "memory");
#pragma unroll
            for (int m = 0; m < 4; ++m)
#pragma unroll
                for (int bj = 0; bj < 2; ++bj) { const f32x4 v0 = pre[m][bj][0] + acc[ai][bj][m][0], v1 = pre[m][bj][1] + acc[ai][bj][m][1];
                    u32x4 w; w.x = cvt_pk_bf16(v0[0], v0[1]); w.y = cvt_pk_bf16(v0[2], v0[3]); w.z = cvt_pk_bf16(v1[0], v1[1]); w.w = cvt_pk_bf16(v1[2], v1[3]);
                    *(u32x4*)(out_b + off0 + (size_t)m * 16 * 1024 + bj * HALF) = w; }
            asm volatile("" ::: "memory");
        }
    }
};
struct EpiOutF {
    static constexpr bool PERM = true, AFTER_DRAIN = false;
    const bf16_t* base_b; float* out_p; int row0;
    __device__ __forceinline__ void operator()(const f32x4 (&acc)[2][2][4][2], const Unit& u, int wr, int wc, int fr, int fq) const {
        const int col0 = u.pn * BM + wc * 32 + 8 * fq;
#pragma unroll
        for (int ai = 0; ai < 2; ++ai) {
            u32x4 pre[4][2];
            const size_t off0 = (size_t)(row0 + u.pm * BM + ai * HALF + wr * 64 + fr) * 1024 + col0;
#pragma unroll
            for (int m = 0; m < 4; ++m)
#pragma unroll
                for (int bj = 0; bj < 2; ++bj) pre[m][bj] = *(const u32x4*)(base_b + off0 + (size_t)m * 16 * 1024 + bj * HALF);
            asm volatile("" ::: "memory");
#pragma unroll
            for (int m = 0; m < 4; ++m)
#pragma unroll
                for (int bj = 0; bj < 2; ++bj) { const u32x4 p = pre[m][bj];
                    const f32x4 b0 = (f32x4){__uint_as_float(p.x << 16), __uint_as_float(p.x & 0xffff0000u), __uint_as_float(p.y << 16), __uint_as_float(p.y & 0xffff0000u)};
                    const f32x4 b1 = (f32x4){__uint_as_float(p.z << 16), __uint_as_float(p.z & 0xffff0000u), __uint_as_float(p.w << 16), __uint_as_float(p.w & 0xffff0000u)};
                    float* o = out_p + off0 + (size_t)m * 16 * 1024 + bj * HALF;
                    *(f32x4*)o = b0 + acc[ai][bj][m][0]; *(f32x4*)(o + 4) = b1 + acc[ai][bj][m][1]; }
            asm volatile("" ::: "memory");
        }
    }
};
template <class Epi, class Sched, bool ALIGN_EPI = false, bool SP2 = false>
__device__ __forceinline__ void gemm_phase(PG8_LAS unsigned char* lds, const Gemm g, const Sched& S, const Epi& E, int tid_in) {
    int tid_ = tid_in; asm volatile("" : "+v"(tid_));
    const int tid = tid_, wid = __builtin_amdgcn_readfirstlane(tid >> 6), lane = tid & 63, wr = wid >> 2, wc = wid & 3, fr = lane & 15, fq = lane >> 4;
    const int K = g.K, nt = K / BK;
    unsigned voffA[2], voffB[2];
#pragma unroll
    for (int i = 0; i < 2; ++i) { int R, C; stage_rc(tid * 16 + i * 8192, R, C); const int Rb = Epi::PERM ? ((R & ~31) + perm32(R & 31)) : R;
        voffA[i] = (unsigned)(R * K + C) * 2u; voffB[i] = (unsigned)(Rb * K + C) * 2u; }
    const size_t kstep = (size_t)(BK * 2);
    const size_t hstep = (size_t)HALF * K * 2;
    const size_t tstep = 2 * hstep;
    const unsigned ldsw = (unsigned)wid * 1024u;
    const int aoff = lds_byte(wr * 64 + fr, fq * 8), boff = lds_byte(wc * 32 + fr, fq * 8);
#define PG8_SA(b, h) (((b) * 2 + (h)) * HTB)
#define PG8_SB(b, h) ((4 + (b) * 2 + (h)) * HTB)
#define PG8_STAGE(bufoff, gbase, voff) do { _Pragma("unroll") for (int _i = 0; _i < 2; ++_i) \
        __builtin_amdgcn_global_load_lds((const unsigned*)((const char*)(gbase) + (voff)[_i]), (PG8_LAS unsigned*)(lds + (bufoff) + ldsw + _i * 8192), 16, 0, 0); } while (0)
#define PG8_LDA(dst, b, h) do { _Pragma("unroll") for (int m = 0; m < 4; ++m) _Pragma("unroll") for (int k = 0; k < 2; ++k) dst[m][k] = *(const PG8_LAS bf16x8*)(lds + PG8_SA(b, h) + aoff + m * 2048 + k * 1024); } while (0)
#define PG8_LDB(dst, b, h) do { _Pragma("unroll") for (int n = 0; n < 2; ++n) _Pragma("unroll") for (int k = 0; k < 2; ++k) dst[n][k] = *(const PG8_LAS bf16x8*)(lds + PG8_SB(b, h) + boff + n * 2048 + k * 1024); } while (0)
#define PG8_MMA(ai, bj, At, Bt) do { __builtin_amdgcn_s_setprio(1); _Pragma("unroll") for (int m = 0; m < 4; ++m) _Pragma("unroll") for (int n = 0; n < 2; ++n) _Pragma("unroll") for (int k = 0; k < 2; ++k) \
        acc[ai][bj][m][n] = __builtin_amdgcn_mfma_f32_16x16x32_bf16(Bt[n][k], At[m][k], acc[ai][bj][m][n], 0, 0, 0); __builtin_amdgcn_s_setprio(0); } while (0)
#define PG8_WAIT_V(n) asm volatile("s_waitcnt vmcnt(" #n ")" ::: "memory")
#define PG8_WAIT_L(n) asm volatile("s_waitcnt lgkmcnt(" #n ")" ::: "memory")
#define PG8_BAR __builtin_amdgcn_s_barrier()
#define PG8_SCHED __builtin_amdgcn_sched_barrier(0)
    Unit cur, nxt; int ui = 0;
    if (!S.next(0, cur)) return;
    f32x4 acc[2][2][4][2];
#pragma unroll
    for (int a = 0; a < 2; ++a)
#pragma unroll
        for (int b = 0; b < 2; ++b)
#pragma unroll
            for (int m = 0; m < 4; ++m)
#pragma unroll
                for (int n = 0; n < 2; ++n) acc[a][b][m][n] = (f32x4){0.f, 0.f, 0.f, 0.f};
    bf16x8 At[4][2], B0[2][2], B1[2][2];
    const char* cA = (const char*)g.A + (size_t)cur.pm * tstep; const char* cB = (const char*)g.Bt + (size_t)cur.pn * tstep;
    S.a_ready(cur);
    if constexpr (SP2) {
        PG8_STAGE(PG8_SB(0, 0), cB, voffB); PG8_STAGE(PG8_SB(0, 1), cB + hstep, voffB); PG8_STAGE(PG8_SA(0, 0), cA, voffA); PG8_STAGE(PG8_SA(0, 1), cA + hstep, voffA);
        if (wr == 1) PG8_BAR;
        PG8_WAIT_V(2); PG8_BAR;
        PG8_STAGE(PG8_SB(1, 0), cB + kstep, voffB); PG8_STAGE(PG8_SA(1, 0), cA + kstep, voffA); PG8_STAGE(PG8_SB(1, 1), cB + hstep + kstep, voffB);
        PG8_WAIT_V(6); PG8_BAR;
    } else {
        PG8_STAGE(PG8_SB(0, 0), cB, voffB); PG8_STAGE(PG8_SA(0, 0), cA, voffA); PG8_STAGE(PG8_SB(0, 1), cB + hstep, voffB); PG8_STAGE(PG8_SA(0, 1), cA + hstep, voffA);
        if (wr == 1) PG8_BAR;
        PG8_WAIT_V(4); PG8_BAR;
        PG8_STAGE(PG8_SB(1, 0), cB + kstep, voffB); PG8_STAGE(PG8_SA(1, 0), cA + kstep, voffA); PG8_STAGE(PG8_SB(1, 1), cB + hstep + kstep, voffB);
        PG8_WAIT_V(6); PG8_BAR;
    }
    for (;;) {
        const bool has_next = S.next(ui + 1, nxt);
        const char* nA = has_next ? (const char*)g.A + (size_t)nxt.pm * tstep : cA; const char* nB = has_next ? (const char*)g.Bt + (size_t)nxt.pn * tstep : cB;
        for (int t = 0; t < nt; t += 2) {
            const bool last = (t == nt - 2);
            const char* a1 = cA + (size_t)(t + 1) * kstep;
            const char* a2 = last ? nA : cA + (size_t)(t + 2) * kstep; const char* b2 = last ? nB : cB + (size_t)(t + 2) * kstep;
            const char* a3 = a2 + kstep; const char* b3 = b2 + kstep;
            if (last && has_next) S.a_ready(nxt);
            if constexpr (SP2) {
            PG8_LDB(B0, 0, 0); PG8_LDB(B1, 0, 1); PG8_SCHED; PG8_LDA(At, 0, 0); PG8_STAGE(PG8_SA(1, 1), a1 + hstep, voffA);
            PG8_WAIT_V(8); PG8_WAIT_L(0); PG8_BAR; PG8_MMA(0, 0, At, B0); PG8_MMA(0, 1, At, B1); PG8_BAR; PG8_SCHED;
            PG8_LDA(At, 0, 1); PG8_STAGE(PG8_SB(0, 0), b2, voffB); PG8_STAGE(PG8_SB(0, 1), b2 + hstep, voffB); PG8_STAGE(PG8_SA(0, 0), a2, voffA);
            PG8_WAIT_V(8); PG8_WAIT_L(0); PG8_BAR; PG8_MMA(1, 0, At, B0); PG8_MMA(1, 1, At, B1); PG8_BAR; PG8_SCHED;
            PG8_LDB(B0, 1, 0); PG8_LDB(B1, 1, 1); PG8_SCHED; PG8_LDA(At, 1, 0); PG8_STAGE(PG8_SA(0, 1), a2 + hstep, voffA);
            PG8_WAIT_V(8); PG8_WAIT_L(0); PG8_BAR; PG8_MMA(0, 0, At, B0); PG8_MMA(0, 1, At, B1); PG8_BAR; PG8_SCHED;
            PG8_LDA(At, 1, 1); PG8_STAGE(PG8_SB(1, 0), b3, voffB); PG8_STAGE(PG8_SB(1, 1), b3 + hstep, voffB); PG8_STAGE(PG8_SA(1, 0), a3, voffA);
            PG8_WAIT_V(8); PG8_WAIT_L(0); PG8_BAR; PG8_MMA(1, 0, At, B0); PG8_MMA(1, 1, At, B1); PG8_BAR; PG8_SCHED;
            } else {
            PG8_LDB(B0, 0, 0); PG8_SCHED; PG8_LDA(At, 0, 0); PG8_STAGE(PG8_SA(1, 1), a1 + hstep, voffA);
            PG8_WAIT_L(8); PG8_BAR; PG8_WAIT_L(0); PG8_MMA(0, 0, At, B0); PG8_BAR; PG8_SCHED;
            PG8_LDB(B1, 0, 1); PG8_STAGE(PG8_SB(0, 0), b2, voffB);
            PG8_BAR; PG8_WAIT_L(0); PG8_MMA(0, 1, At, B1); PG8_BAR;
            PG8_LDA(At, 0, 1); PG8_STAGE(PG8_SA(0, 0), a2, voffA);
            PG8_BAR; PG8_WAIT_L(0); PG8_MMA(1, 0, At, B0); PG8_BAR; PG8_SCHED;
            PG8_STAGE(PG8_SB(0, 1), b2 + hstep, voffB);
            PG8_WAIT_V(6); PG8_BAR; PG8_MMA(1, 1, At, B1); PG8_BAR;
            PG8_LDB(B0, 1, 0); PG8_SCHED; PG8_LDA(At, 1, 0); PG8_STAGE(PG8_SA(0, 1), a2 + hstep, voffA);
            PG8_WAIT_L(8); PG8_BAR; PG8_WAIT_L(0); PG8_MMA(0, 0, At, B0); PG8_BAR; PG8_SCHED;
            PG8_LDB(B1, 1, 1); PG8_STAGE(PG8_SB(1, 0), b3, voffB);
            PG8_BAR; PG8_WAIT_L(0); PG8_MMA(0, 1, At, B1); PG8_BAR;
            PG8_LDA(At, 1, 1); PG8_STAGE(PG8_SA(1, 0), a3, voffA);
            PG8_BAR; PG8_WAIT_L(0); PG8_MMA(1, 0, At, B0); PG8_BAR; PG8_SCHED;
            PG8_STAGE(PG8_SB(1, 1), b3 + hstep, voffB);
            PG8_WAIT_V(6); PG8_BAR; PG8_MMA(1, 1, At, B1); PG8_BAR;
            }
        }
        if constexpr (ALIGN_EPI) { if (wr == 0) PG8_BAR; }
        if constexpr (!Epi::AFTER_DRAIN) { E(acc, cur, wr, wc, fr, fq); S.done(cur); }
        if (!has_next) break;
#pragma unroll
        for (int a = 0; a < 2; ++a)
#pragma unroll
            for (int b = 0; b < 2; ++b)
#pragma unroll
                for (int m = 0; m < 4; ++m)
#pragma unroll
                    for (int n = 0; n < 2; ++n) acc[a][b][m][n] = (f32x4){0.f, 0.f, 0.f, 0.f};
        cur = nxt; cA = nA; cB = nB; ++ui;
        if constexpr (ALIGN_EPI) { if (wr == 1) PG8_BAR; }
    }
    PG8_WAIT_V(0);
    if constexpr (!ALIGN_EPI) { if (wr == 0) PG8_BAR; }
    PG8_BAR;
    if constexpr (Epi::AFTER_DRAIN) { E.fused(acc, cur, wr, wc, fr, fq, lds, wid, lane); S.done(cur); }
#undef PG8_SA
#undef PG8_SB
#undef PG8_STAGE
#undef PG8_LDA
#undef PG8_LDB
#undef PG8_MMA
#undef PG8_WAIT_V
#undef PG8_WAIT_L
#undef PG8_BAR
#undef PG8_SCHED
}
}
namespace attn_body {
using bf16=__hip_bfloat16;
using bf16x8=__attribute__((ext_vector_type(8)))short;
using s16x4=__attribute__((ext_vector_type(4)))short;
using f32x16=__attribute__((ext_vector_type(16)))float;
using f32x4a=__attribute__((ext_vector_type(4)))float;
using u32x4=__attribute__((ext_vector_type(4)))unsigned;
constexpr int D=64;
constexpr int NW=8,QBLK=32,QB=QBLK*NW,KVBLK=64;
constexpr int QP=3584, OP=1024, GP=3584;
__device__ __forceinline__ int crow(int r,int hi){return (r&3)+8*(r>>2)+4*hi;}
#define SBAR() __builtin_amdgcn_sched_barrier(0)
__device__ __forceinline__ void cmask(f32x16&p0,f32x16&p1,int koff,int qrel,int hi){
  const float NEG=-INFINITY; int kb=koff+4*hi;
  #pragma unroll
  for(int r=0;r<16;++r){int kv=kb+(r&3)+8*(r>>2); if(kv>qrel)p0[r]=NEG; if(kv+32>qrel)p1[r]=NEG;}
}
constexpr int NSLOT=3, SLOTB=8192;
constexpr int LDS_K=0, LDS_V=NSLOT*SLOTB, LDS_WS=2*NSLOT*SLOTB, LDS_OST=LDS_WS+NW*64*4, LDS_BIAS=LDS_OST+NW*4096, LDS_BYTES=LDS_BIAS+NW*NSLOT*256;
constexpr float C2=0.125f*1.4426950408889634f;
__device__ __forceinline__ void glds16(const void*gsrc,unsigned lds_dst){unsigned keep;
  asm volatile("s_mov_b32 %0, m0\n\ts_mov_b32 m0, %2\n\ts_nop 0\n\tglobal_load_lds_dwordx4 %1, off\n\ts_mov_b32 m0, %0":"=&s"(keep):"v"(gsrc),"s"(lds_dst):"memory");}
__device__ __forceinline__ void glds4(const void*gsrc,unsigned lds_dst){unsigned keep;
  asm volatile("s_mov_b32 %0, m0\n\ts_mov_b32 m0, %2\n\ts_nop 0\n\tglobal_load_lds_dword %1, off\n\ts_mov_b32 m0, %0":"=&s"(keep):"v"(gsrc),"s"(lds_dst):"memory");}
typedef float f32x2_t __attribute__((ext_vector_type(2))); typedef __bf16 bf16x2_t __attribute__((ext_vector_type(2)));
__device__ __forceinline__ unsigned cvtpk_s(float lo,float hi){f32x2_t v={lo,hi};bf16x2_t b=__builtin_convertvector(v,bf16x2_t);return __builtin_bit_cast(unsigned,b);}
#define WAIT_BAR(N) asm volatile("s_waitcnt vmcnt(" #N ") lgkmcnt(0)\n\ts_barrier":::"memory")
typedef __attribute__((address_space(3))) const char* lds_cptr;
typedef short v4i16_t __attribute__((ext_vector_type(4)));
#define LDSV(T,p) (*(const __attribute__((address_space(3))) T*)(p))
__device__ __forceinline__ void kload8(bf16x8*kf,lds_cptr kp){
  kf[0]=LDSV(bf16x8,kp);      kf[1]=LDSV(bf16x8,kp+512);
  kf[2]=LDSV(bf16x8,kp+2048); kf[3]=LDSV(bf16x8,kp+2560);
  kf[4]=LDSV(bf16x8,kp+4096); kf[5]=LDSV(bf16x8,kp+4608);
  kf[6]=LDSV(bf16x8,kp+6144); kf[7]=LDSV(bf16x8,kp+6656);
}
__device__ __forceinline__ void kload2(bf16x8*kf,lds_cptr kp,int j){ kf[2*j]=LDSV(bf16x8,kp+j*2048); kf[2*j+1]=LDSV(bf16x8,kp+j*2048+512); }
__device__ __forceinline__ s16x4 vtr(lds_cptr p){ return __builtin_bit_cast(s16x4,__builtin_amdgcn_ds_read_tr16_b64_v4i16((__attribute__((address_space(3))) v4i16_t*)p)); }
#define MX3(a,b,c) __builtin_fmaxf(__builtin_fmaxf((a),(b)),(c))
__device__ __forceinline__ float rowmax(const f32x16&p0,const f32x16&p1){
  float a=MX3(p0[0],p0[1],p1[0]),b=MX3(p0[2],p0[3],p1[1]);a=MX3(a,p1[2],p1[3]);
  #pragma unroll
  for(int r=4;r<16;r+=4){a=MX3(a,p0[r],p0[r+1]);b=MX3(b,p0[r+2],p0[r+3]);a=MX3(a,p1[r],p1[r+1]);b=MX3(b,p1[r+2],p1[r+3]);}
  float m=__builtin_fmaxf(a,b);
  auto rr=__builtin_amdgcn_permlane32_swap(__float_as_uint(m),__float_as_uint(m),false,false);
  return __builtin_fmaxf(__uint_as_float(rr[0]),__uint_as_float(rr[1]));
}
__device__ __forceinline__ void pv(f32x16*o,int vb,bf16x8 pa0,bf16x8 pa1,bf16x8 pa2,bf16x8 pa3){
  #pragma unroll
  for(int d0=0;d0<2;++d0){s16x4 lo[4],hi[4];
    #pragma unroll
    for(int ks=0;ks<4;++ks){
      asm volatile("ds_read_b64_tr_b16 %0,%1 offset:%c2":"=&v"(lo[ks]):"v"(vb),"i"(d0*4096+ks*1024):"memory");
      asm volatile("ds_read_b64_tr_b16 %0,%1 offset:%c2":"=&v"(hi[ks]):"v"(vb),"i"(d0*4096+ks*1024+512):"memory");}
    asm volatile("s_waitcnt lgkmcnt(0)":::"memory");SBAR();
    #define PK(k) (bf16x8){lo[k][0],lo[k][1],lo[k][2],lo[k][3],hi[k][0],hi[k][1],hi[k][2],hi[k][3]}
    o[d0]=__builtin_amdgcn_mfma_f32_32x32x16_bf16(pa0,PK(0),o[d0],0,0,0);
    o[d0]=__builtin_amdgcn_mfma_f32_32x32x16_bf16(pa1,PK(1),o[d0],0,0,0);
    o[d0]=__builtin_amdgcn_mfma_f32_32x32x16_bf16(pa2,PK(2),o[d0],0,0,0);
    o[d0]=__builtin_amdgcn_mfma_f32_32x32x16_bf16(pa3,PK(3),o[d0],0,0,0);
    #undef PK
  }
}
struct AUnit {
  const bf16* Q;
  const bf16* K;
  const bf16* V;
  const float* nbk;
  bf16* O;
  const bf16* G;
  int kp;
  int NT, qoff, nvalid;
};
#define FLOORZ_LDS_OFF (131072+1040)
template<int THRL> __device__ __forceinline__ void attn_unit(const AUnit&U,char*shm,int wave0){
  int l__; asm volatile("v_mbcnt_lo_u32_b32 %0, -1, 0\n\tv_mbcnt_hi_u32_b32 %0, -1, %0":"=v"(l__)); int tid_=wave0*64+l__; const int tid=tid_,lane=tid&63,r32=lane&31,hi=lane>>5; const int wid=__builtin_amdgcn_readfirstlane(tid>>6);
  const int KP=U.kp;
  const bf16*Qw=U.Q+(long)(wid*QBLK)*QP;
  const bf16*Kh=U.K,*Vh=U.V;
  const unsigned lds0=(unsigned)(uintptr_t)shm;
  float*wsf=(float*)(shm+LDS_WS)+wid*64;
  const bf16*ksrc=Kh+(long)lane*KP+wid*8;
  const bf16*vsrc=Vh+(long)(16*(wid&3)+(lane>>2))*KP+(wid>>2)*32+(lane&3)*8;
  const float*bsrc=U.nbk+lane;
  const unsigned kdst=lds0+LDS_K+wid*1024, vdst=lds0+LDS_V+wid*1024, bdst=lds0+LDS_BIAS+wid*(NSLOT*256);
  #define DMA_K(t,slot) do{ glds16(ksrc+(long)(t)*KVBLK*KP,(unsigned)__builtin_amdgcn_readfirstlane(kdst+(slot))); glds4(bsrc+(t)*KVBLK,(unsigned)__builtin_amdgcn_readfirstlane(bdst+((slot)>>5))); }while(0)
  #define DMA_V(t,slot) glds16(vsrc+(long)(t)*KVBLK*KP,(unsigned)__builtin_amdgcn_readfirstlane(vdst+(slot)))
  bf16x8 kf[8];
  const lds_cptr shm3=(lds_cptr)shm; const lds_cptr kp0=shm3+LDS_K+hi*1024+r32*16; const lds_cptr vp0=shm3+LDS_V+((lane>>4)&1)*32+(lane&3)*8+(4*hi+((lane&15)>>2))*64;
  const lds_cptr bp0=shm3+LDS_BIAS+wid*(NSLOT*256)+hi*16;
  const int NT=U.NT;
  DMA_K(0,0);DMA_V(0,0);DMA_K(1,SLOTB);
  bf16x8 qr[4];
  #pragma unroll
  for(int d0=0;d0<4;++d0)qr[d0]=*reinterpret_cast<const bf16x8*>(&Qw[(long)r32*QP+d0*16+hi*8]);
  const int qrel=wid*QBLK+r32;
  const float bq=-U.nbk[U.qoff+qrel];
  float nm=0.f,l_reg=0.f;f32x16 o[2];o[0]=f32x16{};o[1]=f32x16{};
  const int qoff=U.qoff;
  #define CMASK(P0,P1,t) do{ if((t)>=NT-4)cmask(P0,P1,64*(t)-qoff,qrel,hi);}while(0)
  #define BLD1(P0,P1,bp,g) do{ const f32x4a a_=LDSV(f32x4a,(bp)+(g)*32); const f32x4a b_=LDSV(f32x4a,(bp)+128+(g)*32); \
      P0[4*(g)]=a_[0];P0[4*(g)+1]=a_[1];P0[4*(g)+2]=a_[2];P0[4*(g)+3]=a_[3]; P1[4*(g)]=b_[0];P1[4*(g)+1]=b_[1];P1[4*(g)+2]=b_[2];P1[4*(g)+3]=b_[3]; }while(0)
  bool resc=false;
  #define RESC() do{ if(resc){ asm volatile("s_waitcnt lgkmcnt(0)":::"memory"); \
      _Pragma("unroll") for(int d_=0;d_<2;++d_) _Pragma("unroll") for(int r=0;r<16;++r)o[d_][r]*=wsf[crow(r,hi)]; } }while(0)
  f32x16 pA0,pA1,pB0,pB1;
  int sl_prev=0,sl_cur=0,sl_next=SLOTB;
  #define ROT() do{sl_prev=sl_cur;sl_cur=sl_next;sl_next=(sl_next==(NSLOT-1)*SLOTB)?0:sl_next+SLOTB;}while(0)
  DMA_K(2,2*SLOTB);
  WAIT_BAR(5);
  { BLD1(pA0,pA1,bp0,0);BLD1(pA0,pA1,bp0,1);BLD1(pA0,pA1,bp0,2);BLD1(pA0,pA1,bp0,3);
    #pragma unroll
    for(int d0=0;d0<4;++d0){
      const bf16x8 b0=LDSV(bf16x8,kp0+d0*2048);
      const bf16x8 b1=LDSV(bf16x8,kp0+d0*2048+512);
      pA0=__builtin_amdgcn_mfma_f32_32x32x16_bf16(b0,qr[d0],pA0,0,0,0);pA1=__builtin_amdgcn_mfma_f32_32x32x16_bf16(b1,qr[d0],pA1,0,0,0);}
  }
  CMASK(pA0,pA1,0);
  { const float rm=rowmax(pA0,pA1); const float z=rm+bq; const float mh=__builtin_fmaxf(z,*(const float*)(shm+FLOORZ_LDS_OFF)); nm=bq-mh;
    _Pragma("unroll") for(int r=0;r<16;++r){pA0[r]=__builtin_amdgcn_exp2f(pA0[r]+nm);pA1[r]=__builtin_amdgcn_exp2f(pA1[r]+nm);} }
  WAIT_BAR(0);
  DMA_K(3,0);DMA_V(1,SLOTB);
  ROT();
  kload8(kf,kp0+sl_cur);
  { const lds_cptr bp_=bp0+(sl_cur>>5); BLD1(pB0,pB1,bp_,0);BLD1(pB0,pB1,bp_,1);BLD1(pB0,pB1,bp_,2);BLD1(pB0,pB1,bp_,3); }
  WAIT_BAR(3);
  s16x4 vlo[8],vhi[8]; u32x4 pw0,pw1,pw2,pw3;
  #define PKW(P,B) cvtpk_s(P[B],P[B+1])
  #define PAF(k) __builtin_bit_cast(bf16x8,pw##k)
  #define VFR(i) (bf16x8){vlo[i][0],vlo[i][1],vlo[i][2],vlo[i][3],vhi[i][0],vhi[i][1],vhi[i][2],vhi[i][3]}
  #define PIN(x) asm volatile("":"+v"(x))
  #define GAPA(MF,A0,A1,A2,A3,W0,W1,PW) do{ MF; sacc+=A0; sacc+=A1; sacc+=A2; sacc+=A3; PIN(sacc); W0; W1; PIN(PW); SBAR(); }while(0)
  #define EX(v) __builtin_amdgcn_exp2f((v)+nm)
  #define GAPB(MF,X,B) do{ MF; X[B]=EX(X[B]); X[B+1]=EX(X[B+1]); X[B+2]=EX(X[B+2]); X[B+3]=EX(X[B+3]); PIN(X); SBAR(); }while(0)
  #define VRD(i) do{ vlo[i]=vtr(vp_+(((i)>>2)*4096+((i)&3)*1024)); vhi[i]=vtr(vp_+(((i)>>2)*4096+((i)&3)*1024+512)); }while(0)
  #define KRD(G,j) do{ if(G){ kload2(kf,kp0+sl_next,j); SBAR(); } }while(0)
  #define BRD(G,P0,P1,g) do{ if(G){ BLD1(P0,P1,bpn_,g); SBAR(); } }while(0)
  #define STEP(C0,C1,P0,P1,t,GK,GV,GL) do{ SBAR(); \
    const lds_cptr vp_=vp0+sl_prev; const lds_cptr bpn_=bp0+(sl_next>>5); \
    VRD(0); SBAR(); float sacc=(P0[0]+P0[1]); \
    GAPA(C0=__builtin_amdgcn_mfma_f32_32x32x16_bf16(kf[0],qr[0],C0,0,0,0), P0[2],P0[3],P0[4],P0[5],     pw0[0]=PKW(P0,0), pw0[1]=PKW(P0,2), pw0); \
    VRD(4); SBAR(); GAPA(C1=__builtin_amdgcn_mfma_f32_32x32x16_bf16(kf[1],qr[0],C1,0,0,0), P0[6],P0[7],P0[8],P0[9],     pw0[2]=PKW(P0,4), pw0[3]=PKW(P0,6), pw0); \
    VRD(1); SBAR(); GAPA(C0=__builtin_amdgcn_mfma_f32_32x32x16_bf16(kf[2],qr[1],C0,0,0,0),   P0[10],P0[11],P0[12],P0[13], pw1[0]=PKW(P0,8), pw1[1]=PKW(P0,10), pw1); \
    VRD(5); SBAR(); GAPA(C1=__builtin_amdgcn_mfma_f32_32x32x16_bf16(kf[3],qr[1],C1,0,0,0),   P0[14],P0[15],P1[0],P1[1],   pw1[2]=PKW(P0,12),pw1[3]=PKW(P0,14), pw1); \
    VRD(2); SBAR(); GAPA(C0=__builtin_amdgcn_mfma_f32_32x32x16_bf16(kf[4],qr[2],C0,0,0,0),   P1[2],P1[3],P1[4],P1[5],     pw2[0]=PKW(P1,0), pw2[1]=PKW(P1,2), pw2); \
    VRD(6); SBAR(); GAPA(C1=__builtin_amdgcn_mfma_f32_32x32x16_bf16(kf[5],qr[2],C1,0,0,0),   P1[6],P1[7],P1[8],P1[9],     pw2[2]=PKW(P1,4), pw2[3]=PKW(P1,6), pw2); \
    VRD(3); SBAR(); GAPA(C0=__builtin_amdgcn_mfma_f32_32x32x16_bf16(kf[6],qr[3],C0,0,0,0),   P1[10],P1[11],P1[12],P1[13], pw3[0]=PKW(P1,8), pw3[1]=PKW(P1,10), pw3); \
    VRD(7); SBAR(); GAPA(C1=__builtin_amdgcn_mfma_f32_32x32x16_bf16(kf[7],qr[3],C1,0,0,0),   P1[14],P1[15],0.f,0.f,       pw3[2]=PKW(P1,12),pw3[3]=PKW(P1,14), pw3); \
    l_reg+=sacc; \
    if(GK){DMA_K((t)+3,sl_cur);} if(GV){DMA_V((t)+1,sl_next);} \
    CMASK(C0,C1,t); \
    { float a=MX3(C0[0],C0[1],C1[0]),b=MX3(C0[2],C0[3],C1[1]); a=MX3(a,C1[2],C1[3]); \
      _Pragma("unroll") for(int r=4;r<16;r+=4){a=MX3(a,C0[r],C0[r+1]);b=MX3(b,C0[r+2],C0[r+3]);a=MX3(a,C1[r],C1[r+1]);b=MX3(b,C1[r+2],C1[r+3]);} \
      float rm=__builtin_fmaxf(a,b); { auto rr=__builtin_amdgcn_permlane32_swap(__float_as_uint(rm),__float_as_uint(rm),false,false); rm=__builtin_fmaxf(__uint_as_float(rr[0]),__uint_as_float(rr[1])); } \
      rm+=nm; resc=false; \
      if(__builtin_expect(__any(rm>(float)THRL),0)){ const float dl=__builtin_fmaxf(rm,0.f); nm-=dl; \
        const float f=__builtin_amdgcn_exp2f(-dl); l_reg*=f; { int l2_; asm volatile("v_mbcnt_lo_u32_b32 %0, -1, 0\n\tv_mbcnt_hi_u32_b32 %0, -1, %0":"=v"(l2_)); if(l2_<32)((float*)(shm+LDS_WS))[wid*64+l2_]=f; } resc=true; } } \
    SBAR(); \
    BRD(GL,P0,P1,0); GAPB(o[0]=__builtin_amdgcn_mfma_f32_32x32x16_bf16(PAF(0),VFR(0),o[0],0,0,0), C0,0); \
    BRD(GL,P0,P1,1); GAPB(o[1]=__builtin_amdgcn_mfma_f32_32x32x16_bf16(PAF(0),VFR(4),o[1],0,0,0), C0,4); \
    KRD(GL,0); GAPB(o[0]=__builtin_amdgcn_mfma_f32_32x32x16_bf16(PAF(1),VFR(1),o[0],0,0,0), C0,8); \
    KRD(GL,1); GAPB(o[1]=__builtin_amdgcn_mfma_f32_32x32x16_bf16(PAF(1),VFR(5),o[1],0,0,0), C0,12); \
    KRD(GL,2); GAPB(o[0]=__builtin_amdgcn_mfma_f32_32x32x16_bf16(PAF(2),VFR(2),o[0],0,0,0), C1,0); \
    KRD(GL,3); GAPB(o[1]=__builtin_amdgcn_mfma_f32_32x32x16_bf16(PAF(2),VFR(6),o[1],0,0,0), C1,4); \
    BRD(GL,P0,P1,2); GAPB(o[0]=__builtin_amdgcn_mfma_f32_32x32x16_bf16(PAF(3),VFR(3),o[0],0,0,0), C1,8); \
    BRD(GL,P0,P1,3); GAPB(o[1]=__builtin_amdgcn_mfma_f32_32x32x16_bf16(PAF(3),VFR(7),o[1],0,0,0), C1,12); \
    }while(0)
  int t=1;
  #undef CMASK
  #define CMASK(P0,P1,t) do{}while(0)
  for(;t+5<NT;t+=2){
    STEP(pB0,pB1,pA0,pA1,t,true,true,true);     WAIT_BAR(3); RESC(); ROT();
    STEP(pA0,pA1,pB0,pB1,t+1,true,true,true);   WAIT_BAR(3); RESC(); ROT();
  }
  #undef CMASK
  #define CMASK(P0,P1,t) do{ if((t)>=NT-4)cmask(P0,P1,64*(t)-qoff,qrel,hi);}while(0)
  #define ENDW(tt) do{ if((tt)+3<NT){WAIT_BAR(3);} else if((tt)+2<NT){WAIT_BAR(1);} else {WAIT_BAR(0);} }while(0)
  for(;t+1<NT;t+=2){
    STEP(pB0,pB1,pA0,pA1,t,(t+3<NT),(t+1<NT),(t+1<NT));       ENDW(t);   RESC(); ROT();
    STEP(pA0,pA1,pB0,pB1,t+1,(t+4<NT),(t+2<NT),(t+2<NT));     ENDW(t+1); RESC(); ROT();
  }
  STEP(pB0,pB1,pA0,pA1,NT-1,false,false,false); RESC();
  { float sacc=pB0[0]+pB0[1]; _Pragma("unroll") for(int r=2;r<16;++r)sacc+=pB0[r]; _Pragma("unroll") for(int r=0;r<16;++r)sacc+=pB1[r]; l_reg+=sacc;
    pw0=(u32x4){PKW(pB0,0),PKW(pB0,2),PKW(pB0,4),PKW(pB0,6)};pw1=(u32x4){PKW(pB0,8),PKW(pB0,10),PKW(pB0,12),PKW(pB0,14)};pw2=(u32x4){PKW(pB1,0),PKW(pB1,2),PKW(pB1,4),PKW(pB1,6)};pw3=(u32x4){PKW(pB1,8),PKW(pB1,10),PKW(pB1,12),PKW(pB1,14)};
    SBAR(); pv(o,(int)(unsigned)(uintptr_t)vp0+sl_cur,PAF(0),PAF(1),PAF(2),PAF(3)); }
  #undef PKW
  #undef PAF
  #undef VFR
  #undef PIN
  #undef GAPA
  #undef GAPB
  #undef EX
  #undef VRD
  #undef KRD
  #undef BRD
  #undef STEP
  #undef ENDW
  const bf16*Gw=U.G+(long)(wid*QBLK)*GP; u32x4 gvv[4];
  #pragma unroll
  for(int i=0;i<4;++i){const int row=i*8+(lane>>3),ch=lane&7; gvv[i]=(wid*QBLK+row<U.nvalid)?*(const u32x4*)(Gw+(long)row*GP+ch*8):(u32x4){0u,0u,0u,0u};}
  __builtin_amdgcn_sched_barrier(0);
  {auto rr=__builtin_amdgcn_permlane32_swap(__float_as_uint(l_reg),__float_as_uint(l_reg),false,false);l_reg=__uint_as_float(rr[0])+__uint_as_float(rr[1]);}
  if(hi==0)wsf[32+r32]=l_reg;asm volatile("s_waitcnt lgkmcnt(0)":::"memory");
  float rli[16];
  #pragma unroll
  for(int r=0;r<16;++r)rli[r]=__builtin_amdgcn_rcpf(wsf[32+crow(r,hi)]);
  bf16*Ow=U.O+(long)(wid*QBLK)*OP;
  { bf16*stg=(bf16*)(shm+LDS_OST)+wid*2048;
    #pragma unroll
    for(int r=0;r<16;++r){const int orow=crow(r,hi);
      #pragma unroll
      for(int d0=0;d0<2;++d0)stg[orow*64+d0*32+r32]=__float2bfloat16(o[d0][r]*rli[r]);}
    asm volatile("s_waitcnt lgkmcnt(0)":::"memory");
    #pragma unroll
    for(int i=0;i<4;++i){const int row=i*8+(lane>>3),ch=lane&7; const u32x4 v=*(const u32x4*)(stg+row*64+ch*8);
      if(wid*QBLK+row<U.nvalid){
        const u32x4 gv=gvv[i]; u32x4 ov;
        #pragma unroll
        for(int e=0;e<4;++e){
          const float o0=__uint_as_float(v[e]<<16), o1=__uint_as_float(v[e]&0xffff0000u);
          const float g0=__uint_as_float(gv[e]<<16), g1=__uint_as_float(gv[e]&0xffff0000u);
          const float s0=g0*__builtin_amdgcn_rcpf(1.f+__expf(-g0)), s1=g1*__builtin_amdgcn_rcpf(1.f+__expf(-g1));
          ov[e]=cvtpk_s(o0*s0,o1*s1); }
        *(u32x4*)(Ow+(long)row*OP+ch*8)=ov; } } }
  asm volatile("s_waitcnt lgkmcnt(0)\n\ts_barrier":::"memory");
  #undef DMA_K
  #undef DMA_V
  #undef CMASK
  #undef RESC
  #undef ROT
  #undef BLD1
}
__device__ __forceinline__ void attn_unit_helper(const AUnit&U,char*shm,int wave0){
  int l__; asm volatile("v_mbcnt_lo_u32_b32 %0, -1, 0\n\tv_mbcnt_hi_u32_b32 %0, -1, %0":"=v"(l__)); const int tid=wave0*64+l__,lane=tid&63; const int wid=__builtin_amdgcn_readfirstlane(tid>>6);
  const int KP=U.kp;
  const unsigned lds0=(unsigned)(uintptr_t)shm;
  const bf16*ksrc=U.K+(long)lane*KP+wid*8;
  const bf16*vsrc=U.V+(long)(16*(wid&3)+(lane>>2))*KP+(wid>>2)*32+(lane&3)*8;
  const float*bsrc=U.nbk+lane;
  const unsigned kdst=lds0+LDS_K+wid*1024, vdst=lds0+LDS_V+wid*1024, bdst=lds0+LDS_BIAS+wid*(NSLOT*256);
  #define DMA_K(t,slot) do{ glds16(ksrc+(long)(t)*KVBLK*KP,(unsigned)__builtin_amdgcn_readfirstlane(kdst+(slot))); glds4(bsrc+(t)*KVBLK,(unsigned)__builtin_amdgcn_readfirstlane(bdst+((slot)>>5))); }while(0)
  #define DMA_V(t,slot) glds16(vsrc+(long)(t)*KVBLK*KP,(unsigned)__builtin_amdgcn_readfirstlane(vdst+(slot)))
  const int NT=U.NT;
  int sl_cur=0,sl_next=SLOTB;
  #define ROT() do{sl_cur=sl_next;sl_next=(sl_next==(NSLOT-1)*SLOTB)?0:sl_next+SLOTB;}while(0)
  DMA_K(0,0);DMA_V(0,0);DMA_K(1,SLOTB);DMA_K(2,2*SLOTB);
  WAIT_BAR(5);
  WAIT_BAR(0);
  DMA_K(3,0);DMA_V(1,SLOTB);
  ROT();
  WAIT_BAR(3);
  for(int t=1;t<NT-1;++t){
    if(t+3<NT){DMA_K(t+3,sl_cur);} if(t+1<NT){DMA_V(t+1,sl_next);}
    if(t+3<NT){WAIT_BAR(3);} else if(t+2<NT){WAIT_BAR(1);} else {WAIT_BAR(0);}
    ROT();
  }
  asm volatile("s_waitcnt lgkmcnt(0)\n\ts_barrier":::"memory");
  #undef DMA_K
  #undef DMA_V
  #undef ROT
}
constexpr int ATTN_LDS_BYTES=LDS_BYTES;
#undef SBAR
#undef WAIT_BAR
#undef MX3
#undef LDSV
#undef FLOORZ_LDS_OFF
}

namespace cg = cooperative_groups;
#define GAS __attribute__((address_space(1)))
#define LAS __attribute__((address_space(3)))
typedef unsigned short bf16;
typedef unsigned v4u __attribute__((ext_vector_type(4)));
typedef unsigned v2u __attribute__((ext_vector_type(2)));
typedef float f32x4 __attribute__((ext_vector_type(4)));
typedef short bf16x8 __attribute__((ext_vector_type(8)));
constexpr int NWAVES = 8;
#define SCHED_FENCE() __builtin_amdgcn_sched_barrier(0)

constexpr int DM = 1024, NB = 16, SEQ = 4096, NL = 2, SB = 8, ST = 16, PAST = 2048, NH = 8, HD = 64;
constexpr int MP = NB * SEQ;
constexpr int MS = SB * ST;
constexpr int MV = MP + MS;
constexpr int MPAD = 257 * 256;
constexpr int INC = 3592;
constexpr int PP = 3584;
constexpr int C_PU = 0, C_PG = 256, C_Q = 512, C_K = 1024, C_V = 1536, C_AG = 2048, C_CB = 2560, C_CC = 2816, C_CX = 3072, C_CG = 3328;
constexpr int KSROWS = 2176;
constexpr int NBKS = 2432;
constexpr float EPS = 1e-6f;
constexpr float LOG2E = 1.4426950408889634f;

constexpr size_t O_YP = 0;
constexpr size_t O_YS = O_YP + (size_t)MP * DM;
constexpr size_t O_KP = O_YS + (size_t)MS * DM;
constexpr size_t O_VP = O_KP + (size_t)NL * MP * 512;
constexpr size_t O_FP = O_VP + (size_t)NL * MP * 512;
constexpr size_t O_PP = O_FP + (size_t)NL * MP * 8;
constexpr size_t O_CP = O_PP + (size_t)NL * NB * 15 * 256;
constexpr size_t O_KS = O_CP + (size_t)NL * NB * 2 * 256;
constexpr size_t O_VS = O_KS + (size_t)NL * MS * 512;
constexpr size_t O_FS = O_VS + (size_t)NL * MS * 512;
constexpr size_t O_PS = O_FS + (size_t)NL * MS * 8;
constexpr size_t O_CS = O_PS + (size_t)NL * SB * 15 * 256;
constexpr size_t O_END = O_CS + (size_t)NL * SB * 2 * 256;

constexpr size_t MiB = 1u << 20;
constexpr size_t WS_WIN = 0;
constexpr size_t WS_WOUT = 16 * MiB;
constexpr size_t WS_PWT = 20 * MiB;
constexpr size_t WS_NBKP = 21 * MiB;
constexpr size_t WS_NBKS = 23 * MiB;
constexpr size_t WS_BAR = 23 * MiB + 768 * 1024;
constexpr size_t WS_KS = 24 * MiB;
constexpr size_t WS_VS = 60 * MiB;
constexpr size_t WS_XN = 96 * MiB;
constexpr size_t WS_PROJ = 226 * MiB;
constexpr size_t WS_X1B = WS_PROJ + (size_t)(MPAD + 512) * PP * 2;
constexpr size_t WS_END = WS_X1B + (size_t)MP * DM * 2;
static_assert(WS_KS + (size_t)NL * SB * KSROWS * 512 * 2 <= WS_VS && WS_VS + (size_t)NL * SB * KSROWS * 512 * 2 <= WS_XN && WS_XN + (size_t)(MPAD + 256) * DM * 2 <= WS_PROJ, "ws map");

constexpr int REP_CONV = 1, REP_POOL = 1; constexpr int REP_P0 = 1, REP_PA = 1, REP_GIN = 1, REP_MIX = 1, REP_ATTN = 1, REP_GOUT0 = 1;
constexpr int STAGGER_TICKS = 1600;
constexpr int RING_BYTES = 131072;
constexpr int LDS_BYTES = 147456;

__device__ __forceinline__ unsigned f2bf(float f) { unsigned u = __builtin_bit_cast(unsigned, f); return (u + 0x7fffu + ((u >> 16) & 1u)) >> 16; }
__device__ __forceinline__ unsigned pk2(float lo, float hi) { return attn_body::cvtpk_s(lo, hi); }
__device__ __forceinline__ float bflo(unsigned w) { return __uint_as_float(w << 16); }
__device__ __forceinline__ float bfhi(unsigned w) { return __uint_as_float(w & 0xffff0000u); }
__device__ __forceinline__ void stagger_wait(int steps) { const unsigned long long t0 = __builtin_amdgcn_s_memrealtime(); const unsigned long long d = (unsigned long long)steps * STAGGER_TICKS; while (__builtin_amdgcn_s_memrealtime() - t0 < d) __builtin_amdgcn_s_sleep(16); }
__device__ __forceinline__ float silu_f(float x) { return x * __builtin_amdgcn_rcpf(1.f + __expf(-x)); }
__device__ __forceinline__ float shx(float v, int m, int lane) { return __int_as_float(__builtin_amdgcn_ds_bpermute((lane ^ m) << 2, __float_as_int(v))); }
__device__ __forceinline__ float wave_sum(float v, int lane) {
#pragma unroll
    for (int o = 1; o < 64; o <<= 1) v += shx(v, o, lane);
    return v;
}

struct Args {
    const float* in[16]; float* out; unsigned char* ws; int ph_lo, ph_hi;
};

struct Str { int s, cs, GS, cg, rowP0, rowsP, sb0, SBs; };
struct Frame {
    LAS unsigned char* lds;
    int tid, lane, wave, vcu, G, wave0;
};
#define FRAME_REFRESH(F) do { int l_; asm volatile("v_mbcnt_lo_u32_b32 %0, -1, 0\n\tv_mbcnt_hi_u32_b32 %0, -1, %0" : "=v"(l_)); int t_ = (F).wave0 * 64 + l_; (F).tid = t_; (F).lane = t_ & 63; (F).wave = __builtin_amdgcn_readfirstlane(t_ >> 6); } while (0)

__host__ __device__ __forceinline__ int win_logical_col(int p) {
    if (p < 512) return p;
    if (p < 1536) { const int reg = (p - 512) >> 8, q = (p - 512) & 255; return 512 + reg * 256 + 64 * ((q >> 5) & 3) + 32 * (q >> 7) + (q & 31); }
    if (p < 2560) return p;
    return p + 8;
}

__device__ __forceinline__ void transpose_item(const float* W, int K, int Nsrc, int srccol0, bf16* WT, int n0, int k0, LAS float* scr, int lane) {
    float tv[32];
#pragma unroll
    for (int i = 0; i < 32; ++i) { const int kk = 2 * i + (lane >> 5); tv[i] = W[(size_t)(k0 + kk) * Nsrc + srccol0 + (lane & 31)]; }
    SCHED_FENCE();
#pragma unroll
    for (int i = 0; i < 32; ++i) { const int kk = 2 * i + (lane >> 5); scr[kk * 33 + (lane & 31)] = tv[i]; }
    asm volatile("s_waitcnt lgkmcnt(0)" ::: "memory");
    const int c = lane & 7;
#pragma unroll
    for (int j = 0; j < 4; ++j) { const int n = (lane >> 3) + 8 * j; const LAS float* s = scr + (8 * c) * 33 + n;
        v4u o; o.x = pk2(s[0 * 33], s[1 * 33]); o.y = pk2(s[2 * 33], s[3 * 33]); o.z = pk2(s[4 * 33], s[5 * 33]); o.w = pk2(s[6 * 33], s[7 * 33]);
        *(v4u*)(WT + (size_t)(n0 + n) * K + k0 + 8 * c) = o; }
    asm volatile("s_waitcnt lgkmcnt(0)" ::: "memory");
}

__device__ __forceinline__ void p0_prologue(Frame& F, const Args& a) {
    LAS float* scr = (LAS float*)(F.lds + F.wave * 16384);
    const int gw = F.vcu * NWAVES + F.wave, NGW = F.G * NWAVES;
    unsigned char* ws = a.ws;
    constexpr int I_IN = (DM / 64) * (PP / 32), I_OUT = (DM / 64) * (DM / 32);
    for (int it = gw; it < NL * (I_IN + I_OUT); it += NGW) {
        const int l = it / (I_IN + I_OUT); int r = it % (I_IN + I_OUT);
        if (r < I_IN) { const int kb = r / (PP / 32), nb = r % (PP / 32);
            transpose_item(a.in[8] + (size_t)l * DM * INC, DM, INC, win_logical_col(32 * nb), (bf16*)(ws + WS_WIN) + (size_t)l * PP * DM, 32 * nb, 64 * kb, scr, F.lane); }
        else { r -= I_IN; const int kb = r / (DM / 32), nb = r % (DM / 32);
            transpose_item(a.in[15] + (size_t)l * DM * DM, DM, DM, 32 * nb, (bf16*)(ws + WS_WOUT) + (size_t)l * DM * DM, 32 * nb, 64 * kb, scr, F.lane); }
    }
    { const int gt = F.vcu * 512 + F.tid, NT_ = F.G * 512; bf16* pwt = (bf16*)(ws + WS_PWT);
      for (int i = gt; i < NL * 4 * 64 * 64; i += NT_) { const int c = i & 63, d = (i >> 6) & 63, lg = i >> 12; pwt[i] = (bf16)f2bf(a.in[12][(size_t)lg * 4096 + c * 64 + d]); } }
    { const size_t gt = (size_t)F.vcu * 512 + F.tid, NT_ = (size_t)F.G * 512;
      const size_t nchunk = (size_t)NL * SB * PAST * 64;
      for (size_t i0 = gt; i0 < 2 * nchunk; i0 += 4 * NT_) {
          f32x4 x0[4], x1[4];
#pragma unroll
          for (int q = 0; q < 4; ++q) { const size_t i = i0 + q * NT_; if (i < 2 * nchunk) { const int which = i >= nchunk; const size_t j = which ? i - nchunk : i;
              const float* src = a.in[2 + which] + (j >> 6) * 512 + (int)(j & 63) * 8; x0[q] = *(const f32x4*)src; x1[q] = *(const f32x4*)(src + 4); } }
          SCHED_FENCE();
#pragma unroll
          for (int q = 0; q < 4; ++q) { const size_t i = i0 + q * NT_; if (i < 2 * nchunk) { const int which = i >= nchunk; const size_t j = which ? i - nchunk : i;
              const size_t rowg = j >> 6; const int c8 = (int)(j & 63) * 8; const size_t lb = rowg / PAST; const int r = (int)(rowg % PAST);
              v4u o; o.x = pk2(x0[q][0], x0[q][1]); o.y = pk2(x0[q][2], x0[q][3]); o.z = pk2(x1[q][0], x1[q][1]); o.w = pk2(x1[q][2], x1[q][3]);
              *(v4u*)((bf16*)(ws + (which ? WS_VS : WS_KS)) + (lb * KSROWS + r) * 512 + c8) = o; } }
          SCHED_FENCE(); }
      const size_t nz = (size_t)NL * SB * (KSROWS - PAST - ST) * 64;
      for (size_t i = gt; i < 2 * nz; i += NT_) {
          const int which = i >= nz; const size_t j = which ? i - nz : i;
          const size_t rowg = j >> 6; const int c8 = (int)(j & 63) * 8; const size_t lb = rowg / (KSROWS - PAST - ST); const int r = (int)(rowg % (KSROWS - PAST - ST)) + PAST + ST;
          bf16* dst = (bf16*)(ws + (which ? WS_VS : WS_KS)) + (lb * KSROWS + r) * 512 + c8;
          *(v4u*)dst = (v4u){0u, 0u, 0u, 0u}; } }
    { const int gt = F.vcu * 512 + F.tid, NT_ = F.G * 512; v4u* p = (v4u*)((bf16*)(ws + WS_XN) + (size_t)MV * DM);
      for (int i = gt; i < (MPAD - MV) * DM / 8; i += NT_) p[i] = (v4u){0u, 0u, 0u, 0u}; }
}

__device__ __forceinline__ void pa_phase(Frame& F, const Args& a, int l, const float* xp, const float* xs, const Str& T, const bf16* xpb = nullptr) {
    LAS float* wg = (LAS float*)F.lds;
    __syncthreads();
    const float* ng = a.in[7] + (size_t)l * DM;
    { const float* wf = a.in[8] + (size_t)l * DM * INC + 2560;
      for (int k = F.tid; k < DM; k += 512) { const f32x4 w0 = *(const f32x4*)(wf + (size_t)k * INC), w1 = *(const f32x4*)(wf + (size_t)k * INC + 4); const float g = ng[k];
          wg[0 * 1024 + k] = w0[0] * g; wg[1 * 1024 + k] = w0[1] * g; wg[2 * 1024 + k] = w0[2] * g; wg[3 * 1024 + k] = w0[3] * g;
          wg[4 * 1024 + k] = w1[0] * g; wg[5 * 1024 + k] = w1[1] * g; wg[6 * 1024 + k] = w1[2] * g; wg[7 * 1024 + k] = w1[3] * g; } }
    __syncthreads();
    const int lane = F.lane;
    f32x4 gv[4];
#pragma unroll
    for (int j = 0; j < 4; ++j) gv[j] = *(const f32x4*)(ng + 4 * lane + 256 * j);
    const float* bfp = a.in[9] + l * 8;
    bf16* XN = (bf16*)(a.ws + WS_XN);
    float* outfp = a.out + O_FP + (size_t)l * MP * 8; float* outfs = a.out + O_FS + (size_t)l * MS * 8;
    const int gw = T.cs * NWAVES + F.wave, NGW = T.GS * NWAVES;
    for (int rg = gw; rg < (T.rowsP + T.SBs * ST) / 4; rg += NGW) {
        const int row0 = rg < T.rowsP / 4 ? T.rowP0 + rg * 4 : MP + T.sb0 * ST + (rg - T.rowsP / 4) * 4;
        const float* src = row0 < MP ? xp + (size_t)row0 * DM : xs + (size_t)(row0 - MP) * DM;
        f32x4 v[4][4]; float rstd[4];
        if (xpb != nullptr && row0 < MP) {
            const bf16* sb = xpb + (size_t)row0 * DM;
#pragma unroll
            for (int r = 0; r < 4; ++r)
#pragma unroll
                for (int j = 0; j < 4; ++j) { const v2u p = *(const v2u*)(sb + (size_t)r * DM + 4 * lane + 256 * j); v[r][j] = (f32x4){bflo(p.x), bfhi(p.x), bflo(p.y), bfhi(p.y)}; }
        } else {
#pragma unroll
            for (int r = 0; r < 4; ++r)
#pragma unroll
                for (int j = 0; j < 4; ++j) v[r][j] = __builtin_nontemporal_load((const f32x4*)(src + (size_t)r * DM + 4 * lane + 256 * j));
        }
#pragma unroll
        for (int r = 0; r < 4; ++r) { float s = 0.f;
#pragma unroll
            for (int j = 0; j < 4; ++j) s += (v[r][j][0] * v[r][j][0] + v[r][j][1] * v[r][j][1]) + (v[r][j][2] * v[r][j][2] + v[r][j][3] * v[r][j][3]);
            rstd[r] = 1.0f / sqrtf(wave_sum(s, lane) * (1.f / DM) + EPS); }
        float acc[32];
#pragma unroll
        for (int i = 0; i < 32; ++i) acc[i] = 0.f;
#pragma unroll
        for (int h = 0; h < 8; ++h) {
#pragma unroll
            for (int j = 0; j < 4; ++j) { const f32x4 w = *(const LAS f32x4*)(wg + h * 1024 + 4 * lane + 256 * j);
#pragma unroll
                for (int r = 0; r < 4; ++r) acc[r * 8 + h] += (v[r][j][0] * w[0] + v[r][j][1] * w[1]) + (v[r][j][2] * w[2] + v[r][j][3] * w[3]); }
            asm volatile("" ::: "memory"); }
#define RS_STAGE(M_, N_) { const bool up = (lane & (M_)) != 0; _Pragma("unroll") for (int i = 0; i < (N_); ++i) { const float send = up ? acc[i] : acc[i + (N_)], keep = up ? acc[i + (N_)] : acc[i]; acc[i] = keep + shx(send, (M_), lane); } }
        RS_STAGE(32, 16) RS_STAGE(16, 8) RS_STAGE(8, 4) RS_STAGE(4, 2) RS_STAGE(2, 1)
#undef RS_STAGE
        acc[0] += shx(acc[0], 1, lane);
        { const int idx = lane >> 1, r = idx >> 3, h = idx & 7;
          const float rs = r == 0 ? rstd[0] : r == 1 ? rstd[1] : r == 2 ? rstd[2] : rstd[3];
          const float xx = acc[0] * rs + bfp[h];
          const float lf = fminf(xx, 0.f) - __logf(1.f + __expf(-fabsf(xx)));
          if ((lane & 1) == 0) { const int row = row0 + r; if (row < MP) outfp[(size_t)row * 8 + h] = lf; else outfs[(size_t)(row - MP) * 8 + h] = lf; } }
#pragma unroll
        for (int r = 0; r < 4; ++r) { unsigned long long* o8 = (unsigned long long*)(XN + (size_t)(row0 + r) * DM) + lane;
#pragma unroll
            for (int j = 0; j < 4; ++j) { const f32x4 y = v[r][j] * rstd[r] * gv[j];
                o8[64 * j] = (unsigned long long)pk2(y[0], y[1]) | ((unsigned long long)pk2(y[2], y[3]) << 32); } }
    }
    __syncthreads();
}

__device__ __forceinline__ void scan_phase(Frame& F, const Args& a, int l, const Str& T) {
    LAS float* sc = (LAS float*)F.lds;
    const float* lfp = a.out + O_FP + (size_t)l * MP * 8; const float* lfs = a.out + O_FS + (size_t)l * MS * 8;
    const float* clf = a.in[4] + (size_t)l * SB * PAST * 8;
    float* nbkp = (float*)(a.ws + WS_NBKP); float* nbks = (float*)(a.ws + WS_NBKS);
    const int nbhp = (T.rowsP / SEQ) * 8, nbhs = T.SBs * 8;
    for (int s = T.cs; s < nbhp + nbhs; s += T.GS) {
        const bool samp = s >= nbhp; const int bh = samp ? T.sb0 * 8 + (s - nbhp) : (T.rowP0 / SEQ) * 8 + s, b = bh >> 3, h = bh & 7;
        const int n = samp ? PAST + ST : SEQ;
        float v[8]; float run = 0.f;
#pragma unroll
        for (int j = 0; j < 8; ++j) { const int t = 8 * F.tid + j; float x = 0.f;
            if (t < n) x = samp ? (t < PAST ? clf[((size_t)b * PAST + t) * 8 + h] : lfs[((size_t)b * ST + (t - PAST)) * 8 + h]) : lfp[((size_t)b * SEQ + t) * 8 + h];
            run += x; v[j] = run; }
        float inc = run;
#pragma unroll
        for (int o = 1; o < 64; o <<= 1) { const int src = F.lane >= o ? F.lane - o : F.lane; const float y = __int_as_float(__builtin_amdgcn_ds_bpermute(src << 2, __float_as_int(inc))); if (F.lane >= o) inc += y; }
        if (F.lane == 63) sc[F.wave] = inc;
        __syncthreads();
        float base = inc - run;
        for (int w = 0; w < F.wave; ++w) base += sc[w];
        float* dst = samp ? nbks + (size_t)bh * NBKS : nbkp + (size_t)bh * SEQ;
        const int t0 = 8 * F.tid;
        if (t0 < n) {
            *(f32x4*)(dst + t0) = (f32x4){-(base + v[0]) * LOG2E, -(base + v[1]) * LOG2E, -(base + v[2]) * LOG2E, -(base + v[3]) * LOG2E};
            *(f32x4*)(dst + t0 + 4) = (f32x4){-(base + v[4]) * LOG2E, -(base + v[5]) * LOG2E, -(base + v[6]) * LOG2E, -(base + v[7]) * LOG2E};
        } else if (samp && t0 < NBKS) {
            *(f32x4*)(dst + t0) = (f32x4){0.f, 0.f, 0.f, 0.f}; *(f32x4*)(dst + t0 + 4) = (f32x4){0.f, 0.f, 0.f, 0.f};
        }
        __syncthreads();
    }
}

template <int W> __device__ __forceinline__ void pool_task(const Args& a, int l, int rt, int g, int lane) {
    const int fr = lane & 15, fq = lane >> 4;
    const bool samp = rt >= MP / 16;
    const int row = rt * 16 + fr;
    const int t = samp ? fr : (row & (SEQ - 1));
    const int b = samp ? (rt - MP / 16) : (row >> 12);
    const bf16* proj = (const bf16*)(a.ws + WS_PROJ);
    const bf16* pu = proj + (size_t)row * PP + C_PU + g * 64;
    const float* sp = a.in[5] + ((size_t)(l * SB + (samp ? b : 0)) * 15) * 256 + g * 64;
    const float inv = 1.0f / (float)(samp ? W : (t + 1 < W ? t + 1 : W));
    const bf16* pwt = (const bf16*)(a.ws + WS_PWT) + (size_t)(l * 4 + g) * 4096;
    const float* psc = a.in[13] + l * 256 + g * 64;
    const bf16* pg = proj + (size_t)row * PP + C_PG + g * 64;
    bf16x8 bfr[4][2]; f32x4 sc[4]; v2u gg[4];
    bf16x8 af[2];
    float* outp = samp ? a.out + O_PS + ((size_t)(l * SB + b) * 15) * 256 + g * 64 : a.out + O_PP + ((size_t)(l * NB + b) * 15) * 256 + g * 64;
#pragma unroll
    for (int kk = 0; kk < 2; ++kk) {
        const int ch = 32 * kk + 8 * fq;
        v4u xs[W];
#pragma unroll
        for (int j = 0; j < W; ++j) { const int jj = (t - j >= 0) ? j : 0; xs[j] = *(const v4u*)(pu - (size_t)jj * PP + ch); }
        if (kk == 0) {
#pragma unroll
            for (int n = 0; n < 4; ++n) {
#pragma unroll
                for (int k2 = 0; k2 < 2; ++k2) bfr[n][k2] = *(const bf16x8*)(pwt + (16 * n + fr) * 64 + 32 * k2 + 8 * fq);
                sc[n] = *(const f32x4*)(psc + 16 * n + 4 * fq); gg[n] = *(const v2u*)(pg + 16 * n + 4 * fq); }
        }
        SCHED_FENCE();
        float s[8], u[8];
#pragma unroll
        for (int e = 0; e < 4; ++e) { u[2 * e] = bflo(xs[0][e]); u[2 * e + 1] = bfhi(xs[0][e]); s[2 * e] = 0.f; s[2 * e + 1] = 0.f; }
#pragma unroll
        for (int j = 0; j < W; ++j) { const bool ok = (t - j >= 0);
#pragma unroll
            for (int e = 0; e < 4; ++e) { s[2 * e] += ok ? bflo(xs[j][e]) : 0.f; s[2 * e + 1] += ok ? bfhi(xs[j][e]) : 0.f; } }
        if (samp) {
#pragma unroll 1
            for (int j = 1; j < W; ++j) { const int tt = t - j;
                if (tt < 0) { const float* q = sp + (size_t)(15 + tt) * 256 + ch; const f32x4 x0 = *(const f32x4*)q, x1 = *(const f32x4*)(q + 4);
                    s[0] += x0[0]; s[1] += x0[1]; s[2] += x0[2]; s[3] += x0[3]; s[4] += x1[0]; s[5] += x1[1]; s[6] += x1[2]; s[7] += x1[3]; } }
        }
        v4u pk; pk.x = pk2(s[0] * inv - u[0], s[1] * inv - u[1]); pk.y = pk2(s[2] * inv - u[2], s[3] * inv - u[3]); pk.z = pk2(s[4] * inv - u[4], s[5] * inv - u[5]); pk.w = pk2(s[6] * inv - u[6], s[7] * inv - u[7]);
        af[kk] = __builtin_bit_cast(bf16x8, pk);
        const int orow = samp ? t - 1 : t - (SEQ - 15);
        if (orow >= 0) { float* q = outp + (size_t)orow * 256 + ch; *(f32x4*)q = (f32x4){u[0], u[1], u[2], u[3]}; *(f32x4*)(q + 4) = (f32x4){u[4], u[5], u[6], u[7]}; }
        SCHED_FENCE();
    }
    f32x4 acc[4];
#pragma unroll
    for (int n = 0; n < 4; ++n) { acc[n] = (f32x4){0.f, 0.f, 0.f, 0.f};
#pragma unroll
        for (int kk = 0; kk < 2; ++kk) acc[n] = __builtin_amdgcn_mfma_f32_16x16x32_bf16(bfr[n][kk], af[kk], acc[n], 0, 0, 0); }
    bf16* mix = (bf16*)(a.ws + WS_XN) + (size_t)row * DM + g * 64;
#pragma unroll
    for (int n = 0; n < 4; ++n) { const int d = 16 * n + 4 * fq;
        const float o0 = acc[n][0] * sc[n][0] * silu_f(bflo(gg[n].x)), o1 = acc[n][1] * sc[n][1] * silu_f(bfhi(gg[n].x)), o2 = acc[n][2] * sc[n][2] * silu_f(bflo(gg[n].y)), o3 = acc[n][3] * sc[n][3] * silu_f(bfhi(gg[n].y));
        v2u o; o.x = pk2(o0, o1); o.y = pk2(o2, o3); *(v2u*)(mix + d) = o; }
}

__device__ __forceinline__ void conv_item(const Args& a, int l, int rb, int tid, const Str& T) {
    const int chunk = tid & 31, run = tid >> 5, ch = chunk * 8;
    const bool samp = rb == MP / 128;
    const int row0 = rb * 128 + run * 8;
    const int t0 = samp ? (run & 1) * 8 : (row0 & (SEQ - 1));
    const int b = samp ? (run >> 1) : (row0 >> 12);
    if (samp && (b < T.sb0 || b >= T.sb0 + T.SBs)) return;
    const bf16* proj = (const bf16*)(a.ws + WS_PROJ);
    bf16* mix = (bf16*)(a.ws + WS_XN);
    float zm2[8], zm1[8], w0[8], w1[8], w2[8];
    { const float* cw = a.in[14] + (size_t)l * 3 * 256 + ch;
#pragma unroll
      for (int e = 0; e < 8; ++e) { w0[e] = cw[e]; w1[e] = cw[256 + e]; w2[e] = cw[512 + e]; } }
    const bool first = (t0 == 0);
    v4u hc2, hx2, hc1, hx1;
    { const bf16* p2 = proj + (size_t)(first ? row0 : row0 - 2) * PP; const bf16* p1 = proj + (size_t)(first ? row0 : row0 - 1) * PP;
      hc2 = *(const v4u*)(p2 + C_CC + ch); hx2 = *(const v4u*)(p2 + C_CX + ch); hc1 = *(const v4u*)(p1 + C_CC + ch); hx1 = *(const v4u*)(p1 + C_CX + ch); }
    float* outc = samp ? a.out + O_CS + ((size_t)(l * SB + b) * 2) * 256 + ch : a.out + O_CP + ((size_t)(l * NB + b) * 2) * 256 + ch;
    const int tlast = samp ? ST - 2 : SEQ - 2;
    v4u lcb[8], lcc[8], lcx[8], lcg[8];
#pragma unroll
    for (int i = 0; i < 8; ++i) { const bf16* p = proj + (size_t)(row0 + i) * PP;
        lcb[i] = *(const v4u*)(p + C_CB + ch); lcc[i] = *(const v4u*)(p + C_CC + ch); lcx[i] = *(const v4u*)(p + C_CX + ch); lcg[i] = *(const v4u*)(p + C_CG + ch); }
    SCHED_FENCE();
    if (first) {
        if (samp) { const float* sc = a.in[6] + ((size_t)(l * SB + b) * 2) * 256 + ch;
#pragma unroll
            for (int e = 0; e < 8; ++e) { zm2[e] = sc[e]; zm1[e] = sc[256 + e]; } }
        else {
#pragma unroll
            for (int e = 0; e < 8; ++e) { zm2[e] = 0.f; zm1[e] = 0.f; } }
    } else {
#pragma unroll
        for (int e = 0; e < 4; ++e) { zm2[2 * e] = bflo(hc2[e]) * bflo(hx2[e]); zm2[2 * e + 1] = bfhi(hc2[e]) * bfhi(hx2[e]); zm1[2 * e] = bflo(hc1[e]) * bflo(hx1[e]); zm1[2 * e + 1] = bfhi(hc1[e]) * bfhi(hx1[e]); }
    }
#pragma unroll
    for (int i = 0; i < 8; ++i) {
        const v4u cb = lcb[i], cc = lcc[i], cx = lcx[i], cgt = lcg[i];
        float z[8], o[8];
#pragma unroll
        for (int e = 0; e < 4; ++e) { z[2 * e] = bflo(cc[e]) * bflo(cx[e]); z[2 * e + 1] = bfhi(cc[e]) * bfhi(cx[e]); }
#pragma unroll
        for (int e = 0; e < 8; ++e) { const float y = w0[e] * zm2[e] + w1[e] * zm1[e] + w2[e] * z[e]; o[e] = y; zm2[e] = zm1[e]; zm1[e] = z[e]; }
#pragma unroll
        for (int e = 0; e < 4; ++e) { o[2 * e] *= bflo(cb[e]) * silu_f(bflo(cgt[e])); o[2 * e + 1] *= bfhi(cb[e]) * silu_f(bfhi(cgt[e])); }
        v4u ov; ov.x = pk2(o[0], o[1]); ov.y = pk2(o[2], o[3]); ov.z = pk2(o[4], o[5]); ov.w = pk2(o[6], o[7]);
        *(v4u*)(mix + (size_t)(row0 + i) * DM + 768 + ch) = ov;
        const int t = t0 + i;
        if (t >= tlast) { float* q = outc + (size_t)(t - tlast) * 256; *(f32x4*)q = (f32x4){z[0], z[1], z[2], z[3]}; *(f32x4*)(q + 4) = (f32x4){z[4], z[5], z[6], z[7]}; }
    }
}

__device__ __forceinline__ void mixer_phase(Frame& F, const Args& a, int l, const Str& T) {
    for (int r2_ = 0; r2_ < REP_CONV; ++r2_) { const int nb = T.rowsP / 128;
      for (int k = T.cs; k < nb + 1; k += T.GS) conv_item(a, l, k < nb ? T.rowP0 / 128 + k : MP / 128, F.tid, T); }
    const int gw = T.cs * NWAVES + F.wave, NGW = T.GS * NWAVES;
    const int ntp = T.rowsP / 16, NTs = ntp + T.SBs;
    for (int r3_ = 0; r3_ < REP_POOL; ++r3_) for (int k = gw; k < NTs * 4; k += NGW) { const int j = k % NTs, g = 3 - k / NTs; const int rt = j < ntp ? T.rowP0 / 16 + j : MP / 16 + T.sb0 + (j - ntp);
        if (g == 0) pool_task<2>(a, l, rt, 0, F.lane); else if (g == 1) pool_task<4>(a, l, rt, 1, F.lane); else if (g == 2) pool_task<8>(a, l, rt, 2, F.lane); else pool_task<16>(a, l, rt, 3, F.lane); }
}

__device__ __forceinline__ void small_mm(const bf16* A, const bf16* Bt, const int (&boff)[4], int lane, f32x4 (&acc)[4]) {
    const int fr = lane & 15, fq = lane >> 4;
    const bf16* ap = A + (size_t)fr * DM + 8 * fq;
    const bf16* bp[4];
#pragma unroll
    for (int n = 0; n < 4; ++n) { bp[n] = Bt + (size_t)(boff[n] + fr) * DM + 8 * fq; acc[n] = (f32x4){0.f, 0.f, 0.f, 0.f}; }
#pragma unroll 1
    for (int k0 = 0; k0 < DM / 32; k0 += 8) {
        bf16x8 av[8], bv[8][4];
#pragma unroll
        for (int i = 0; i < 8; ++i) { av[i] = *(const bf16x8*)(ap + 32 * (k0 + i));
#pragma unroll
            for (int n = 0; n < 4; ++n) bv[i][n] = *(const bf16x8*)(bp[n] + 32 * (k0 + i)); }
        SCHED_FENCE();
#pragma unroll
        for (int i = 0; i < 8; ++i)
#pragma unroll
            for (int n = 0; n < 4; ++n) acc[n] = __builtin_amdgcn_mfma_f32_16x16x32_bf16(bv[i][n], av[i], acc[n], 0, 0, 0);
        SCHED_FENCE();
    }
}
__device__ __forceinline__ void small_inproj_item(const Args& a, int l, int rb, int cb, int lane) {
    const int fr = lane & 15, fq = lane >> 4, pn = cb >> 2, hh = cb & 3;
    const bool headed = (pn >= 2 && pn <= 5);
    int boff[4];
#pragma unroll
    for (int n = 0; n < 4; ++n) boff[n] = headed ? pn * 256 + 32 * hh + (n & 1) * 16 + (n >> 1) * 128 : cb * 64 + 16 * n;
    f32x4 acc[4];
    small_mm((const bf16*)(a.ws + WS_XN) + (size_t)(MP + rb * 16) * DM, (const bf16*)(a.ws + WS_WIN) + (size_t)l * PP * DM, boff, lane, acc);
    const int lr = rb * 16 + fr;
    bf16* proj = (bf16*)(a.ws + WS_PROJ) + (size_t)(MP + lr) * PP;
    if (headed) {
        const bool isq = pn < 4; const int head = (pn & 1) * 4 + hh;
        const float* g = (isq ? a.in[10] : a.in[11]) + l * 64;
        float ss = 0.f;
#pragma unroll
        for (int n = 0; n < 4; ++n) ss += (acc[n][0] * acc[n][0] + acc[n][1] * acc[n][1]) + (acc[n][2] * acc[n][2] + acc[n][3] * acc[n][3]);
        ss += shx(ss, 16, lane); ss += shx(ss, 32, lane);
        const float rs = 1.0f / sqrtf(ss * (1.0f / 64.0f) + EPS) * (isq ? attn_body::C2 : 1.0f);
        bf16* kd = (bf16*)(a.ws + WS_KS) + ((size_t)(l * SB + rb) * KSROWS + PAST + fr) * 512 + head * 64;
        float* ko = a.out + O_KS + (size_t)l * MS * 512 + (size_t)lr * 512 + head * 64;
#pragma unroll
        for (int n = 0; n < 4; ++n) { const int d = 16 * n + 4 * fq; const f32x4 gv = *(const f32x4*)(g + d); const f32x4 y = acc[n] * rs * gv;
            v2u w; w.x = pk2(y[0], y[1]); w.y = pk2(y[2], y[3]);
            if (isq) *(v2u*)(proj + C_Q + head * 64 + d) = w;
            else { *(v2u*)(kd + d) = w; *(f32x4*)(ko + d) = y; } }
    } else if (pn == 6 || pn == 7) {
        const int c0 = cb * 64 - C_V;
        bf16* vd = (bf16*)(a.ws + WS_VS) + ((size_t)(l * SB + rb) * KSROWS + PAST + fr) * 512 + c0;
        float* vo = a.out + O_VS + (size_t)l * MS * 512 + (size_t)lr * 512 + c0;
#pragma unroll
        for (int n = 0; n < 4; ++n) { const int d = 16 * n + 4 * fq; v2u w; w.x = pk2(acc[n][0], acc[n][1]); w.y = pk2(acc[n][2], acc[n][3]); *(v2u*)(vd + d) = w; *(f32x4*)(vo + d) = acc[n]; }
    } else {
#pragma unroll
        for (int n = 0; n < 4; ++n) { const int d = cb * 64 + 16 * n + 4 * fq; v2u w; w.x = pk2(acc[n][0], acc[n][1]); w.y = pk2(acc[n][2], acc[n][3]); *(v2u*)(proj + d) = w; }
    }
}
__device__ __forceinline__ void small_outproj_item(const Args& a, int l, int rb, int cb, int lane, const float* base_s, float* out_s) {
    const int fr = lane & 15, fq = lane >> 4;
    int boff[4];
#pragma unroll
    for (int n = 0; n < 4; ++n) boff[n] = cb * 64 + 16 * n;
    f32x4 acc[4];
    small_mm((const bf16*)(a.ws + WS_XN) + (size_t)(MP + rb * 16) * DM, (const bf16*)(a.ws + WS_WOUT) + (size_t)l * DM * DM, boff, lane, acc);
    const size_t off = (size_t)(rb * 16 + fr) * DM + cb * 64 + 4 * fq;
#pragma unroll
    for (int n = 0; n < 4; ++n) { const f32x4 bs = *(const f32x4*)(base_s + off + 16 * n); *(f32x4*)(out_s + off + 16 * n) = bs + acc[n]; }
}

#define XB_TMO      128
#define XB_XCNT(j)  (256  + 64 * (j))
#define XB_XSUB(j)  (1280 + 64 * (j))
#define XB_XGEN(j)  (2304 + 64 * (j))
#define XB_TOP      3328
#define XB_TOPGEN   3392
#define XCD_BAR_WORDS 3456
#define XB_SPIN_CAP (1u << 18)

__device__ __forceinline__ unsigned xb_ld(unsigned* p)              { return __hip_atomic_load(p, __ATOMIC_RELAXED, __HIP_MEMORY_SCOPE_AGENT); }
__device__ __forceinline__ unsigned xb_add(unsigned* p, unsigned v) { return __hip_atomic_fetch_add(p, v, __ATOMIC_RELAXED, __HIP_MEMORY_SCOPE_AGENT); }
__device__ __forceinline__ unsigned xb_xcc_id() { return (unsigned)__builtin_amdgcn_s_getreg((3 << 11) | 20) & 0xFu; }
#define XB_SPIN(cond, bar) do { unsigned _sp = 0; while (cond) { __builtin_amdgcn_s_sleep(1); \
    if ((++_sp & 255u) == 0u) { if (xb_ld(&(bar)[XB_TMO])) break; if (_sp > XB_SPIN_CAP) { atomicAdd(&(bar)[XB_TMO], 1u); break; } } } } while (0)

__device__ __forceinline__ bool xb_is_t0(int w0) { int l_; asm volatile("v_mbcnt_lo_u32_b32 %0, -1, 0\n\tv_mbcnt_hi_u32_b32 %0, -1, %0" : "=v"(l_)); return w0 == 0 && l_ == 0; }
struct XcdBarrier {
    int w0; unsigned G; unsigned* bar; unsigned x;
    volatile LAS unsigned* st;
};

__device__ __forceinline__ XcdBarrier xcd_barrier_post(unsigned* bar, volatile LAS unsigned* st, int w0, unsigned G) {
    XcdBarrier b; b.w0 = w0; b.G = G; b.bar = bar; b.x = xb_xcc_id(); b.st = st;
    if (xb_is_t0(w0)) (void)xb_add(&bar[XB_XCNT(b.x)], 1u);
    return b;
}
__device__ __forceinline__ void xcd_barrier_complete(unsigned* bar, unsigned x, unsigned& nloc, unsigned& nx, unsigned G) {
    unsigned sum, cnt, mine, sp = 0u;
    for (;;) {
        sum = 0u; cnt = 0u; mine = 0u;
#pragma unroll
        for (unsigned j = 0; j < 16; ++j) { const unsigned c = xb_ld(&bar[XB_XCNT(j)]); sum += c; cnt += (c > 0u) ? 1u : 0u; mine = (j == x) ? c : mine; }
        if (sum == G) break;
        __builtin_amdgcn_s_sleep(1);
        if ((++sp & 255u) == 0u) { if (xb_ld(&bar[XB_TMO])) break; if (sp > XB_SPIN_CAP) { atomicAdd(&bar[XB_TMO], 1u); break; } }
    }
    nloc = mine > 0u ? mine : 1u; nx = cnt > 0u ? cnt : 1u;
}

__device__ __forceinline__ void xcd_barrier(const XcdBarrier& b) {
    asm volatile("s_waitcnt vmcnt(0)" ::: "memory");
    __syncthreads();
    if (xb_is_t0(b.w0)) {
        unsigned* bar = b.bar;
        __builtin_amdgcn_s_waitcnt(0);
        unsigned nloc = b.st[0], nx = b.st[1];
        if (nloc == 0u) { xcd_barrier_complete(bar, b.x, nloc, nx, b.G); b.st[0] = nloc; b.st[1] = nx; }
        const unsigned old = xb_add(&bar[XB_XSUB(b.x)], 1u);
        const unsigned gen = old / nloc;
        if (old + 1u == (gen + 1u) * nloc) {
            __builtin_amdgcn_fence(__ATOMIC_RELEASE, "agent");
            asm volatile("s_waitcnt vmcnt(0)" ::: "memory");
            const unsigned og = xb_add(&bar[XB_TOP], 1u);
            const unsigned tg = og / nx;
            if (og + 1u == (tg + 1u) * nx) xb_add(&bar[XB_TOPGEN], 1u);
            else XB_SPIN(xb_ld(&bar[XB_TOPGEN]) == tg, bar);
            __builtin_amdgcn_fence(__ATOMIC_ACQUIRE, "agent");
            xb_add(&bar[XB_XGEN(b.x)], 1u);
            asm volatile("s_waitcnt vmcnt(0)" ::: "memory");
        } else {
            XB_SPIN(xb_ld(&bar[XB_XGEN(b.x)]) == gen, bar);
            __builtin_amdgcn_fence(__ATOMIC_ACQUIRE, "agent");
            asm volatile("s_waitcnt vmcnt(0)" ::: "memory");
        }
    }
    __syncthreads();
}


__device__ __forceinline__ void attention_phase(Frame& F, const Args& a, int l, char* lds, const Str& T) {
    using abf = attn_body::bf16;
    const abf* proj = (const abf*)(a.ws + WS_PROJ);
    abf* mix = (abf*)(a.ws + WS_XN);
    const float* nbkp = (const float*)(a.ws + WS_NBKP); const float* nbks = (const float*)(a.ws + WS_NBKS);
    const int nsu = (T.rowsP / SEQ) * 16, bh0 = (T.rowP0 / SEQ) * 8;
    float skip_thr, floorz;
    { float gq = fabsf(a.in[10][l * 64 + F.lane]), gk = fabsf(a.in[11][l * 64 + F.lane]);
#pragma unroll
      for (int o = 1; o < 64; o <<= 1) { gq = fmaxf(gq, shx(gq, o, F.lane)); gk = fmaxf(gk, shx(gk, o, F.lane)); }
      const float qkmax = attn_body::C2 * 64.0f * gq * gk * 1.02f; floorz = fminf(0.0f, 100.0f - qkmax); skip_thr = qkmax - floorz + 134.0f + 2.0f; }
    const int NX = (T.GS % 8 == 0) ? 8 : 1;
    const int x = (NX == 8) ? (T.cs / (T.GS / 8)) : 0;
    const int nbh = (T.rowsP / SEQ) * 8 / NX, nbs = T.SBs * 8 / NX;
    const int NU = nbs + nbh * 16;
    unsigned* qcnt = (unsigned*)(a.ws + WS_BAR) + 8192 + (l * 8 + x) * 64 + T.s * 1024;
    volatile LAS int* slot = (volatile LAS int*)(F.lds + RING_BYTES + 1024);
    if (xb_is_t0(F.wave0)) *(volatile LAS float*)(F.lds + RING_BYTES + 1040) = floorz;
    (void)nsu;
#pragma unroll 1
    for (int it = 0;; ++it) {
        if (xb_is_t0(F.wave0)) slot[it & 1] = (int)__hip_atomic_fetch_add(qcnt, 1u, __ATOMIC_RELAXED, __HIP_MEMORY_SCOPE_AGENT);
        __syncthreads();
        const int j = slot[it & 1];
        if (j >= NU) break;
        {
            attn_body::AUnit U;
            if (j >= nbs) {
                const int jj = j - nbs, qb = 15 - jj / nbh;
                const int bh = bh0 + x * nbh + jj % nbh, b = bh >> 3, h = bh & 7;
                const size_t r0 = (size_t)b * SEQ + (size_t)qb * 256;
                U.Q = proj + r0 * PP + C_Q + h * 64; U.K = proj + (size_t)b * SEQ * PP + C_K + h * 64; U.V = proj + (size_t)b * SEQ * PP + C_V + h * 64;
                U.nbk = nbkp + (size_t)bh * SEQ; U.O = mix + r0 * DM + 256 + h * 64; U.G = proj + r0 * PP + C_AG + h * 64;
                U.kp = PP; U.NT = 4 * qb + 4; U.qoff = qb * 256; U.nvalid = 256;
            } else {
                const int bh = T.sb0 * 8 + x * nbs + j, b = bh >> 3, h = bh & 7;
                const size_t r0 = (size_t)MP + (size_t)b * ST;
                const size_t kb = ((size_t)(l * SB + b) * KSROWS) * 512 + h * 64;
                U.Q = proj + r0 * PP + C_Q + h * 64; U.K = (const abf*)(a.ws + WS_KS) + kb; U.V = (const abf*)(a.ws + WS_VS) + kb;
                U.nbk = nbks + (size_t)bh * NBKS; U.O = mix + r0 * DM + 256 + h * 64; U.G = proj + r0 * PP + C_AG + h * 64;
                U.kp = 512; U.NT = KSROWS / 64; U.qoff = PAST; U.nvalid = ST;
            }
            { const int tl = F.lane; const float ref = U.nbk[U.qoff];
              const float far = (tl < U.NT - 4) ? U.nbk[64 * tl + 63] : ref;
              const unsigned long long dead = __ballot((tl < U.NT - 4) && (ref - far > skip_thr));
              int D = (int)__builtin_ctzll(~dead) & ~1; D = __builtin_amdgcn_readfirstlane(D);
              if (D > U.NT - 4) D = (U.NT - 4) & ~1;
              U.K += (size_t)D * 64 * U.kp; U.V += (size_t)D * 64 * U.kp; U.nbk += D * 64; U.NT -= D; U.qoff -= D * 64; }
            if (F.wave0 * 32 < U.nvalid) attn_body::attn_unit<8>(U, lds, F.wave0); else attn_body::attn_unit_helper(U, lds, F.wave0);
        }
    }
    __syncthreads();
}

__global__ void __launch_bounds__(NWAVES * 64, 2) mega_fwd(Args args) {
    extern __shared__ __attribute__((aligned(16))) unsigned char lds[];
    cg::grid_group grid = cg::this_grid();
    Frame F;
    F.lds = (LAS unsigned char*)lds;
    F.wave0 = __builtin_amdgcn_readfirstlane((int)threadIdx.x >> 6); FRAME_REFRESH(F);
    F.G = gridDim.x; { const int bx = blockIdx.x; F.vcu = (F.G % 8 == 0) ? (bx % 8) * (F.G / 8) + bx / 8 : bx; }
    const int NS = 1;
    Str T; Str T0;
    { const int bx = blockIdx.x, xi = bx / 8, xc = bx % 8;
      T.s = NS == 2 ? (xi & 1) : 0; T.GS = F.G / NS; T.cs = NS == 2 ? (xc * (F.G / 16) + (xi >> 1)) : F.vcu; T.cg = NS == 2 ? ((xi >> 1) * 8 + xc) : bx;
      T.rowsP = MP / NS; T.rowP0 = T.s * T.rowsP; T.SBs = SB / NS; T.sb0 = T.s * T.SBs;
      T0.s = 0; T0.GS = F.G; T0.cs = F.vcu; T0.cg = bx; T0.rowsP = MP; T0.rowP0 = 0; T0.SBs = SB; T0.sb0 = 0; }
    unsigned* barw = (unsigned*)(args.ws + WS_BAR) + T.s * 4096;
    volatile LAS unsigned* barst = (volatile LAS unsigned*)(F.lds + RING_BYTES + 512);
#define SEAM(k) do { xcd_barrier(bar); } while (0)
    XcdBarrier bar; bar.w0 = F.wave0; bar.bar = barw; bar.x = 0; bar.st = barst; bar.G = (unsigned)T.GS;
    if (threadIdx.x < 2) barst[threadIdx.x] = 0u;
    if (blockIdx.x == 0) for (int i_ = threadIdx.x; i_ < 2 * 4096 + 2048; i_ += NWAVES * 64) ((unsigned*)(args.ws + WS_BAR))[i_] = 0u;
    __syncthreads();
    unsigned char* ws = args.ws;
    float* out = args.out;

    for (int r_ = 0; r_ < REP_P0; ++r_) { p0_prologue(F, args); __syncthreads(); }
    for (int r_ = 0; r_ < REP_PA; ++r_) pa_phase(F, args, 0, args.in[0], args.in[1], T0);
    grid.sync();
    bar = xcd_barrier_post(barw, barst, F.wave0, (unsigned)T.GS);
    if (T.s == 1) stagger_wait(1);
#pragma unroll 1
    for (int l = 0; l < NL; ++l) {
        {
            FRAME_REFRESH(F);
            scan_phase(F, args, l, T);
            { const int nscan = (T.rowsP / SEQ) * 8 + T.SBs * 8;
              const int nfree = T.GS > nscan ? T.GS - nscan : T.GS; const int w0 = ((T.GS > nscan ? T.cs - nscan : T.cs)) * NWAVES + F.wave;
              if (w0 >= 0) for (int it = w0; it < T.SBs * (PP / 64); it += nfree * NWAVES) small_inproj_item(args, l, T.sb0 + it / (PP / 64), it % (PP / 64), F.lane);
              __syncthreads(); }
            pg8::Gemm g{(const bf16*)(ws + WS_XN) + (size_t)T.rowP0 * DM, (const bf16*)(ws + WS_WIN) + (size_t)l * PP * DM, T.rowsP, PP, DM};
            pg8::StaticOrder S; S.init(T.rowsP, PP, T.GS, T.cg);
            pg8::EpiIn E;
            E.proj = (bf16*)(ws + WS_PROJ); E.ks = (bf16*)(ws + WS_KS) + (size_t)l * SB * KSROWS * 512; E.vs = (bf16*)(ws + WS_VS) + (size_t)l * SB * KSROWS * 512;
            E.outk_p = out + O_KP + (size_t)l * MP * 512; E.outv_p = out + O_VP + (size_t)l * MP * 512;
            E.outk_s = out + O_KS + (size_t)l * MS * 512; E.outv_s = out + O_VS + (size_t)l * MS * 512;
            E.qg = args.in[10] + l * 64; E.kg = args.in[11] + l * 64; E.row0 = T.rowP0;
            for (int r_ = 0; r_ < REP_GIN; ++r_) pg8::gemm_phase<pg8::EpiIn, pg8::StaticOrder, true, true>(F.lds, g, S, E, F.tid);
        }
        SEAM(0);
        {
            FRAME_REFRESH(F);
            for (int r_ = 0; r_ < REP_MIX; ++r_) mixer_phase(F, args, l, T);
            __syncthreads();
            for (int r_ = 0; r_ < REP_ATTN; ++r_) attention_phase(F, args, l, (char*)lds, T);
        }
        SEAM(1);
        {
            FRAME_REFRESH(F);
            { const int gw = T.cs * NWAVES + F.wave;
              for (int it = gw; it < T.SBs * (DM / 64); it += T.GS * NWAVES) small_outproj_item(args, l, T.sb0 + it / (DM / 64), it % (DM / 64), F.lane, l == 0 ? args.in[1] : out + O_YS, out + O_YS);
              __syncthreads(); }
            pg8::Gemm g{(const bf16*)(ws + WS_XN) + (size_t)T.rowP0 * DM, (const bf16*)(ws + WS_WOUT) + (size_t)l * DM * DM, T.rowsP, DM, DM};
            pg8::StaticOrder S; S.init(T.rowsP, DM, T.GS, T.cg);
            if (l == 0) { pg8::EpiOutB E; E.base_p = args.in[0]; E.out_b = (bf16*)(ws + WS_X1B); E.row0 = T.rowP0;
                for (int r_ = 0; r_ < REP_GOUT0; ++r_) pg8::gemm_phase<pg8::EpiOutB, pg8::StaticOrder, true, true>(F.lds, g, S, E, F.tid); }
            else { pg8::EpiOutF E; E.base_b = (const bf16*)(ws + WS_X1B); E.out_p = out + O_YP; E.row0 = T.rowP0;
                pg8::gemm_phase<pg8::EpiOutF, pg8::StaticOrder, true, true>(F.lds, g, S, E, F.tid); }
        }
        if (l + 1 < NL) {
            SEAM(2);
            { FRAME_REFRESH(F); for (int r_ = 0; r_ < REP_PA; ++r_) pa_phase(F, args, l + 1, out + O_YP, out + O_YS, T, (const bf16*)(ws + WS_X1B)); }
            SEAM(3);
        }
    }
#undef SEAM
}

#ifndef MK_MULTI
#define MK_MULTI 0
#endif
constexpr int N_PHASES = 8;

extern "C" void kernel_launch(void* const* d_in, const int* in_sizes, int n_in, void* d_out, int out_size, void* d_ws, size_t ws_size, hipStream_t stream) {
    static int grid = 0;
    if (grid == 0) {
        if (n_in != 16 || (size_t)out_size != O_END || ws_size < WS_END) { fprintf(stderr, "kernel_launch: shape mismatch: n_in %d out %d (want %zu) ws %zu (want %zu)\n", n_in, out_size, (size_t)O_END, ws_size, (size_t)WS_END); grid = -1; return; }
        int dev = 0, cus = 0, per_cu = 0;
        if (hipGetDevice(&dev) != hipSuccess || hipDeviceGetAttribute(&cus, hipDeviceAttributeMultiprocessorCount, dev) != hipSuccess) { grid = -1; return; }
        if (hipFuncSetAttribute((const void*)mega_fwd, hipFuncAttributeMaxDynamicSharedMemorySize, LDS_BYTES) != hipSuccess) { fprintf(stderr, "kernel_launch: hipFuncSetAttribute failed\n"); grid = -1; return; }
        if (hipOccupancyMaxActiveBlocksPerMultiprocessor(&per_cu, (const void*)mega_fwd, NWAVES * 64, LDS_BYTES) != hipSuccess || per_cu < 1) { fprintf(stderr, "kernel_launch: occupancy query says %d\n", per_cu); per_cu = 1; }
        (void)hipGetLastError();
        grid = cus * 1;
    }
    if (grid < 0) return;
    Args a{};
    for (int i = 0; i < 16; ++i) a.in[i] = (const float*)d_in[i];
    a.out = (float*)d_out; a.ws = (unsigned char*)d_ws;
#if MK_MULTI
    for (int p = 0; p < N_PHASES; ++p) { a.ph_lo = p; a.ph_hi = p + 1; hipLaunchKernelGGL(mega_fwd, dim3(grid), dim3(NWAVES * 64), LDS_BYTES, stream, a); }
#else
    a.ph_lo = 0; a.ph_hi = N_PHASES;
    void* kargs[] = {&a};
    hipError_t e = hipLaunchCooperativeKernel((const void*)mega_fwd, dim3(grid), dim3(NWAVES * 64), kargs, LDS_BYTES, stream);
    if (e != hipSuccess) fprintf(stderr, "cooperative launch failed: %s (grid %d)\n", hipGetErrorString(e), grid);
#endif
}
```

```cpp
#include <hip/hip_runtime.h>
#include <hip/hip_cooperative_groups.h>
#include <hip/hip_bf16.h>
#include <cstdio>
#include <cstdint>
#include <cmath>
namespace pg8 {
#define PG8_LAS __attribute__((address_space(3)))
typedef unsigned short bf16_t;
typedef short bf16x8 __attribute__((ext_vector_type(8)));
typedef float f32x4 __attribute__((ext_vector_type(4)));
typedef unsigned u32x4 __attribute__((ext_vector_type(4)));
constexpr int BM = 256, BK = 64, HALF = 128, HTB = HALF * BK * 2  , STAGE_BYTES = 8 * HTB, NXCD = 8, WGM = 8;

__host__ __device__ __forceinline__ int lds_byte(int r, int c) { const int st = (r >> 4) * 2 + (c >> 5), rr = r & 15, cc = c & 31, ob = rr * 64 + cc * 2; return st * 1024 + (ob ^ (((ob >> 9) & 1) << 5)); }
__host__ __device__ __forceinline__ void stage_rc(int b, int& R, int& C) { const int st = b / 1024, sb = b % 1024, swz = sb ^ (((sb >> 9) & 1) << 5); R = (st >> 1) * 16 + swz / 64; C = (st & 1) * 32 + (swz % 64) / 2; }
__host__ __device__ __forceinline__ int perm32(int rho) { const int n = rho >> 4, i = rho & 15; return 8 * (i >> 2) + 4 * n + (i & 3); }

struct Unit { int pm, pn; };
struct Gemm { const bf16_t* A; const bf16_t* Bt; int M, N, K; };

struct StaticOrder {
    int nM, nN, nwg, G, c;
    __host__ __device__ void init(int M, int N, int G_, int c_) { nM = M / BM; nN = N / BM; nwg = nM * nN; G = G_; c = c_; }
    __host__ __device__ bool next(int i, Unit& u) const {
        const long L = (long)i * G + c; if (L >= nwg) return false;
        int wgid = (int)L; { const int q = nwg / NXCD, r = nwg % NXCD, xcd = wgid % NXCD, off = wgid / NXCD; wgid = (xcd < r ? xcd * (q + 1) : r * (q + 1) + (xcd - r) * q) + off; }
        const int nig = WGM * nN, gid = wgid / nig, fm = gid * WGM, gsz = (nM - fm) < WGM ? (nM - fm) : WGM;
        u.pm = fm + ((wgid % nig) % gsz); u.pn = (wgid % nig) / gsz;
        if (nN == 14) u.pn = (int)((0xD7CBA598362140ULL >> (4 * u.pn)) & 15ULL);
        return true;
    }
    __device__ __forceinline__ void a_ready(const Unit&) const {}
    __device__ __forceinline__ void done(const Unit&) const {}
};

__device__ __forceinline__ unsigned cvt_pk_bf16(float lo, float hi) { unsigned r; asm volatile("v_cvt_pk_bf16_f32 %0, %1, %2" : "=v"(r) : "v"(lo), "v"(hi)); return r; }
typedef float f32x2 __attribute__((ext_vector_type(2)));
constexpr int E_MP = 65536, E_PP = 3584, E_KSROWS = 2176, E_PAST = 2048;
constexpr float E_C2 = 0.125f * 1.4426950408889634f;
struct EpiIn {
    static constexpr bool PERM = true, AFTER_DRAIN = false;
    bf16_t* proj; bf16_t* ks; bf16_t* vs; float* outk_p; float* outv_p; float* outk_s; float* outv_s; const float* qg; const float* kg; int row0;
    __device__ __forceinline__ void operator()(const f32x4 (&acc)[2][2][4][2], const Unit& u, int wr, int wc, int fr, int fq) const {
        const int pn = u.pn; const bool samp = false;
        const int nai = samp ? 1 : 2;
        if (pn >= 2 && pn <= 5) {
            const bool isq = pn < 4; const int head = (pn & 1) * 4 + wc;
            const float* g = isq ? qg : kg;
            f32x4 gv[2][2];
#pragma unroll
            for (int bj = 0; bj < 2; ++bj)
#pragma unroll
                for (int n = 0; n < 2; ++n) gv[bj][n] = *(const f32x4*)(g + 32 * bj + 8 * fq + 4 * n);
#pragma unroll
            for (int ai = 0; ai < 2; ++ai) if (ai < nai)
#pragma unroll
                for (int m = 0; m < 4; ++m) {
                    const int row = row0 + u.pm * BM + ai * HALF + wr * 64 + m * 16 + fr;
                    float ss = 0.f;
#pragma unroll
                    for (int bj = 0; bj < 2; ++bj)
#pragma unroll
                        for (int n = 0; n < 2; ++n) { const f32x4 x = acc[ai][bj][m][n]; ss += (x[0] * x[0] + x[1] * x[1]) + (x[2] * x[2] + x[3] * x[3]); }
                    { const int ln = fr + 16 * fq; ss += __int_as_float(__builtin_amdgcn_ds_bpermute((ln ^ 16) << 2, __float_as_int(ss))); ss += __int_as_float(__builtin_amdgcn_ds_bpermute((ln ^ 32) << 2, __float_as_int(ss))); }
                    float rs = __builtin_amdgcn_rsqf(ss * (1.0f / 64.0f) + 1e-6f);
                    const float rq = rs * E_C2;
#pragma unroll
                    for (int bj = 0; bj < 2; ++bj) {
                        const f32x4 k0 = acc[ai][bj][m][0] * rs * gv[bj][0], k1 = acc[ai][bj][m][1] * rs * gv[bj][1];
                        const int col = head * 64 + 32 * bj + 8 * fq;
                        if (isq) { const f32x4 v0 = acc[ai][bj][m][0] * rq * gv[bj][0], v1 = acc[ai][bj][m][1] * rq * gv[bj][1];
                            u32x4 w; w.x = cvt_pk_bf16(v0[0], v0[1]); w.y = cvt_pk_bf16(v0[2], v0[3]); w.z = cvt_pk_bf16(v1[0], v1[1]); w.w = cvt_pk_bf16(v1[2], v1[3]);
                            *(u32x4*)(proj + (size_t)row * E_PP + 512 + col) = w; }
                        else { u32x4 w; w.x = cvt_pk_bf16(k0[0], k0[1]); w.y = cvt_pk_bf16(k0[2], k0[3]); w.z = cvt_pk_bf16(k1[0], k1[1]); w.w = cvt_pk_bf16(k1[2], k1[3]);
                            if (!samp) { *(u32x4*)(proj + (size_t)row * E_PP + 1024 + col) = w; float* o = outk_p + (size_t)row * 512 + col; __builtin_nontemporal_store(k0, (f32x4*)o); __builtin_nontemporal_store(k1, (f32x4*)(o + 4)); }
                            else { const int lr = row - E_MP, b = lr >> 4, t = lr & 15; *(u32x4*)(ks + ((size_t)b * E_KSROWS + E_PAST + t) * 512 + col) = w; float* o = outk_s + (size_t)lr * 512 + col; *(f32x4*)o = k0; *(f32x4*)(o + 4) = k1; } }
                    }
                }
        } else if (pn == 6 || pn == 7) {
#pragma unroll
            for (int ai = 0; ai < 2; ++ai) if (ai < nai)
#pragma unroll
                for (int m = 0; m < 4; ++m) {
                    const int row = row0 + u.pm * BM + ai * HALF + wr * 64 + m * 16 + fr;
#pragma unroll
                    for (int bj = 0; bj < 2; ++bj) {
                        const f32x4 v0 = acc[ai][bj][m][0], v1 = acc[ai][bj][m][1];
                        const int col = (pn - 6) * 256 + 128 * bj + 32 * wc + 8 * fq;
                        u32x4 w; w.x = cvt_pk_bf16(v0[0], v0[1]); w.y = cvt_pk_bf16(v0[2], v0[3]); w.z = cvt_pk_bf16(v1[0], v1[1]); w.w = cvt_pk_bf16(v1[2], v1[3]);
                        if (!samp) { *(u32x4*)(proj + (size_t)row * E_PP + 1536 + col) = w; float* o = outv_p + (size_t)row * 512 + col; __builtin_nontemporal_store(v0, (f32x4*)o); __builtin_nontemporal_store(v1, (f32x4*)(o + 4)); }
                        else { const int lr = row - E_MP, b = lr >> 4, t = lr & 15; *(u32x4*)(vs + ((size_t)b * E_KSROWS + E_PAST + t) * 512 + col) = w; float* o = outv_s + (size_t)lr * 512 + col; *(f32x4*)o = v0; *(f32x4*)(o + 4) = v1; }
                    }
                }
        } else {
#pragma unroll
            for (int ai = 0; ai < 2; ++ai) if (ai < nai)
#pragma unroll
                for (int m = 0; m < 4; ++m) {
                    bf16_t* rowp = proj + (size_t)(row0 + u.pm * BM + ai * HALF + wr * 64 + m * 16 + fr) * E_PP + pn * BM + wc * 32 + 8 * fq;
#pragma unroll
                    for (int bj = 0; bj < 2; ++bj) { const f32x4 v0 = acc[ai][bj][m][0], v1 = acc[ai][bj][m][1];
                        u32x4 w; w.x = cvt_pk_bf16(v0[0], v0[1]); w.y = cvt_pk_bf16(v0[2], v0[3]); w.z = cvt_pk_bf16(v1[0], v1[1]); w.w = cvt_pk_bf16(v1[2], v1[3]);
                        *(u32x4*)(rowp + bj * HALF) = w; }
                }
        }
    }
};
struct EpiOut {
    static constexpr bool PERM = false, AFTER_DRAIN = false;
    const float* base_p; const float* base_s; float* out_p; float* out_s; int row0;
    __device__ __forceinline__ void operator()(const f32x4 (&acc)[2][2][4][2], const Unit& u, int wr, int wc, int fr, int fq) const {
        const int col0 = u.pn * BM + wc * 32 + 4 * fq;
#pragma unroll
        for (int ai = 0; ai < 2; ++ai) {
            f32x4 pre[4][2][2];
            const size_t off0 = (size_t)(row0 + u.pm * BM + ai * HALF + wr * 64 + fr) * 1024 + col0;
#pragma unroll
            for (int m = 0; m < 4; ++m)
#pragma unroll
                for (int bj = 0; bj < 2; ++bj)
#pragma unroll
                    for (int n = 0; n < 2; ++n) pre[m][bj][n] = *(const f32x4*)(base_p + off0 + (size_t)m * 16 * 1024 + bj * HALF + n * 16);
            asm volatile("" ::: "memory");
#pragma unroll
            for (int m = 0; m < 4; ++m)
#pragma unroll
                for (int bj = 0; bj < 2; ++bj)
#pragma unroll
                    for (int n = 0; n < 2; ++n) *(f32x4*)(out_p + off0 + (size_t)m * 16 * 1024 + bj * HALF + n * 16) = pre[m][bj][n] + acc[ai][bj][m][n];
            asm volatile("" ::: "memory");
        }
    }
};

struct EpiOutB {
    static constexpr bool PERM = true, AFTER_DRAIN = false;
    const float* base_p; bf16_t* out_b; int row0;
    __device__ __forceinline__ void operator()(const f32x4 (&acc)[2][2][4][2], const Unit& u, int wr, int wc, int fr, int fq) const {
        const int col0 = u.pn * BM + wc * 32 + 8 * fq;
#pragma unroll
        for (int ai = 0; ai < 2; ++ai) {
            f32x4 pre[4][2][2];
            const size_t off0 = (size_t)(row0 + u.pm * BM + ai * HALF + wr * 64 + fr) * 1024 + col0;
#pragma unroll
            for (int m = 0; m < 4; ++m)
#pragma unroll
                for (int bj = 0; bj < 2; ++bj)
#pragma unroll
                    for (int n = 0; n < 2; ++n) pre[m][bj][n] = *(const f32x4*)(base_p + off0 + (size_t)m * 16 * 1024 + bj * HALF + n * 4);
            asm volatile("" ::: "memory");
#pragma unroll
            for (int m = 0; m < 4; ++m)
#pragma unroll
                for (int bj = 0; bj < 2; ++bj) { const f32x4 v0 = pre[m][bj][0] + acc[ai][bj][m][0], v1 = pre[m][bj][1] + acc[ai][bj][m][1];
                    u32x4 w; w.x = cvt_pk_bf16(v0[0], v0[1]); w.y = cvt_pk_bf16(v0[2], v0[3]); w.z = cvt_pk_bf16(v1[0], v1[1]); w.w = cvt_pk_bf16(v1[2], v1[3]);
                    *(u32x4*)(out_b + off0 + (size_t)m * 16 * 1024 + bj * HALF) = w; }
            asm volatile("" ::: "memory");
        }
    }
};
struct EpiOutF {
    static constexpr bool PERM = true, AFTER_DRAIN = false;
    const bf16_t* base_b; float* out_p; int row0;
    __device__ __forceinline__ void operator()(const f32x4 (&acc)[2][2][4][2], const Unit& u, int wr, int wc, int fr, int fq) const {
        const int col0 = u.pn * BM + wc * 32 + 8 * fq;
#pragma unroll
        for (int ai = 0; ai < 2; ++ai) {
            u32x4 pre[4][2];
            const size_t off0 = (size_t)(row0 + u.pm * BM + ai * HALF + wr * 64 + fr) * 1024 + col0;
#pragma unroll
            for (int m = 0; m < 4; ++m)
#pragma unroll
                for (int bj = 0; bj < 2; ++bj) pre[m][bj] = *(const u32x4*)(base_b + off0 + (size_t)m * 16 * 1024 + bj * HALF);
            asm volatile("" ::: "memory");
#pragma unroll
            for (int m = 0; m < 4; ++m)
#pragma unroll
                for (int bj = 0; bj < 2; ++bj) { const u32x4 p = pre[m][bj];
                    const f32x4 b0 = (f32x4){__uint_as_float(p.x << 16), __uint_as_float(p.x & 0xffff0000u), __uint_as_float(p.y << 16), __uint_as_float(p.y & 0xffff0000u)};
                    const f32x4 b1 = (f32x4){__uint_as_float(p.z << 16), __uint_as_float(p.z & 0xffff0000u), __uint_as_float(p.w << 16), __uint_as_float(p.w & 0xffff0000u)};
                    float* o = out_p + off0 + (size_t)m * 16 * 1024 + bj * HALF;
                    *(f32x4*)o = b0 + acc[ai][bj][m][0]; *(f32x4*)(o + 4) = b1 + acc[ai][bj][m][1]; }
            asm volatile("" ::: "memory");
        }
    }
};
template <class Epi, class Sched, bool ALIGN_EPI = false, bool SP2 = false>
__device__ __forceinline__ void gemm_phase(PG8_LAS unsigned char* lds, const Gemm g, const Sched& S, const Epi& E, int tid_in) {
    int tid_ = tid_in; asm volatile("" : "+v"(tid_));
    const int tid = tid_, wid = __builtin_amdgcn_readfirstlane(tid >> 6), lane = tid & 63, wr = wid >> 2, wc = wid & 3, fr = lane & 15, fq = lane >> 4;
    const int K = g.K, nt = K / BK;
    unsigned voffA[2], voffB[2];
#pragma unroll
    for (int i = 0; i < 2; ++i) { int R, C; stage_rc(tid * 16 + i * 8192, R, C); const int Rb = Epi::PERM ? ((R & ~31) + perm32(R & 31)) : R;
        voffA[i] = (unsigned)(R * K + C) * 2u; voffB[i] = (unsigned)(Rb * K + C) * 2u; }
    const size_t kstep = (size_t)(BK * 2);
    const size_t hstep = (size_t)HALF * K * 2;
    const size_t tstep = 2 * hstep;
    const unsigned ldsw = (unsigned)wid * 1024u;
    const int aoff = lds_byte(wr * 64 + fr, fq * 8), boff = lds_byte(wc * 32 + fr, fq * 8);
#define PG8_SA(b, h) (((b) * 2 + (h)) * HTB)
#define PG8_SB(b, h) ((4 + (b) * 2 + (h)) * HTB)
#define PG8_STAGE(bufoff, gbase, voff) do { _Pragma("unroll") for (int _i = 0; _i < 2; ++_i) \
        __builtin_amdgcn_global_load_lds((const unsigned*)((const char*)(gbase) + (voff)[_i]), (PG8_LAS unsigned*)(lds + (bufoff) + ldsw + _i * 8192), 16, 0, 0); } while (0)
#define PG8_LDA(dst, b, h) do { _Pragma("unroll") for (int m = 0; m < 4; ++m) _Pragma("unroll") for (int k = 0; k < 2; ++k) dst[m][k] = *(const PG8_LAS bf16x8*)(lds + PG8_SA(b, h) + aoff + m * 2048 + k * 1024); } while (0)
#define PG8_LDB(dst, b, h) do { _Pragma("unroll") for (int n = 0; n < 2; ++n) _Pragma("unroll") for (int k = 0; k < 2; ++k) dst[n][k] = *(const PG8_LAS bf16x8*)(lds + PG8_SB(b, h) + boff + n * 2048 + k * 1024); } while (0)
#define PG8_MMA(ai, bj, At, Bt) do { __builtin_amdgcn_s_setprio(1); _Pragma("unroll") for (int m = 0; m < 4; ++m) _Pragma("unroll") for (int n = 0; n < 2; ++n) _Pragma("unroll") for (int k = 0; k < 2; ++k) \
        acc[ai][bj][m][n] = __builtin_amdgcn_mfma_f32_16x16x32_bf16(Bt[n][k], At[m][k], acc[ai][bj][m][n], 0, 0, 0); __builtin_amdgcn_s_setprio(0); } while (0)
#define PG8_WAIT_V(n) asm volatile("s_waitcnt vmcnt(" #n ")" ::: "memory")
#define PG8_WAIT_L(n) asm volatile("s_waitcnt lgkmcnt(" #n ")" ::: "memory")
#define PG8_BAR __builtin_amdgcn_s_barrier()
#define PG8_SCHED __builtin_amdgcn_sched_barrier(0)
    Unit cur, nxt; int ui = 0;
    if (!S.next(0, cur)) return;
    f32x4 acc[2][2][4][2];
#pragma unroll
    for (int a = 0; a < 2; ++a)
#pragma unroll
        for (int b = 0; b < 2; ++b)
#pragma unroll
            for (int m = 0; m < 4; ++m)
#pragma unroll
                for (int n = 0; n < 2; ++n) acc[a][b][m][n] = (f32x4){0.f, 0.f, 0.f, 0.f};
    bf16x8 At[4][2], B0[2][2], B1[2][2];
    const char* cA = (const char*)g.A + (size_t)cur.pm * tstep; const char* cB = (const char*)g.Bt + (size_t)cur.pn * tstep;
    S.a_ready(cur);
    if constexpr (SP2) {
        PG8_STAGE(PG8_SB(0, 0), cB, voffB); PG8_STAGE(PG8_SB(0, 1), cB + hstep, voffB); PG8_STAGE(PG8_SA(0, 0), cA, voffA); PG8_STAGE(PG8_SA(0, 1), cA + hstep, voffA);
        if (wr == 1) PG8_BAR;
        PG8_WAIT_V(2); PG8_BAR;
        PG8_STAGE(PG8_SB(1, 0), cB + kstep, voffB); PG8_STAGE(PG8_SA(1, 0), cA + kstep, voffA); PG8_STAGE(PG8_SB(1, 1), cB + hstep + kstep, voffB);
        PG8_WAIT_V(6); PG8_BAR;
    } else {
        PG8_STAGE(PG8_SB(0, 0), cB, voffB); PG8_STAGE(PG8_SA(0, 0), cA, voffA); PG8_STAGE(PG8_SB(0, 1), cB + hstep, voffB); PG8_STAGE(PG8_SA(0, 1), cA + hstep, voffA);
        if (wr == 1) PG8_BAR;
        PG8_WAIT_V(4); PG8_BAR;
        PG8_STAGE(PG8_SB(1, 0), cB + kstep, voffB); PG8_STAGE(PG8_SA(1, 0), cA + kstep, voffA); PG8_STAGE(PG8_SB(1, 1), cB + hstep + kstep, voffB);
        PG8_WAIT_V(6); PG8_BAR;
    }
    for (;;) {
        const bool has_next = S.next(ui + 1, nxt);
        const char* nA = has_next ? (const char*)g.A + (size_t)nxt.pm * tstep : cA; const char* nB = has_next ? (const char*)g.Bt + (size_t)nxt.pn * tstep : cB;
        for (int t = 0; t < nt; t += 2) {
            const bool last = (t == nt - 2);
            const char* a1 = cA + (size_t)(t + 1) * kstep;
            const char* a2 = last ? nA : cA + (size_t)(t + 2) * kstep; const char* b2 = last ? nB : cB + (size_t)(t + 2) * kstep;
            const char* a3 = a2 + kstep; const char* b3 = b2 + kstep;
            if (last && has_next) S.a_ready(nxt);
            if constexpr (SP2) {
            PG8_LDB(B0, 0, 0); PG8_LDB(B1, 0, 1); PG8_SCHED; PG8_LDA(At, 0, 0); PG8_STAGE(PG8_SA(1, 1), a1 + hstep, voffA);
            PG8_WAIT_V(8); PG8_WAIT_L(0); PG8_BAR; PG8_MMA(0, 0, At, B0); PG8_MMA(0, 1, At, B1); PG8_BAR; PG8_SCHED;
            PG8_LDA(At, 0, 1); PG8_STAGE(PG8_SB(0, 0), b2, voffB); PG8_STAGE(PG8_SB(0, 1), b2 + hstep, voffB); PG8_STAGE(PG8_SA(0, 0), a2, voffA);
            PG8_WAIT_V(8); PG8_WAIT_L(0); PG8_BAR; PG8_MMA(1, 0, At, B0); PG8_MMA(1, 1, At, B1); PG8_BAR; PG8_SCHED;
            PG8_LDB(B0, 1, 0); PG8_LDB(B1, 1, 1); PG8_SCHED; PG8_LDA(At, 1, 0); PG8_STAGE(PG8_SA(0, 1), a2 + hstep, voffA);
            PG8_WAIT_V(8); PG8_WAIT_L(0); PG8_BAR; PG8_MMA(0, 0, At, B0); PG8_MMA(0, 1, At, B1); PG8_BAR; PG8_SCHED;
            PG8_LDA(At, 1, 1); PG8_STAGE(PG8_SB(1, 0), b3, voffB); PG8_STAGE(PG8_SB(1, 1), b3 + hstep, voffB); PG8_STAGE(PG8_SA(1, 0), a3, voffA);
            PG8_WAIT_V(8); PG8_WAIT_L(0); PG8_BAR; PG8_MMA(1, 0, At, B0); PG8_MMA(1, 1, At, B1); PG8_BAR; PG8_SCHED;
            } else {
            PG8_LDB(B0, 0, 0); PG8_SCHED; PG8_LDA(At, 0, 0); PG8_STAGE(PG8_SA(1, 1), a1 + hstep, voffA);
            PG8_WAIT_L(8); PG8_BAR; PG8_WAIT_L(0); PG8_MMA(0, 0, At, B0); PG8_BAR; PG8_SCHED;
            PG8_LDB(B1, 0, 1); PG8_STAGE(PG8_SB(0, 0), b2, voffB);
            PG8_BAR; PG8_WAIT_L(0); PG8_MMA(0, 1, At, B1); PG8_BAR;
            PG8_LDA(At, 0, 1); PG8_STAGE(PG8_SA(0, 0), a2, voffA);
            PG8_BAR; PG8_WAIT_L(0); PG8_MMA(1, 0, At, B0); PG8_BAR; PG8_SCHED;
            PG8_STAGE(PG8_SB(0, 1), b2 + hstep, voffB);
            PG8_WAIT_V(6); PG8_BAR; PG8_MMA(1, 1, At, B1); PG8_BAR;
            PG8_LDB(B0, 1, 0); PG8_SCHED; PG8_LDA(At, 1, 0); PG8_STAGE(PG8_SA(0, 1), a2 + hstep, voffA);
            PG8_WAIT_L(8); PG8_BAR; PG8_WAIT_L(0); PG8_MMA(0, 0, At, B0); PG8_BAR; PG8_SCHED;
            PG8_LDB(B1, 1, 1); PG8_STAGE(PG8_SB(1, 0), b3, voffB);
            PG8_BAR; PG8_WAIT_L(0); PG8_MMA(0, 1, At, B1); PG8_BAR;
            PG8_LDA(At, 1, 1); PG8_STAGE(PG8_SA(1, 0), a3, voffA);
            PG8_BAR; PG8_WAIT_L(0); PG8_MMA(1, 0, At, B0); PG8_BAR; PG8_SCHED;
            PG8_STAGE(PG8_SB(1, 1), b3 + hstep, voffB);
            PG8_WAIT_V(6); PG8_BAR; PG8_MMA(1, 1, At, B1); PG8_BAR;
            }
        }
        if constexpr (ALIGN_EPI) { if (wr == 0) PG8_BAR; }
        if constexpr (!Epi::AFTER_DRAIN) { E(acc, cur, wr, wc, fr, fq); S.done(cur); }
        if (!has_next) break;
#pragma unroll
        for (int a = 0; a < 2; ++a)
#pragma unroll
            for (int b = 0; b < 2; ++b)
#pragma unroll
                for (int m = 0; m < 4; ++m)
#pragma unroll
                    for (int n = 0; n < 2; ++n) acc[a][b][m][n] = (f32x4){0.f, 0.f, 0.f, 0.f};
        cur = nxt; cA = nA; cB = nB; ++ui;
        if constexpr (ALIGN_EPI) { if (wr == 1) PG8_BAR; }
    }
    PG8_WAIT_V(0);
    if constexpr (!ALIGN_EPI) { if (wr == 0) PG8_BAR; }
    PG8_BAR;
    if constexpr (Epi::AFTER_DRAIN) { E.fused(acc, cur, wr, wc, fr, fq, lds, wid, lane); S.done(cur); }
#undef PG8_SA
#undef PG8_SB
#undef PG8_STAGE
#undef PG8_LDA
#undef PG8_LDB
#undef PG8_MMA
#undef PG8_WAIT_V
#undef PG8_WAIT_L
#undef PG8_BAR
#undef PG8_SCHED
}
}
namespace attn_body {
using bf16=__hip_bfloat16;
using bf16x8=__attribute__((ext_vector_type(8)))short;
using s16x4=__attribute__((ext_vector_type(4)))short;
using f32x16=__attribute__((ext_vector_type(16)))float;
using f32x4a=__attribute__((ext_vector_type(4)))float;
using u32x4=__attribute__((ext_vector_type(4)))unsigned;
constexpr int D=64;
constexpr int NW=8,QBLK=32,QB=QBLK*NW,KVBLK=64;
constexpr int QP=3584, OP=1024, GP=3584;
__device__ __forceinline__ int crow(int r,int hi){return (r&3)+8*(r>>2)+4*hi;}
#define SBAR() __builtin_amdgcn_sched_barrier(0)
__device__ __forceinline__ void cmask(f32x16&p0,f32x16&p1,int koff,int qrel,int hi){
  const float NEG=-INFINITY; int kb=koff+4*hi;
  #pragma unroll
  for(int r=0;r<16;++r){int kv=kb+(r&3)+8*(r>>2); if(kv>qrel)p0[r]=NEG; if(kv+32>qrel)p1[r]=NEG;}
}
constexpr int NSLOT=3, SLOTB=8192;
constexpr int LDS_K=0, LDS_V=NSLOT*SLOTB, LDS_WS=2*NSLOT*SLOTB, LDS_OST=LDS_WS+NW*64*4, LDS_BIAS=LDS_OST+NW*4096, LDS_BYTES=LDS_BIAS+NW*NSLOT*256;
constexpr float C2=0.125f*1.4426950408889634f;
__device__ __forceinline__ void glds16(const void*gsrc,unsigned lds_dst){unsigned keep;
  asm volatile("s_mov_b32 %0, m0\n\ts_mov_b32 m0, %2\n\ts_nop 0\n\tglobal_load_lds_dwordx4 %1, off\n\ts_mov_b32 m0, %0":"=&s"(keep):"v"(gsrc),"s"(lds_dst):"memory");}
__device__ __forceinline__ void glds4(const void*gsrc,unsigned lds_dst){unsigned keep;
  asm volatile("s_mov_b32 %0, m0\n\ts_mov_b32 m0, %2\n\ts_nop 0\n\tglobal_load_lds_dword %1, off\n\ts_mov_b32 m0, %0":"=&s"(keep):"v"(gsrc),"s"(lds_dst):"memory");}
typedef float f32x2_t __attribute__((ext_vector_type(2))); typedef __bf16 bf16x2_t __attribute__((ext_vector_type(2)));
__device__ __forceinline__ unsigned cvtpk_s(float lo,float hi){f32x2_t v={lo,hi};bf16x2_t b=__builtin_convertvector(v,bf16x2_t);return __builtin_bit_cast(unsigned,b);}
#define WAIT_BAR(N) asm volatile("s_waitcnt vmcnt(" #N ") lgkmcnt(0)\n\ts_barrier":::"memory")
typedef __attribute__((address_space(3))) const char* lds_cptr;
typedef short v4i16_t __attribute__((ext_vector_type(4)));
#define LDSV(T,p) (*(const __attribute__((address_space(3))) T*)(p))
__device__ __forceinline__ void kload8(bf16x8*kf,lds_cptr kp){
  kf[0]=LDSV(bf16x8,kp);      kf[1]=LDSV(bf16x8,kp+512);
  kf[2]=LDSV(bf16x8,kp+2048); kf[3]=LDSV(bf16x8,kp+2560);
  kf[4]=LDSV(bf16x8,kp+4096); kf[5]=LDSV(bf16x8,kp+4608);
  kf[6]=LDSV(bf16x8,kp+6144); kf[7]=LDSV(bf16x8,kp+6656);
}
__device__ __forceinline__ void kload2(bf16x8*kf,lds_cptr kp,int j){ kf[2*j]=LDSV(bf16x8,kp+j*2048); kf[2*j+1]=LDSV(bf16x8,kp+j*2048+512); }
__device__ __forceinline__ s16x4 vtr(lds_cptr p){ return __builtin_bit_cast(s16x4,__builtin_amdgcn_ds_read_tr16_b64_v4i16((__attribute__((address_space(3))) v4i16_t*)p)); }
#define MX3(a,b,c) __builtin_fmaxf(__builtin_fmaxf((a),(b)),(c))
__device__ __forceinline__ float rowmax(const f32x16&p0,const f32x16&p1){
  float a=MX3(p0[0],p0[1],p1[0]),b=MX3(p0[2],p0[3],p1[1]);a=MX3(a,p1[2],p1[3]);
  #pragma unroll
  for(int r=4;r<16;r+=4){a=MX3(a,p0[r],p0[r+1]);b=MX3(b,p0[r+2],p0[r+3]);a=MX3(a,p1[r],p1[r+1]);b=MX3(b,p1[r+2],p1[r+3]);}
  float m=__builtin_fmaxf(a,b);
  auto rr=__builtin_amdgcn_permlane32_swap(__float_as_uint(m),__float_as_uint(m),false,false);
  return __builtin_fmaxf(__uint_as_float(rr[0]),__uint_as_float(rr[1]));
}
__device__ __forceinline__ void pv(f32x16*o,int vb,bf16x8 pa0,bf16x8 pa1,bf16x8 pa2,bf16x8 pa3){
  #pragma unroll
  for(int d0=0;d0<2;++d0){s16x4 lo[4],hi[4];
    #pragma unroll
    for(int ks=0;ks<4;++ks){
      asm volatile("ds_read_b64_tr_b16 %0,%1 offset:%c2":"=&v"(lo[ks]):"v"(vb),"i"(d0*4096+ks*1024):"memory");
      asm volatile("ds_read_b64_tr_b16 %0,%1 offset:%c2":"=&v"(hi[ks]):"v"(vb),"i"(d0*4096+ks*1024+512):"memory");}
    asm volatile("s_waitcnt lgkmcnt(0)":::"memory");SBAR();
    #define PK(k) (bf16x8){lo[k][0],lo[k][1],lo[k][2],lo[k][3],hi[k][0],hi[k][1],hi[k][2],hi[k][3]}
    o[d0]=__builtin_amdgcn_mfma_f32_32x32x16_bf16(pa0,PK(0),o[d0],0,0,0);
    o[d0]=__builtin_amdgcn_mfma_f32_32x32x16_bf16(pa1,PK(1),o[d0],0,0,0);
    o[d0]=__builtin_amdgcn_mfma_f32_32x32x16_bf16(pa2,PK(2),o[d0],0,0,0);
    o[d0]=__builtin_amdgcn_mfma_f32_32x32x16_bf16(pa3,PK(3),o[d0],0,0,0);
    #undef PK
  }
}
struct AUnit {
  const bf16* Q;
  const bf16* K;
  const bf16* V;
  const float* nbk;
  bf16* O;
  const bf16* G;
  int kp;
  int NT, qoff, nvalid;
};
#define FLOORZ_LDS_OFF (131072+1040)
template<int THRL> __device__ __forceinline__ void attn_unit(const AUnit&U,char*shm,int wave0){
  int l__; asm volatile("v_mbcnt_lo_u32_b32 %0, -1, 0\n\tv_mbcnt_hi_u32_b32 %0, -1, %0":"=v"(l__)); int tid_=wave0*64+l__; const int tid=tid_,lane=tid&63,r32=lane&31,hi=lane>>5; const int wid=__builtin_amdgcn_readfirstlane(tid>>6);
  const int KP=U.kp;
  const bf16*Qw=U.Q+(long)(wid*QBLK)*QP;
  const bf16*Kh=U.K,*Vh=U.V;
  const unsigned lds0=(unsigned)(uintptr_t)shm;
  float*wsf=(float*)(shm+LDS_WS)+wid*64;
  const bf16*ksrc=Kh+(long)lane*KP+wid*8;
  const bf16*vsrc=Vh+(long)(16*(wid&3)+(lane>>2))*KP+(wid>>2)*32+(lane&3)*8;
  const float*bsrc=U.nbk+lane;
  const unsigned kdst=lds0+LDS_K+wid*1024, vdst=lds0+LDS_V+wid*1024, bdst=lds0+LDS_BIAS+wid*(NSLOT*256);
  #define DMA_K(t,slot) do{ glds16(ksrc+(long)(t)*KVBLK*KP,(unsigned)__builtin_amdgcn_readfirstlane(kdst+(slot))); glds4(bsrc+(t)*KVBLK,(unsigned)__builtin_amdgcn_readfirstlane(bdst+((slot)>>5))); }while(0)
  #define DMA_V(t,slot) glds16(vsrc+(long)(t)*KVBLK*KP,(unsigned)__builtin_amdgcn_readfirstlane(vdst+(slot)))
  bf16x8 kf[8];
  const lds_cptr shm3=(lds_cptr)shm; const lds_cptr kp0=shm3+LDS_K+hi*1024+r32*16; const lds_cptr vp0=shm3+LDS_V+((lane>>4)&1)*32+(lane&3)*8+(4*hi+((lane&15)>>2))*64;
  const lds_cptr bp0=shm3+LDS_BIAS+wid*(NSLOT*256)+hi*16;
  const int NT=U.NT;
  DMA_K(0,0);DMA_V(0,0);DMA_K(1,SLOTB);
  bf16x8 qr[4];
  #pragma unroll
  for(int d0=0;d0<4;++d0)qr[d0]=*reinterpret_cast<const bf16x8*>(&Qw[(long)r32*QP+d0*16+hi*8]);
  const int qrel=wid*QBLK+r32;
  const float bq=-U.nbk[U.qoff+qrel];
  float nm=0.f,l_reg=0.f;f32x16 o[2];o[0]=f32x16{};o[1]=f32x16{};
  const int qoff=U.qoff;
  #define CMASK(P0,P1,t) do{ if((t)>=NT-4)cmask(P0,P1,64*(t)-qoff,qrel,hi);}while(0)
  #define BLD1(P0,P1,bp,g) do{ const f32x4a a_=LDSV(f32x4a,(bp)+(g)*32); const f32x4a b_=LDSV(f32x4a,(bp)+128+(g)*32); \
      P0[4*(g)]=a_[0];P0[4*(g)+1]=a_[1];P0[4*(g)+2]=a_[2];P0[4*(g)+3]=a_[3]; P1[4*(g)]=b_[0];P1[4*(g)+1]=b_[1];P1[4*(g)+2]=b_[2];P1[4*(g)+3]=b_[3]; }while(0)
  bool resc=false;
  #define RESC() do{ if(resc){ asm volatile("s_waitcnt lgkmcnt(0)":::"memory"); \
      _Pragma("unroll") for(int d_=0;d_<2;++d_) _Pragma("unroll") for(int r=0;r<16;++r)o[d_][r]*=wsf[crow(r,hi)]; } }while(0)
  f32x16 pA0,pA1,pB0,pB1;
  int sl_prev=0,sl_cur=0,sl_next=SLOTB;
  #define ROT() do{sl_prev=sl_cur;sl_cur=sl_next;sl_next=(sl_next==(NSLOT-1)*SLOTB)?0:sl_next+SLOTB;}while(0)
  DMA_K(2,2*SLOTB);
  WAIT_BAR(2);
  { BLD1(pA0,pA1,bp0,0);BLD1(pA0,pA1,bp0,1);BLD1(pA0,pA1,bp0,2);BLD1(pA0,pA1,bp0,3);
    #pragma unroll
    for(int d0=0;d0<4;++d0){
      const bf16x8 b0=LDSV(bf16x8,kp0+d0*2048);
      const bf16x8 b1=LDSV(bf16x8,kp0+d0*2048+512);
      pA0=__builtin_amdgcn_mfma_f32_32x32x16_bf16(b0,qr[d0],pA0,0,0,0);pA1=__builtin_amdgcn_mfma_f32_32x32x16_bf16(b1,qr[d0],pA1,0,0,0);}
  }
  CMASK(pA0,pA1,0);
  { const float rm=rowmax(pA0,pA1); const float z=rm+bq; const float mh=__builtin_fmaxf(z,*(const float*)(shm+FLOORZ_LDS_OFF)); nm=bq-mh;
    _Pragma("unroll") for(int r=0;r<16;++r){pA0[r]=__builtin_amdgcn_exp2f(pA0[r]+nm);pA1[r]=__builtin_amdgcn_exp2f(pA1[r]+nm);} }
  WAIT_BAR(0);
  DMA_K(3,0);DMA_V(1,SLOTB);
  ROT();
  kload8(kf,kp0+sl_cur);
  { const lds_cptr bp_=bp0+(sl_cur>>5); BLD1(pB0,pB1,bp_,0);BLD1(pB0,pB1,bp_,1);BLD1(pB0,pB1,bp_,2);BLD1(pB0,pB1,bp_,3); }
  WAIT_BAR(3);
  s16x4 vlo[8],vhi[8]; u32x4 pw0,pw1,pw2,pw3;
  #define PKW(P,B) cvtpk_s(P[B],P[B+1])
  #define PAF(k) __builtin_bit_cast(bf16x8,pw##k)
  #define VFR(i) (bf16x8){vlo[i][0],vlo[i][1],vlo[i][2],vlo[i][3],vhi[i][0],vhi[i][1],vhi[i][2],vhi[i][3]}
  #define PIN(x) asm volatile("":"+v"(x))
  #define GAPA(MF,A0,A1,A2,A3,W0,W1,PW) do{ MF; sacc+=A0; sacc+=A1; sacc+=A2; sacc+=A3; PIN(sacc); W0; W1; PIN(PW); SBAR(); }while(0)
  #define EX(v) __builtin_amdgcn_exp2f((v)+nm)
  #define GAPB(MF,X,B) do{ MF; X[B]=EX(X[B]); X[B+1]=EX(X[B+1]); X[B+2]=EX(X[B+2]); X[B+3]=EX(X[B+3]); PIN(X); SBAR(); }while(0)
  #define VRD(i) do{ vlo[i]=vtr(vp_+(((i)>>2)*4096+((i)&3)*1024)); vhi[i]=vtr(vp_+(((i)>>2)*4096+((i)&3)*1024+512)); }while(0)
  #define KRD(G,j) do{ if(G){ kload2(kf,kp0+sl_next,j); SBAR(); } }while(0)
  #define BRD(G,P0,P1,g) do{ if(G){ BLD1(P0,P1,bpn_,g); SBAR(); } }while(0)
  #define STEP(C0,C1,P0,P1,t,GK,GV,GL) do{ SBAR(); \
    const lds_cptr vp_=vp0+sl_prev; const lds_cptr bpn_=bp0+(sl_next>>5); \
    VRD(0); SBAR(); float sacc=(P0[0]+P0[1]); \
    GAPA(C0=__builtin_amdgcn_mfma_f32_32x32x16_bf16(kf[0],qr[0],C0,0,0,0), P0[2],P0[3],P0[4],P0[5],     pw0[0]=PKW(P0,0), pw0[1]=PKW(P0,2), pw0); \
    VRD(4); SBAR(); GAPA(C1=__builtin_amdgcn_mfma_f32_32x32x16_bf16(kf[1],qr[0],C1,0,0,0), P0[6],P0[7],P0[8],P0[9],     pw0[2]=PKW(P0,4), pw0[3]=PKW(P0,6), pw0); \
    VRD(1); SBAR(); GAPA(C0=__builtin_amdgcn_mfma_f32_32x32x16_bf16(kf[2],qr[1],C0,0,0,0),   P0[10],P0[11],P0[12],P0[13], pw1[0]=PKW(P0,8), pw1[1]=PKW(P0,10), pw1); \
    VRD(5); SBAR(); GAPA(C1=__builtin_amdgcn_mfma_f32_32x32x16_bf16(kf[3],qr[1],C1,0,0,0),   P0[14],P0[15],P1[0],P1[1],   pw1[2]=PKW(P0,12),pw1[3]=PKW(P0,14), pw1); \
    VRD(2); SBAR(); GAPA(C0=__builtin_amdgcn_mfma_f32_32x32x16_bf16(kf[4],qr[2],C0,0,0,0),   P1[2],P1[3],P1[4],P1[5],     pw2[0]=PKW(P1,0), pw2[1]=PKW(P1,2), pw2); \
    VRD(6); SBAR(); GAPA(C1=__builtin_amdgcn_mfma_f32_32x32x16_bf16(kf[5],qr[2],C1,0,0,0),   P1[6],P1[7],P1[8],P1[9],     pw2[2]=PKW(P1,4), pw2[3]=PKW(P1,6), pw2); \
    VRD(3); SBAR(); GAPA(C0=__builtin_amdgcn_mfma_f32_32x32x16_bf16(kf[6],qr[3],C0,0,0,0),   P1[10],P1[11],P1[12],P1[13], pw3[0]=PKW(P1,8), pw3[1]=PKW(P1,10), pw3); \
    VRD(7); SBAR(); GAPA(C1=__builtin_amdgcn_mfma_f32_32x32x16_bf16(kf[7],qr[3],C1,0,0,0),   P1[14],P1[15],0.f,0.f,       pw3[2]=PKW(P1,12),pw3[3]=PKW(P1,14), pw3); \
    l_reg+=sacc; \
    if(GK){DMA_K((t)+3,sl_cur);} if(GV){DMA_V((t)+1,sl_next);} \
    CMASK(C0,C1,t); \
    { float a=MX3(C0[0],C0[1],C1[0]),b=MX3(C0[2],C0[3],C1[1]); a=MX3(a,C1[2],C1[3]); \
      _Pragma("unroll") for(int r=4;r<16;r+=4){a=MX3(a,C0[r],C0[r+1]);b=MX3(b,C0[r+2],C0[r+3]);a=MX3(a,C1[r],C1[r+1]);b=MX3(b,C1[r+2],C1[r+3]);} \
      float rm=__builtin_fmaxf(a,b); { auto rr=__builtin_amdgcn_permlane32_swap(__float_as_uint(rm),__float_as_uint(rm),false,false); rm=__builtin_fmaxf(__uint_as_float(rr[0]),__uint_as_float(rr[1])); } \
      rm+=nm; resc=false; \
      if(__builtin_expect(__any(rm>(float)THRL),0)){ const float dl=__builtin_fmaxf(rm,0.f); nm-=dl; \
        const float f=__builtin_amdgcn_exp2f(-dl); l_reg*=f; { int l2_; asm volatile("v_mbcnt_lo_u32_b32 %0, -1, 0\n\tv_mbcnt_hi_u32_b32 %0, -1, %0":"=v"(l2_)); if(l2_<32)((float*)(shm+LDS_WS))[wid*64+l2_]=f; } resc=true; } } \
    SBAR(); \
    BRD(GL,P0,P1,0); GAPB(o[0]=__builtin_amdgcn_mfma_f32_32x32x16_bf16(PAF(0),VFR(0),o[0],0,0,0), C0,0); \
    BRD(GL,P0,P1,1); GAPB(o[1]=__builtin_amdgcn_mfma_f32_32x32x16_bf16(PAF(0),VFR(4),o[1],0,0,0), C0,4); \
    KRD(GL,0); GAPB(o[0]=__builtin_amdgcn_mfma_f32_32x32x16_bf16(PAF(1),VFR(1),o[0],0,0,0), C0,8); \
    KRD(GL,1); GAPB(o[1]=__builtin_amdgcn_mfma_f32_32x32x16_bf16(PAF(1),VFR(5),o[1],0,0,0), C0,12); \
    KRD(GL,2); GAPB(o[0]=__builtin_amdgcn_mfma_f32_32x32x16_bf16(PAF(2),VFR(2),o[0],0,0,0), C1,0); \
    KRD(GL,3); GAPB(o[1]=__builtin_amdgcn_mfma_f32_32x32x16_bf16(PAF(2),VFR(6),o[1],0,0,0), C1,4); \
    BRD(GL,P0,P1,2); GAPB(o[0]=__builtin_amdgcn_mfma_f32_32x32x16_bf16(PAF(3),VFR(3),o[0],0,0,0), C1,8); \
    BRD(GL,P0,P1,3); GAPB(o[1]=__builtin_amdgcn_mfma_f32_32x32x16_bf16(PAF(3),VFR(7),o[1],0,0,0), C1,12); \
    }while(0)
  int t=1;
  #undef CMASK
  #define CMASK(P0,P1,t) do{}while(0)
  for(;t+5<NT;t+=2){
    STEP(pB0,pB1,pA0,pA1,t,true,true,true);     WAIT_BAR(3); RESC(); ROT();
    STEP(pA0,pA1,pB0,pB1,t+1,true,true,true);   WAIT_BAR(3); RESC(); ROT();
  }
  #undef CMASK
  #define CMASK(P0,P1,t) do{ if((t)>=NT-4)cmask(P0,P1,64*(t)-qoff,qrel,hi);}while(0)
  #define ENDW(tt) do{ if((tt)+3<NT){WAIT_BAR(3);} else if((tt)+2<NT){WAIT_BAR(1);} else {WAIT_BAR(0);} }while(0)
  for(;t+1<NT;t+=2){
    STEP(pB0,pB1,pA0,pA1,t,(t+3<NT),(t+1<NT),(t+1<NT));       ENDW(t);   RESC(); ROT();
    STEP(pA0,pA1,pB0,pB1,t+1,(t+4<NT),(t+2<NT),(t+2<NT));     ENDW(t+1); RESC(); ROT();
  }
  STEP(pB0,pB1,pA0,pA1,NT-1,false,false,false); RESC();
  { float sacc=pB0[0]+pB0[1]; _Pragma("unroll") for(int r=2;r<16;++r)sacc+=pB0[r]; _Pragma("unroll") for(int r=0;r<16;++r)sacc+=pB1[r]; l_reg+=sacc;
    pw0=(u32x4){PKW(pB0,0),PKW(pB0,2),PKW(pB0,4),PKW(pB0,6)};pw1=(u32x4){PKW(pB0,8),PKW(pB0,10),PKW(pB0,12),PKW(pB0,14)};pw2=(u32x4){PKW(pB1,0),PKW(pB1,2),PKW(pB1,4),PKW(pB1,6)};pw3=(u32x4){PKW(pB1,8),PKW(pB1,10),PKW(pB1,12),PKW(pB1,14)};
    SBAR(); pv(o,(int)(unsigned)(uintptr_t)vp0+sl_cur,PAF(0),PAF(1),PAF(2),PAF(3)); }
  #undef PKW
  #undef PAF
  #undef VFR
  #undef PIN
  #undef GAPA
  #undef GAPB
  #undef EX
  #undef VRD
  #undef KRD
  #undef BRD
  #undef STEP
  #undef ENDW
  const bf16*Gw=U.G+(long)(wid*QBLK)*GP; u32x4 gvv[4];
  #pragma unroll
  for(int i=0;i<4;++i){const int row=i*8+(lane>>3),ch=lane&7; gvv[i]=(wid*QBLK+row<U.nvalid)?*(const u32x4*)(Gw+(long)row*GP+ch*8):(u32x4){0u,0u,0u,0u};}
  __builtin_amdgcn_sched_barrier(0);
  {auto rr=__builtin_amdgcn_permlane32_swap(__float_as_uint(l_reg),__float_as_uint(l_reg),false,false);l_reg=__uint_as_float(rr[0])+__uint_as_float(rr[1]);}
  if(hi==0)wsf[32+r32]=l_reg;asm volatile("s_waitcnt lgkmcnt(0)":::"memory");
  float rli[16];
  #pragma unroll
  for(int r=0;r<16;++r)rli[r]=__builtin_amdgcn_rcpf(wsf[32+crow(r,hi)]);
  bf16*Ow=U.O+(long)(wid*QBLK)*OP;
  { bf16*stg=(bf16*)(shm+LDS_OST)+wid*2048;
    #pragma unroll
    for(int r=0;r<16;++r){const int orow=crow(r,hi);
      #pragma unroll
      for(int d0=0;d0<2;++d0)stg[orow*64+d0*32+r32]=__float2bfloat16(o[d0][r]*rli[r]);}
    asm volatile("s_waitcnt lgkmcnt(0)":::"memory");
    #pragma unroll
    for(int i=0;i<4;++i){const int row=i*8+(lane>>3),ch=lane&7; const u32x4 v=*(const u32x4*)(stg+row*64+ch*8);
      if(wid*QBLK+row<U.nvalid){
        const u32x4 gv=gvv[i]; u32x4 ov;
        #pragma unroll
        for(int e=0;e<4;++e){
          const float o0=__uint_as_float(v[e]<<16), o1=__uint_as_float(v[e]&0xffff0000u);
          const float g0=__uint_as_float(gv[e]<<16), g1=__uint_as_float(gv[e]&0xffff0000u);
          const float s0=g0*__builtin_amdgcn_rcpf(1.f+__expf(-g0)), s1=g1*__builtin_amdgcn_rcpf(1.f+__expf(-g1));
          ov[e]=cvtpk_s(o0*s0,o1*s1); }
        *(u32x4*)(Ow+(long)row*OP+ch*8)=ov; } } }
  asm volatile("s_waitcnt lgkmcnt(0)\n\ts_barrier":::"memory");
  #undef DMA_K
  #undef DMA_V
  #undef CMASK
  #undef RESC
  #undef ROT
  #undef BLD1
}
__device__ __forceinline__ void attn_unit_helper(const AUnit&U,char*shm,int wave0){
  int l__; asm volatile("v_mbcnt_lo_u32_b32 %0, -1, 0\n\tv_mbcnt_hi_u32_b32 %0, -1, %0":"=v"(l__)); const int tid=wave0*64+l__,lane=tid&63; const int wid=__builtin_amdgcn_readfirstlane(tid>>6);
  const int KP=U.kp;
  const unsigned lds0=(unsigned)(uintptr_t)shm;
  const bf16*ksrc=U.K+(long)lane*KP+wid*8;
  const bf16*vsrc=U.V+(long)(16*(wid&3)+(lane>>2))*KP+(wid>>2)*32+(lane&3)*8;
  const float*bsrc=U.nbk+lane;
  const unsigned kdst=lds0+LDS_K+wid*1024, vdst=lds0+LDS_V+wid*1024, bdst=lds0+LDS_BIAS+wid*(NSLOT*256);
  #define DMA_K(t,slot) do{ glds16(ksrc+(long)(t)*KVBLK*KP,(unsigned)__builtin_amdgcn_readfirstlane(kdst+(slot))); glds4(bsrc+(t)*KVBLK,(unsigned)__builtin_amdgcn_readfirstlane(bdst+((slot)>>5))); }while(0)
  #define DMA_V(t,slot) glds16(vsrc+(long)(t)*KVBLK*KP,(unsigned)__builtin_amdgcn_readfirstlane(vdst+(slot)))
  const int NT=U.NT;
  int sl_cur=0,sl_next=SLOTB;
  #define ROT() do{sl_cur=sl_next;sl_next=(sl_next==(NSLOT-1)*SLOTB)?0:sl_next+SLOTB;}while(0)
  DMA_K(0,0);DMA_V(0,0);DMA_K(1,SLOTB);DMA_K(2,2*SLOTB);
  WAIT_BAR(2);
  WAIT_BAR(0);
  DMA_K(3,0);DMA_V(1,SLOTB);
  ROT();
  WAIT_BAR(3);
  for(int t=1;t<NT-1;++t){
    if(t+3<NT){DMA_K(t+3,sl_cur);} if(t+1<NT){DMA_V(t+1,sl_next);}
    if(t+3<NT){WAIT_BAR(3);} else if(t+2<NT){WAIT_BAR(1);} else {WAIT_BAR(0);}
    ROT();
  }
  asm volatile("s_waitcnt lgkmcnt(0)\n\ts_barrier":::"memory");
  #undef DMA_K
  #undef DMA_V
  #undef ROT
}
constexpr int ATTN_LDS_BYTES=LDS_BYTES;
#undef SBAR
#undef WAIT_BAR
#undef MX3
#undef LDSV
#undef FLOORZ_LDS_OFF
}

namespace cg = cooperative_groups;
#define GAS __attribute__((address_space(1)))
#define LAS __attribute__((address_space(3)))
typedef unsigned short bf16;
typedef unsigned v4u __attribute__((ext_vector_type(4)));
typedef unsigned v2u __attribute__((ext_vector_type(2)));
typedef float f32x4 __attribute__((ext_vector_type(4)));
typedef short bf16x8 __attribute__((ext_vector_type(8)));
constexpr int NWAVES = 8;
#define SCHED_FENCE() __builtin_amdgcn_sched_barrier(0)

constexpr int DM = 1024, NB = 16, SEQ = 4096, NL = 2, SB = 8, ST = 16, PAST = 2048, NH = 8, HD = 64;
constexpr int MP = NB * SEQ;
constexpr int MS = SB * ST;
constexpr int MV = MP + MS;
constexpr int MPAD = 257 * 256;
constexpr int INC = 3592;
constexpr int PP = 3584;
constexpr int C_PU = 0, C_PG = 256, C_Q = 512, C_K = 1024, C_V = 1536, C_AG = 2048, C_CB = 2560, C_CC = 2816, C_CX = 3072, C_CG = 3328;
constexpr int KSROWS = 2176;
constexpr int NBKS = 2432;
constexpr float EPS = 1e-6f;
constexpr float LOG2E = 1.4426950408889634f;

constexpr size_t O_YP = 0;
constexpr size_t O_YS = O_YP + (size_t)MP * DM;
constexpr size_t O_KP = O_YS + (size_t)MS * DM;
constexpr size_t O_VP = O_KP + (size_t)NL * MP * 512;
constexpr size_t O_FP = O_VP + (size_t)NL * MP * 512;
constexpr size_t O_PP = O_FP + (size_t)NL * MP * 8;
constexpr size_t O_CP = O_PP + (size_t)NL * NB * 15 * 256;
constexpr size_t O_KS = O_CP + (size_t)NL * NB * 2 * 256;
constexpr size_t O_VS = O_KS + (size_t)NL * MS * 512;
constexpr size_t O_FS = O_VS + (size_t)NL * MS * 512;
constexpr size_t O_PS = O_FS + (size_t)NL * MS * 8;
constexpr size_t O_CS = O_PS + (size_t)NL * SB * 15 * 256;
constexpr size_t O_END = O_CS + (size_t)NL * SB * 2 * 256;

constexpr size_t MiB = 1u << 20;
constexpr size_t WS_WIN = 0;
constexpr size_t WS_WOUT = 16 * MiB;
constexpr size_t WS_PWT = 20 * MiB;
constexpr size_t WS_NBKP = 21 * MiB;
constexpr size_t WS_NBKS = 23 * MiB;
constexpr size_t WS_BAR = 23 * MiB + 768 * 1024;
constexpr size_t WS_KS = 24 * MiB;
constexpr size_t WS_VS = 60 * MiB;
constexpr size_t WS_XN = 96 * MiB;
constexpr size_t WS_PROJ = 226 * MiB;
constexpr size_t WS_X1B = WS_PROJ + (size_t)(MPAD + 512) * PP * 2;
constexpr size_t WS_END = WS_X1B + (size_t)MP * DM * 2;
static_assert(WS_KS + (size_t)NL * SB * KSROWS * 512 * 2 <= WS_VS && WS_VS + (size_t)NL * SB * KSROWS * 512 * 2 <= WS_XN && WS_XN + (size_t)(MPAD + 256) * DM * 2 <= WS_PROJ, "ws map");

constexpr int REP_CONV = 1, REP_POOL = 1; constexpr int REP_P0 = 1, REP_PA = 1, REP_GIN = 1, REP_MIX = 1, REP_ATTN = 1, REP_GOUT0 = 1;
constexpr int STAGGER_TICKS = 1600;
constexpr int RING_BYTES = 131072;
constexpr int LDS_BYTES = 147456;

__device__ __forceinline__ unsigned f2bf(float f) { unsigned u = __builtin_bit_cast(unsigned, f); return (u + 0x7fffu + ((u >> 16) & 1u)) >> 16; }
__device__ __forceinline__ unsigned pk2(float lo, float hi) { return attn_body::cvtpk_s(lo, hi); }
__device__ __forceinline__ float bflo(unsigned w) { return __uint_as_float(w << 16); }
__device__ __forceinline__ float bfhi(unsigned w) { return __uint_as_float(w & 0xffff0000u); }
__device__ __forceinline__ void stagger_wait(int steps) { const unsigned long long t0 = __builtin_amdgcn_s_memrealtime(); const unsigned long long d = (unsigned long long)steps * STAGGER_TICKS; while (__builtin_amdgcn_s_memrealtime() - t0 < d) __builtin_amdgcn_s_sleep(16); }
__device__ __forceinline__ float silu_f(float x) { return x * __builtin_amdgcn_rcpf(1.f + __expf(-x)); }
__device__ __forceinline__ float shx(float v, int m, int lane) { return __int_as_float(__builtin_amdgcn_ds_bpermute((lane ^ m) << 2, __float_as_int(v))); }
__device__ __forceinline__ float wave_sum(float v, int lane) {
#pragma unroll
    for (int o = 1; o < 64; o <<= 1) v += shx(v, o, lane);
    return v;
}

struct Args {
    const float* in[16]; float* out; unsigned char* ws; int ph_lo, ph_hi;
};

struct Str { int s, cs, GS, cg, rowP0, rowsP, sb0, SBs; };
struct Frame {
    LAS unsigned char* lds;
    int tid, lane, wave, vcu, G, wave0;
};
#define FRAME_REFRESH(F) do { int l_; asm volatile("v_mbcnt_lo_u32_b32 %0, -1, 0\n\tv_mbcnt_hi_u32_b32 %0, -1, %0" : "=v"(l_)); int t_ = (F).wave0 * 64 + l_; (F).tid = t_; (F).lane = t_ & 63; (F).wave = __builtin_amdgcn_readfirstlane(t_ >> 6); } while (0)

__host__ __device__ __forceinline__ int win_logical_col(int p) {
    if (p < 512) return p;
    if (p < 1536) { const int reg = (p - 512) >> 8, q = (p - 512) & 255; return 512 + reg * 256 + 64 * ((q >> 5) & 3) + 32 * (q >> 7) + (q & 31); }
    if (p < 2560) return p;
    return p + 8;
}

__device__ __forceinline__ void transpose_item(const float* W, int K, int Nsrc, int srccol0, bf16* WT, int n0, int k0, LAS float* scr, int lane) {
    float tv[32];
#pragma unroll
    for (int i = 0; i < 32; ++i) { const int kk = 2 * i + (lane >> 5); tv[i] = W[(size_t)(k0 + kk) * Nsrc + srccol0 + (lane & 31)]; }
    SCHED_FENCE();
#pragma unroll
    for (int i = 0; i < 32; ++i) { const int kk = 2 * i + (lane >> 5); scr[kk * 33 + (lane & 31)] = tv[i]; }
    asm volatile("s_waitcnt lgkmcnt(0)" ::: "memory");
    const int c = lane & 7;
#pragma unroll
    for (int j = 0; j < 4; ++j) { const int n = (lane >> 3) + 8 * j; const LAS float* s = scr + (8 * c) * 33 + n;
        v4u o; o.x = pk2(s[0 * 33], s[1 * 33]); o.y = pk2(s[2 * 33], s[3 * 33]); o.z = pk2(s[4 * 33], s[5 * 33]); o.w = pk2(s[6 * 33], s[7 * 33]);
        *(v4u*)(WT + (size_t)(n0 + n) * K + k0 + 8 * c) = o; }
    asm volatile("s_waitcnt lgkmcnt(0)" ::: "memory");
}

__device__ __forceinline__ void p0_prologue(Frame& F, const Args& a) {
    LAS float* scr = (LAS float*)(F.lds + F.wave * 16384);
    const int gw = F.vcu * NWAVES + F.wave, NGW = F.G * NWAVES;
    unsigned char* ws = a.ws;
    constexpr int I_IN = (DM / 64) * (PP / 32), I_OUT = (DM / 64) * (DM / 32);
    for (int it = gw; it < NL * (I_IN + I_OUT); it += NGW) {
        const int l = it / (I_IN + I_OUT); int r = it % (I_IN + I_OUT);
        if (r < I_IN) { const int kb = r / (PP / 32), nb = r % (PP / 32);
            transpose_item(a.in[8] + (size_t)l * DM * INC, DM, INC, win_logical_col(32 * nb), (bf16*)(ws + WS_WIN) + (size_t)l * PP * DM, 32 * nb, 64 * kb, scr, F.lane); }
        else { r -= I_IN; const int kb = r / (DM / 32), nb = r % (DM / 32);
            transpose_item(a.in[15] + (size_t)l * DM * DM, DM, DM, 32 * nb, (bf16*)(ws + WS_WOUT) + (size_t)l * DM * DM, 32 * nb, 64 * kb, scr, F.lane); }
    }
    { const int gt = F.vcu * 512 + F.tid, NT_ = F.G * 512; bf16* pwt = (bf16*)(ws + WS_PWT);
      for (int i = gt; i < NL * 4 * 64 * 64; i += NT_) { const int c = i & 63, d = (i >> 6) & 63, lg = i >> 12; pwt[i] = (bf16)f2bf(a.in[12][(size_t)lg * 4096 + c * 64 + d]); } }
    { const size_t gt = (size_t)F.vcu * 512 + F.tid, NT_ = (size_t)F.G * 512;
      const size_t nchunk = (size_t)NL * SB * PAST * 64;
      for (size_t i0 = gt; i0 < 2 * nchunk; i0 += 4 * NT_) {
          f32x4 x0[4], x1[4];
#pragma unroll
          for (int q = 0; q < 4; ++q) { const size_t i = i0 + q * NT_; if (i < 2 * nchunk) { const int which = i >= nchunk; const size_t j = which ? i - nchunk : i;
              const float* src = a.in[2 + which] + (j >> 6) * 512 + (int)(j & 63) * 8; x0[q] = *(const f32x4*)src; x1[q] = *(const f32x4*)(src + 4); } }
          SCHED_FENCE();
#pragma unroll
          for (int q = 0; q < 4; ++q) { const size_t i = i0 + q * NT_; if (i < 2 * nchunk) { const int which = i >= nchunk; const size_t j = which ? i - nchunk : i;
              const size_t rowg = j >> 6; const int c8 = (int)(j & 63) * 8; const size_t lb = rowg / PAST; const int r = (int)(rowg % PAST);
              v4u o; o.x = pk2(x0[q][0], x0[q][1]); o.y = pk2(x0[q][2], x0[q][3]); o.z = pk2(x1[q][0], x1[q][1]); o.w = pk2(x1[q][2], x1[q][3]);
              *(v4u*)((bf16*)(ws + (which ? WS_VS : WS_KS)) + (lb * KSROWS + r) * 512 + c8) = o; } }
          SCHED_FENCE(); }
      const size_t nz = (size_t)NL * SB * (KSROWS - PAST - ST) * 64;
      for (size_t i = gt; i < 2 * nz; i += NT_) {
          const int which = i >= nz; const size_t j = which ? i - nz : i;
          const size_t rowg = j >> 6; const int c8 = (int)(j & 63) * 8; const size_t lb = rowg / (KSROWS - PAST - ST); const int r = (int)(rowg % (KSROWS - PAST - ST)) + PAST + ST;
          bf16* dst = (bf16*)(ws + (which ? WS_VS : WS_KS)) + (lb * KSROWS + r) * 512 + c8;
          *(v4u*)dst = (v4u){0u, 0u, 0u, 0u}; } }
    { const int gt = F.vcu * 512 + F.tid, NT_ = F.G * 512; v4u* p = (v4u*)((bf16*)(ws + WS_XN) + (size_t)MV * DM);
      for (int i = gt; i < (MPAD - MV) * DM / 8; i += NT_) p[i] = (v4u){0u, 0u, 0u, 0u}; }
}

__device__ __forceinline__ void pa_phase(Frame& F, const Args& a, int l, const float* xp, const float* xs, const Str& T, const bf16* xpb = nullptr) {
    LAS float* wg = (LAS float*)F.lds;
    __syncthreads();
    const float* ng = a.in[7] + (size_t)l * DM;
    { const float* wf = a.in[8] + (size_t)l * DM * INC + 2560;
      for (int k = F.tid; k < DM; k += 512) { const f32x4 w0 = *(const f32x4*)(wf + (size_t)k * INC), w1 = *(const f32x4*)(wf + (size_t)k * INC + 4); const float g = ng[k];
          wg[0 * 1024 + k] = w0[0] * g; wg[1 * 1024 + k] = w0[1] * g; wg[2 * 1024 + k] = w0[2] * g; wg[3 * 1024 + k] = w0[3] * g;
          wg[4 * 1024 + k] = w1[0] * g; wg[5 * 1024 + k] = w1[1] * g; wg[6 * 1024 + k] = w1[2] * g; wg[7 * 1024 + k] = w1[3] * g; } }
    __syncthreads();
    const int lane = F.lane;
    f32x4 gv[4];
#pragma unroll
    for (int j = 0; j < 4; ++j) gv[j] = *(const f32x4*)(ng + 4 * lane + 256 * j);
    const float* bfp = a.in[9] + l * 8;
    bf16* XN = (bf16*)(a.ws + WS_XN);
    float* outfp = a.out + O_FP + (size_t)l * MP * 8; float* outfs = a.out + O_FS + (size_t)l * MS * 8;
    const int gw = T.cs * NWAVES + F.wave, NGW = T.GS * NWAVES;
    for (int rg = gw; rg < (T.rowsP + T.SBs * ST) / 4; rg += NGW) {
        const int row0 = rg < T.rowsP / 4 ? T.rowP0 + rg * 4 : MP + T.sb0 * ST + (rg - T.rowsP / 4) * 4;
        const float* src = row0 < MP ? xp + (size_t)row0 * DM : xs + (size_t)(row0 - MP) * DM;
        f32x4 v[4][4]; float rstd[4];
        if (xpb != nullptr && row0 < MP) {
            const bf16* sb = xpb + (size_t)row0 * DM;
#pragma unroll
            for (int r = 0; r < 4; ++r)
#pragma unroll
                for (int j = 0; j < 4; ++j) { const v2u p = *(const v2u*)(sb + (size_t)r * DM + 4 * lane + 256 * j); v[r][j] = (f32x4){bflo(p.x), bfhi(p.x), bflo(p.y), bfhi(p.y)}; }
        } else {
#pragma unroll
            for (int r = 0; r < 4; ++r)
#pragma unroll
                for (int j = 0; j < 4; ++j) v[r][j] = __builtin_nontemporal_load((const f32x4*)(src + (size_t)r * DM + 4 * lane + 256 * j));
        }
#pragma unroll
        for (int r = 0; r < 4; ++r) { float s = 0.f;
#pragma unroll
            for (int j = 0; j < 4; ++j) s += (v[r][j][0] * v[r][j][0] + v[r][j][1] * v[r][j][1]) + (v[r][j][2] * v[r][j][2] + v[r][j][3] * v[r][j][3]);
            rstd[r] = 1.0f / sqrtf(wave_sum(s, lane) * (1.f / DM) + EPS); }
        float acc[32];
#pragma unroll
        for (int i = 0; i < 32; ++i) acc[i] = 0.f;
#pragma unroll
        for (int h = 0; h < 8; ++h) {
#pragma unroll
            for (int j = 0; j < 4; ++j) { const f32x4 w = *(const LAS f32x4*)(wg + h * 1024 + 4 * lane + 256 * j);
#pragma unroll
                for (int r = 0; r < 4; ++r) acc[r * 8 + h] += (v[r][j][0] * w[0] + v[r][j][1] * w[1]) + (v[r][j][2] * w[2] + v[r][j][3] * w[3]); }
            asm volatile("" ::: "memory"); }
#define RS_STAGE(M_, N_) { const bool up = (lane & (M_)) != 0; _Pragma("unroll") for (int i = 0; i < (N_); ++i) { const float send = up ? acc[i] : acc[i + (N_)], keep = up ? acc[i + (N_)] : acc[i]; acc[i] = keep + shx(send, (M_), lane); } }
        RS_STAGE(32, 16) RS_STAGE(16, 8) RS_STAGE(8, 4) RS_STAGE(4, 2) RS_STAGE(2, 1)
#undef RS_STAGE
        acc[0] += shx(acc[0], 1, lane);
        { const int idx = lane >> 1, r = idx >> 3, h = idx & 7;
          const float rs = r == 0 ? rstd[0] : r == 1 ? rstd[1] : r == 2 ? rstd[2] : rstd[3];
          const float xx = acc[0] * rs + bfp[h];
          const float lf = fminf(xx, 0.f) - __logf(1.f + __expf(-fabsf(xx)));
          if ((lane & 1) == 0) { const int row = row0 + r; if (row < MP) outfp[(size_t)row * 8 + h] = lf; else outfs[(size_t)(row - MP) * 8 + h] = lf; } }
#pragma unroll
        for (int r = 0; r < 4; ++r) { unsigned long long* o8 = (unsigned long long*)(XN + (size_t)(row0 + r) * DM) + lane;
#pragma unroll
            for (int j = 0; j < 4; ++j) { const f32x4 y = v[r][j] * rstd[r] * gv[j];
                o8[64 * j] = (unsigned long long)pk2(y[0], y[1]) | ((unsigned long long)pk2(y[2], y[3]) << 32); } }
    }
    __syncthreads();
}

__device__ __forceinline__ void scan_phase(Frame& F, const Args& a, int l, const Str& T) {
    LAS float* sc = (LAS float*)F.lds;
    const float* lfp = a.out + O_FP + (size_t)l * MP * 8; const float* lfs = a.out + O_FS + (size_t)l * MS * 8;
    const float* clf = a.in[4] + (size_t)l * SB * PAST * 8;
    float* nbkp = (float*)(a.ws + WS_NBKP); float* nbks = (float*)(a.ws + WS_NBKS);
    const int nbhp = (T.rowsP / SEQ) * 8, nbhs = T.SBs * 8;
    for (int s = T.cs; s < nbhp + nbhs; s += T.GS) {
        const bool samp = s >= nbhp; const int bh = samp ? T.sb0 * 8 + (s - nbhp) : (T.rowP0 / SEQ) * 8 + s, b = bh >> 3, h = bh & 7;
        const int n = samp ? PAST + ST : SEQ;
        float v[8]; float run = 0.f;
#pragma unroll
        for (int j = 0; j < 8; ++j) { const int t = 8 * F.tid + j; float x = 0.f;
            if (t < n) x = samp ? (t < PAST ? clf[((size_t)b * PAST + t) * 8 + h] : lfs[((size_t)b * ST + (t - PAST)) * 8 + h]) : lfp[((size_t)b * SEQ + t) * 8 + h];
            run += x; v[j] = run; }
        float inc = run;
#pragma unroll
        for (int o = 1; o < 64; o <<= 1) { const int src = F.lane >= o ? F.lane - o : F.lane; const float y = __int_as_float(__builtin_amdgcn_ds_bpermute(src << 2, __float_as_int(inc))); if (F.lane >= o) inc += y; }
        if (F.lane == 63) sc[F.wave] = inc;
        __syncthreads();
        float base = inc - run;
        for (int w = 0; w < F.wave; ++w) base += sc[w];
        float* dst = samp ? nbks + (size_t)bh * NBKS : nbkp + (size_t)bh * SEQ;
        const int t0 = 8 * F.tid;
        if (t0 < n) {
            *(f32x4*)(dst + t0) = (f32x4){-(base + v[0]) * LOG2E, -(base + v[1]) * LOG2E, -(base + v[2]) * LOG2E, -(base + v[3]) * LOG2E};
            *(f32x4*)(dst + t0 + 4) = (f32x4){-(base + v[4]) * LOG2E, -(base + v[5]) * LOG2E, -(base + v[6]) * LOG2E, -(base + v[7]) * LOG2E};
        } else if (samp && t0 < NBKS) {
            *(f32x4*)(dst + t0) = (f32x4){0.f, 0.f, 0.f, 0.f}; *(f32x4*)(dst + t0 + 4) = (f32x4){0.f, 0.f, 0.f, 0.f};
        }
        __syncthreads();
    }
}

template <int W> __device__ __forceinline__ void pool_task(const Args& a, int l, int rt, int g, int lane) {
    const int fr = lane & 15, fq = lane >> 4;
    const bool samp = rt >= MP / 16;
    const int row = rt * 16 + fr;
    const int t = samp ? fr : (row & (SEQ - 1));
    const int b = samp ? (rt - MP / 16) : (row >> 12);
    const bf16* proj = (const bf16*)(a.ws + WS_PROJ);
    const bf16* pu = proj + (size_t)row * PP + C_PU + g * 64;
    const float* sp = a.in[5] + ((size_t)(l * SB + (samp ? b : 0)) * 15) * 256 + g * 64;
    const float inv = 1.0f / (float)(samp ? W : (t + 1 < W ? t + 1 : W));
    const bf16* pwt = (const bf16*)(a.ws + WS_PWT) + (size_t)(l * 4 + g) * 4096;
    const float* psc = a.in[13] + l * 256 + g * 64;
    const bf16* pg = proj + (size_t)row * PP + C_PG + g * 64;
    bf16x8 bfr[4][2]; f32x4 sc[4]; v2u gg[4];
    bf16x8 af[2];
    float* outp = samp ? a.out + O_PS + ((size_t)(l * SB + b) * 15) * 256 + g * 64 : a.out + O_PP + ((size_t)(l * NB + b) * 15) * 256 + g * 64;
#pragma unroll
    for (int kk = 0; kk < 2; ++kk) {
        const int ch = 32 * kk + 8 * fq;
        v4u xs[W];
#pragma unroll
        for (int j = 0; j < W; ++j) { const int jj = (t - j >= 0) ? j : 0; xs[j] = *(const v4u*)(pu - (size_t)jj * PP + ch); }
        if (kk == 0) {
#pragma unroll
            for (int n = 0; n < 4; ++n) {
#pragma unroll
                for (int k2 = 0; k2 < 2; ++k2) bfr[n][k2] = *(const bf16x8*)(pwt + (16 * n + fr) * 64 + 32 * k2 + 8 * fq);
                sc[n] = *(const f32x4*)(psc + 16 * n + 4 * fq); gg[n] = *(const v2u*)(pg + 16 * n + 4 * fq); }
        }
        SCHED_FENCE();
        float s[8], u[8];
#pragma unroll
        for (int e = 0; e < 4; ++e) { u[2 * e] = bflo(xs[0][e]); u[2 * e + 1] = bfhi(xs[0][e]); s[2 * e] = 0.f; s[2 * e + 1] = 0.f; }
#pragma unroll
        for (int j = 0; j < W; ++j) { const bool ok = (t - j >= 0);
#pragma unroll
            for (int e = 0; e < 4; ++e) { s[2 * e] += ok ? bflo(xs[j][e]) : 0.f; s[2 * e + 1] += ok ? bfhi(xs[j][e]) : 0.f; } }
        if (samp) {
#pragma unroll 1
            for (int j = 1; j < W; ++j) { const int tt = t - j;
                if (tt < 0) { const float* q = sp + (size_t)(15 + tt) * 256 + ch; const f32x4 x0 = *(const f32x4*)q, x1 = *(const f32x4*)(q + 4);
                    s[0] += x0[0]; s[1] += x0[1]; s[2] += x0[2]; s[3] += x0[3]; s[4] += x1[0]; s[5] += x1[1]; s[6] += x1[2]; s[7] += x1[3]; } }
        }
        v4u pk; pk.x = pk2(s[0] * inv - u[0], s[1] * inv - u[1]); pk.y = pk2(s[2] * inv - u[2], s[3] * inv - u[3]); pk.z = pk2(s[4] * inv - u[4], s[5] * inv - u[5]); pk.w = pk2(s[6] * inv - u[6], s[7] * inv - u[7]);
        af[kk] = __builtin_bit_cast(bf16x8, pk);
        const int orow = samp ? t - 1 : t - (SEQ - 15);
        if (orow >= 0) { float* q = outp + (size_t)orow * 256 + ch; *(f32x4*)q = (f32x4){u[0], u[1], u[2], u[3]}; *(f32x4*)(q + 4) = (f32x4){u[4], u[5], u[6], u[7]}; }
        SCHED_FENCE();
    }
    f32x4 acc[4];
#pragma unroll
    for (int n = 0; n < 4; ++n) { acc[n] = (f32x4){0.f, 0.f, 0.f, 0.f};
#pragma unroll
        for (int kk = 0; kk < 2; ++kk) acc[n] = __builtin_amdgcn_mfma_f32_16x16x32_bf16(bfr[n][kk], af[kk], acc[n], 0, 0, 0); }
    bf16* mix = (bf16*)(a.ws + WS_XN) + (size_t)row * DM + g * 64;
#pragma unroll
    for (int n = 0; n < 4; ++n) { const int d = 16 * n + 4 * fq;
        const float o0 = acc[n][0] * sc[n][0] * silu_f(bflo(gg[n].x)), o1 = acc[n][1] * sc[n][1] * silu_f(bfhi(gg[n].x)), o2 = acc[n][2] * sc[n][2] * silu_f(bflo(gg[n].y)), o3 = acc[n][3] * sc[n][3] * silu_f(bfhi(gg[n].y));
        v2u o; o.x = pk2(o0, o1); o.y = pk2(o2, o3); *(v2u*)(mix + d) = o; }
}

__device__ __forceinline__ void conv_item(const Args& a, int l, int rb, int tid, const Str& T) {
    const int chunk = tid & 31, run = tid >> 5, ch = chunk * 8;
    const bool samp = rb == MP / 128;
    const int row0 = rb * 128 + run * 8;
    const int t0 = samp ? (run & 1) * 8 : (row0 & (SEQ - 1));
    const int b = samp ? (run >> 1) : (row0 >> 12);
    if (samp && (b < T.sb0 || b >= T.sb0 + T.SBs)) return;
    const bf16* proj = (const bf16*)(a.ws + WS_PROJ);
    bf16* mix = (bf16*)(a.ws + WS_XN);
    float zm2[8], zm1[8], w0[8], w1[8], w2[8];
    { const float* cw = a.in[14] + (size_t)l * 3 * 256 + ch;
#pragma unroll
      for (int e = 0; e < 8; ++e) { w0[e] = cw[e]; w1[e] = cw[256 + e]; w2[e] = cw[512 + e]; } }
    const bool first = (t0 == 0);
    v4u hc2, hx2, hc1, hx1;
    { const bf16* p2 = proj + (size_t)(first ? row0 : row0 - 2) * PP; const bf16* p1 = proj + (size_t)(first ? row0 : row0 - 1) * PP;
      hc2 = *(const v4u*)(p2 + C_CC + ch); hx2 = *(const v4u*)(p2 + C_CX + ch); hc1 = *(const v4u*)(p1 + C_CC + ch); hx1 = *(const v4u*)(p1 + C_CX + ch); }
    float* outc = samp ? a.out + O_CS + ((size_t)(l * SB + b) * 2) * 256 + ch : a.out + O_CP + ((size_t)(l * NB + b) * 2) * 256 + ch;
    const int tlast = samp ? ST - 2 : SEQ - 2;
    v4u lcb[8], lcc[8], lcx[8], lcg[8];
#pragma unroll
    for (int i = 0; i < 8; ++i) { const bf16* p = proj + (size_t)(row0 + i) * PP;
        lcb[i] = *(const v4u*)(p + C_CB + ch); lcc[i] = *(const v4u*)(p + C_CC + ch); lcx[i] = *(const v4u*)(p + C_CX + ch); lcg[i] = *(const v4u*)(p + C_CG + ch); }
    SCHED_FENCE();
    if (first) {
        if (samp) { const float* sc = a.in[6] + ((size_t)(l * SB + b) * 2) * 256 + ch;
#pragma unroll
            for (int e = 0; e < 8; ++e) { zm2[e] = sc[e]; zm1[e] = sc[256 + e]; } }
        else {
#pragma unroll
            for (int e = 0; e < 8; ++e) { zm2[e] = 0.f; zm1[e] = 0.f; } }
    } else {
#pragma unroll
        for (int e = 0; e < 4; ++e) { zm2[2 * e] = bflo(hc2[e]) * bflo(hx2[e]); zm2[2 * e + 1] = bfhi(hc2[e]) * bfhi(hx2[e]); zm1[2 * e] = bflo(hc1[e]) * bflo(hx1[e]); zm1[2 * e + 1] = bfhi(hc1[e]) * bfhi(hx1[e]); }
    }
#pragma unroll
    for (int i = 0; i < 8; ++i) {
        const v4u cb = lcb[i], cc = lcc[i], cx = lcx[i], cgt = lcg[i];
        float z[8], o[8];
#pragma unroll
        for (int e = 0; e < 4; ++e) { z[2 * e] = bflo(cc[e]) * bflo(cx[e]); z[2 * e + 1] = bfhi(cc[e]) * bfhi(cx[e]); }
#pragma unroll
        for (int e = 0; e < 8; ++e) { const float y = w0[e] * zm2[e] + w1[e] * zm1[e] + w2[e] * z[e]; o[e] = y; zm2[e] = zm1[e]; zm1[e] = z[e]; }
#pragma unroll
        for (int e = 0; e < 4; ++e) { o[2 * e] *= bflo(cb[e]) * silu_f(bflo(cgt[e])); o[2 * e + 1] *= bfhi(cb[e]) * silu_f(bfhi(cgt[e])); }
        v4u ov; ov.x = pk2(o[0], o[1]); ov.y = pk2(o[2], o[3]); ov.z = pk2(o[4], o[5]); ov.w = pk2(o[6], o[7]);
        *(v4u*)(mix + (size_t)(row0 + i) * DM + 768 + ch) = ov;
        const int t = t0 + i;
        if (t >= tlast) { float* q = outc + (size_t)(t - tlast) * 256; *(f32x4*)q = (f32x4){z[0], z[1], z[2], z[3]}; *(f32x4*)(q + 4) = (f32x4){z[4], z[5], z[6], z[7]}; }
    }
}

__device__ __forceinline__ void mixer_phase(Frame& F, const Args& a, int l, const Str& T) {
    for (int r2_ = 0; r2_ < REP_CONV; ++r2_) { const int nb = T.rowsP / 128;
      for (int k = T.cs; k < nb + 1; k += T.GS) conv_item(a, l, k < nb ? T.rowP0 / 128 + k : MP / 128, F.tid, T); }
    const int gw = T.cs * NWAVES + F.wave, NGW = T.GS * NWAVES;
    const int ntp = T.rowsP / 16, NTs = ntp + T.SBs;
    for (int r3_ = 0; r3_ < REP_POOL; ++r3_) for (int k = gw; k < NTs * 4; k += NGW) { const int j = k % NTs, g = 3 - k / NTs; const int rt = j < ntp ? T.rowP0 / 16 + j : MP / 16 + T.sb0 + (j - ntp);
        if (g == 0) pool_task<2>(a, l, rt, 0, F.lane); else if (g == 1) pool_task<4>(a, l, rt, 1, F.lane); else if (g == 2) pool_task<8>(a, l, rt, 2, F.lane); else pool_task<16>(a, l, rt, 3, F.lane); }
}

__device__ __forceinline__ void small_mm(const bf16* A, const bf16* Bt, const int (&boff)[4], int lane, f32x4 (&acc)[4]) {
    const int fr = lane & 15, fq = lane >> 4;
    const bf16* ap = A + (size_t)fr * DM + 8 * fq;
    const bf16* bp[4];
#pragma unroll
    for (int n = 0; n < 4; ++n) { bp[n] = Bt + (size_t)(boff[n] + fr) * DM + 8 * fq; acc[n] = (f32x4){0.f, 0.f, 0.f, 0.f}; }
#pragma unroll 1
    for (int k0 = 0; k0 < DM / 32; k0 += 8) {
        bf16x8 av[8], bv[8][4];
#pragma unroll
        for (int i = 0; i < 8; ++i) { av[i] = *(const bf16x8*)(ap + 32 * (k0 + i));
#pragma unroll
            for (int n = 0; n < 4; ++n) bv[i][n] = *(const bf16x8*)(bp[n] + 32 * (k0 + i)); }
        SCHED_FENCE();
#pragma unroll
        for (int i = 0; i < 8; ++i)
#pragma unroll
            for (int n = 0; n < 4; ++n) acc[n] = __builtin_amdgcn_mfma_f32_16x16x32_bf16(bv[i][n], av[i], acc[n], 0, 0, 0);
        SCHED_FENCE();
    }
}
__device__ __forceinline__ void small_inproj_item(const Args& a, int l, int rb, int cb, int lane) {
    const int fr = lane & 15, fq = lane >> 4, pn = cb >> 2, hh = cb & 3;
    const bool headed = (pn >= 2 && pn <= 5);
    int boff[4];
#pragma unroll
    for (int n = 0; n < 4; ++n) boff[n] = headed ? pn * 256 + 32 * hh + (n & 1) * 16 + (n >> 1) * 128 : cb * 64 + 16 * n;
    f32x4 acc[4];
    small_mm((const bf16*)(a.ws + WS_XN) + (size_t)(MP + rb * 16) * DM, (const bf16*)(a.ws + WS_WIN) + (size_t)l * PP * DM, boff, lane, acc);
    const int lr = rb * 16 + fr;
    bf16* proj = (bf16*)(a.ws + WS_PROJ) + (size_t)(MP + lr) * PP;
    if (headed) {
        const bool isq = pn < 4; const int head = (pn & 1) * 4 + hh;
        const float* g = (isq ? a.in[10] : a.in[11]) + l * 64;
        float ss = 0.f;
#pragma unroll
        for (int n = 0; n < 4; ++n) ss += (acc[n][0] * acc[n][0] + acc[n][1] * acc[n][1]) + (acc[n][2] * acc[n][2] + acc[n][3] * acc[n][3]);
        ss += shx(ss, 16, lane); ss += shx(ss, 32, lane);
        const float rs = 1.0f / sqrtf(ss * (1.0f / 64.0f) + EPS) * (isq ? attn_body::C2 : 1.0f);
        bf16* kd = (bf16*)(a.ws + WS_KS) + ((size_t)(l * SB + rb) * KSROWS + PAST + fr) * 512 + head * 64;
        float* ko = a.out + O_KS + (size_t)l * MS * 512 + (size_t)lr * 512 + head * 64;
#pragma unroll
        for (int n = 0; n < 4; ++n) { const int d = 16 * n + 4 * fq; const f32x4 gv = *(const f32x4*)(g + d); const f32x4 y = acc[n] * rs * gv;
            v2u w; w.x = pk2(y[0], y[1]); w.y = pk2(y[2], y[3]);
            if (isq) *(v2u*)(proj + C_Q + head * 64 + d) = w;
            else { *(v2u*)(kd + d) = w; *(f32x4*)(ko + d) = y; } }
    } else if (pn == 6 || pn == 7) {
        const int c0 = cb * 64 - C_V;
        bf16* vd = (bf16*)(a.ws + WS_VS) + ((size_t)(l * SB + rb) * KSROWS + PAST + fr) * 512 + c0;
        float* vo = a.out + O_VS + (size_t)l * MS * 512 + (size_t)lr * 512 + c0;
#pragma unroll
        for (int n = 0; n < 4; ++n) { const int d = 16 * n + 4 * fq; v2u w; w.x = pk2(acc[n][0], acc[n][1]); w.y = pk2(acc[n][2], acc[n][3]); *(v2u*)(vd + d) = w; *(f32x4*)(vo + d) = acc[n]; }
    } else {
#pragma unroll
        for (int n = 0; n < 4; ++n) { const int d = cb * 64 + 16 * n + 4 * fq; v2u w; w.x = pk2(acc[n][0], acc[n][1]); w.y = pk2(acc[n][2], acc[n][3]); *(v2u*)(proj + d) = w; }
    }
}
__device__ __forceinline__ void small_outproj_item(const Args& a, int l, int rb, int cb, int lane, const float* base_s, float* out_s) {
    const int fr = lane & 15, fq = lane >> 4;
    int boff[4];
#pragma unroll
    for (int n = 0; n < 4; ++n) boff[n] = cb * 64 + 16 * n;
    f32x4 acc[4];
    small_mm((const bf16*)(a.ws + WS_XN) + (size_t)(MP + rb * 16) * DM, (const bf16*)(a.ws + WS_WOUT) + (size_t)l * DM * DM, boff, lane, acc);
    const size_t off = (size_t)(rb * 16 + fr) * DM + cb * 64 + 4 * fq;
#pragma unroll
    for (int n = 0; n < 4; ++n) { const f32x4 bs = *(const f32x4*)(base_s + off + 16 * n); *(f32x4*)(out_s + off + 16 * n) = bs + acc[n]; }
}

#define XB_TMO      128
#define XB_XCNT(j)  (256  + 64 * (j))
#define XB_XSUB(j)  (1280 + 64 * (j))
#define XB_XGEN(j)  (2304 + 64 * (j))
#define XB_TOP      3328
#define XB_TOPGEN   3392
#define XCD_BAR_WORDS 3456
#define XB_SPIN_CAP (1u << 18)

__device__ __forceinline__ unsigned xb_ld(unsigned* p)              { return __hip_atomic_load(p, __ATOMIC_RELAXED, __HIP_MEMORY_SCOPE_AGENT); }
__device__ __forceinline__ unsigned xb_add(unsigned* p, unsigned v) { return __hip_atomic_fetch_add(p, v, __ATOMIC_RELAXED, __HIP_MEMORY_SCOPE_AGENT); }
__device__ __forceinline__ unsigned xb_xcc_id() { return (unsigned)__builtin_amdgcn_s_getreg((3 << 11) | 20) & 0xFu; }
#define XB_SPIN(cond, bar) do { unsigned _sp = 0; while (cond) { __builtin_amdgcn_s_sleep(1); \
    if ((++_sp & 255u) == 0u) { if (xb_ld(&(bar)[XB_TMO])) break; if (_sp > XB_SPIN_CAP) { atomicAdd(&(bar)[XB_TMO], 1u); break; } } } } while (0)

__device__ __forceinline__ bool xb_is_t0(int w0) { int l_; asm volatile("v_mbcnt_lo_u32_b32 %0, -1, 0\n\tv_mbcnt_hi_u32_b32 %0, -1, %0" : "=v"(l_)); return w0 == 0 && l_ == 0; }
struct XcdBarrier {
    int w0; unsigned G; unsigned* bar; unsigned x;
    volatile LAS unsigned* st;
};

__device__ __forceinline__ XcdBarrier xcd_barrier_post(unsigned* bar, volatile LAS unsigned* st, int w0, unsigned G) {
    XcdBarrier b; b.w0 = w0; b.G = G; b.bar = bar; b.x = xb_xcc_id(); b.st = st;
    if (xb_is_t0(w0)) (void)xb_add(&bar[XB_XCNT(b.x)], 1u);
    return b;
}
__device__ __forceinline__ void xcd_barrier_complete(unsigned* bar, unsigned x, unsigned& nloc, unsigned& nx, unsigned G) {
    unsigned sum, cnt, mine, sp = 0u;
    for (;;) {
        sum = 0u; cnt = 0u; mine = 0u;
#pragma unroll
        for (unsigned j = 0; j < 16; ++j) { const unsigned c = xb_ld(&bar[XB_XCNT(j)]); sum += c; cnt += (c > 0u) ? 1u : 0u; mine = (j == x) ? c : mine; }
        if (sum == G) break;
        __builtin_amdgcn_s_sleep(1);
        if ((++sp & 255u) == 0u) { if (xb_ld(&bar[XB_TMO])) break; if (sp > XB_SPIN_CAP) { atomicAdd(&bar[XB_TMO], 1u); break; } }
    }
    nloc = mine > 0u ? mine : 1u; nx = cnt > 0u ? cnt : 1u;
}

__device__ __forceinline__ void xcd_barrier(const XcdBarrier& b) {
    asm volatile("s_waitcnt vmcnt(0)" ::: "memory");
    __syncthreads();
    if (xb_is_t0(b.w0)) {
        unsigned* bar = b.bar;
        __builtin_amdgcn_s_waitcnt(0);
        unsigned nloc = b.st[0], nx = b.st[1];
        if (nloc == 0u) { xcd_barrier_complete(bar, b.x, nloc, nx, b.G); b.st[0] = nloc; b.st[1] = nx; }
        const unsigned old = xb_add(&bar[XB_XSUB(b.x)], 1u);
        const unsigned gen = old / nloc;
        if (old + 1u == (gen + 1u) * nloc) {
            __builtin_amdgcn_fence(__ATOMIC_RELEASE, "agent");
            asm volatile("s_waitcnt vmcnt(0)" ::: "memory");
            const unsigned og = xb_add(&bar[XB_TOP], 1u);
            const unsigned tg = og / nx;
            if (og + 1u == (tg + 1u) * nx) xb_add(&bar[XB_TOPGEN], 1u);
            else XB_SPIN(xb_ld(&bar[XB_TOPGEN]) == tg, bar);
            __builtin_amdgcn_fence(__ATOMIC_ACQUIRE, "agent");
            xb_add(&bar[XB_XGEN(b.x)], 1u);
            asm volatile("s_waitcnt vmcnt(0)" ::: "memory");
        } else {
            XB_SPIN(xb_ld(&bar[XB_XGEN(b.x)]) == gen, bar);
            __builtin_amdgcn_fence(__ATOMIC_ACQUIRE, "agent");
            asm volatile("s_waitcnt vmcnt(0)" ::: "memory");
        }
    }
    __syncthreads();
}


__device__ __forceinline__ void attention_phase(Frame& F, const Args& a, int l, char* lds, const Str& T) {
    using abf = attn_body::bf16;
    const abf* proj = (const abf*)(a.ws + WS_PROJ);
    abf* mix = (abf*)(a.ws + WS_XN);
    const float* nbkp = (const float*)(a.ws + WS_NBKP); const float* nbks = (const float*)(a.ws + WS_NBKS);
    const int nsu = (T.rowsP / SEQ) * 16, bh0 = (T.rowP0 / SEQ) * 8;
    float skip_thr, floorz;
    { float gq = fabsf(a.in[10][l * 64 + F.lane]), gk = fabsf(a.in[11][l * 64 + F.lane]);
#pragma unroll
      for (int o = 1; o < 64; o <<= 1) { gq = fmaxf(gq, shx(gq, o, F.lane)); gk = fmaxf(gk, shx(gk, o, F.lane)); }
      const float qkmax = attn_body::C2 * 64.0f * gq * gk * 1.02f; floorz = fminf(0.0f, 100.0f - qkmax); skip_thr = qkmax - floorz + 134.0f + 2.0f; }
    const int NX = (T.GS % 8 == 0) ? 8 : 1;
    const int x = (NX == 8) ? (T.cs / (T.GS / 8)) : 0;
    const int nbh = (T.rowsP / SEQ) * 8 / NX, nbs = T.SBs * 8 / NX;
    const int NU = nbs + nbh * 16;
    unsigned* qcnt = (unsigned*)(a.ws + WS_BAR) + 8192 + (l * 8 + x) * 64 + T.s * 1024;
    volatile LAS int* slot = (volatile LAS int*)(F.lds + RING_BYTES + 1024);
    if (xb_is_t0(F.wave0)) *(volatile LAS float*)(F.lds + RING_BYTES + 1040) = floorz;
    (void)nsu;
#pragma unroll 1
    for (int it = 0;; ++it) {
        if (xb_is_t0(F.wave0)) slot[it & 1] = (int)__hip_atomic_fetch_add(qcnt, 1u, __ATOMIC_RELAXED, __HIP_MEMORY_SCOPE_AGENT);
        __syncthreads();
        const int j = slot[it & 1];
        if (j >= NU) break;
        {
            attn_body::AUnit U;
            if (j >= nbs) {
                const int jj = j - nbs, qb = 15 - jj / nbh;
                const int bh = bh0 + x * nbh + jj % nbh, b = bh >> 3, h = bh & 7;
                const size_t r0 = (size_t)b * SEQ + (size_t)qb * 256;
                U.Q = proj + r0 * PP + C_Q + h * 64; U.K = proj + (size_t)b * SEQ * PP + C_K + h * 64; U.V = proj + (size_t)b * SEQ * PP + C_V + h * 64;
                U.nbk = nbkp + (size_t)bh * SEQ; U.O = mix + r0 * DM + 256 + h * 64; U.G = proj + r0 * PP + C_AG + h * 64;
                U.kp = PP; U.NT = 4 * qb + 4; U.qoff = qb * 256; U.nvalid = 256;
            } else {
                const int bh = T.sb0 * 8 + x * nbs + j, b = bh >> 3, h = bh & 7;
                const size_t r0 = (size_t)MP + (size_t)b * ST;
                const size_t kb = ((size_t)(l * SB + b) * KSROWS) * 512 + h * 64;
                U.Q = proj + r0 * PP + C_Q + h * 64; U.K = (const abf*)(a.ws + WS_KS) + kb; U.V = (const abf*)(a.ws + WS_VS) + kb;
                U.nbk = nbks + (size_t)bh * NBKS; U.O = mix + r0 * DM + 256 + h * 64; U.G = proj + r0 * PP + C_AG + h * 64;
                U.kp = 512; U.NT = KSROWS / 64; U.qoff = PAST; U.nvalid = ST;
            }
            { const int tl = F.lane; const float ref = U.nbk[U.qoff];
              const float far = (tl < U.NT - 4) ? U.nbk[64 * tl + 63] : ref;
              const unsigned long long dead = __ballot((tl < U.NT - 4) && (ref - far > skip_thr));
              int D = (int)__builtin_ctzll(~dead) & ~1; D = __builtin_amdgcn_readfirstlane(D);
              if (D > U.NT - 4) D = (U.NT - 4) & ~1;
              U.K += (size_t)D * 64 * U.kp; U.V += (size_t)D * 64 * U.kp; U.nbk += D * 64; U.NT -= D; U.qoff -= D * 64; }
            if (F.wave0 * 32 < U.nvalid) attn_body::attn_unit<8>(U, lds, F.wave0); else attn_body::attn_unit_helper(U, lds, F.wave0);
        }
    }
    __syncthreads();
}

__global__ void __launch_bounds__(NWAVES * 64, 2) mega_fwd(Args args) {
    extern __shared__ __attribute__((aligned(16))) unsigned char lds[];
    cg::grid_group grid = cg::this_grid();
    Frame F;
    F.lds = (LAS unsigned char*)lds;
    F.wave0 = __builtin_amdgcn_readfirstlane((int)threadIdx.x >> 6); FRAME_REFRESH(F);
    F.G = gridDim.x; { const int bx = blockIdx.x; F.vcu = (F.G % 8 == 0) ? (bx % 8) * (F.G / 8) + bx / 8 : bx; }
    const int NS = 1;
    Str T; Str T0;
    { const int bx = blockIdx.x, xi = bx / 8, xc = bx % 8;
      T.s = NS == 2 ? (xi & 1) : 0; T.GS = F.G / NS; T.cs = NS == 2 ? (xc * (F.G / 16) + (xi >> 1)) : F.vcu; T.cg = NS == 2 ? ((xi >> 1) * 8 + xc) : bx;
      T.rowsP = MP / NS; T.rowP0 = T.s * T.rowsP; T.SBs = SB / NS; T.sb0 = T.s * T.SBs;
      T0.s = 0; T0.GS = F.G; T0.cs = F.vcu; T0.cg = bx; T0.rowsP = MP; T0.rowP0 = 0; T0.SBs = SB; T0.sb0 = 0; }
    unsigned* barw = (unsigned*)(args.ws + WS_BAR) + T.s * 4096;
    volatile LAS unsigned* barst = (volatile LAS unsigned*)(F.lds + RING_BYTES + 512);
#define SEAM(k) do { xcd_barrier(bar); } while (0)
    XcdBarrier bar; bar.w0 = F.wave0; bar.bar = barw; bar.x = 0; bar.st = barst; bar.G = (unsigned)T.GS;
    if (threadIdx.x < 2) barst[threadIdx.x] = 0u;
    if (blockIdx.x == 0) for (int i_ = threadIdx.x; i_ < 2 * 4096 + 2048; i_ += NWAVES * 64) ((unsigned*)(args.ws + WS_BAR))[i_] = 0u;
    __syncthreads();
    unsigned char* ws = args.ws;
    float* out = args.out;

    for (int r_ = 0; r_ < REP_P0; ++r_) { p0_prologue(F, args); __syncthreads(); }
    for (int r_ = 0; r_ < REP_PA; ++r_) pa_phase(F, args, 0, args.in[0], args.in[1], T0);
    grid.sync();
    bar = xcd_barrier_post(barw, barst, F.wave0, (unsigned)T.GS);
    if (T.s == 1) stagger_wait(1);
#pragma unroll 1
    for (int l = 0; l < NL; ++l) {
        {
            FRAME_REFRESH(F);
            scan_phase(F, args, l, T);
            { const int nscan = (T.rowsP / SEQ) * 8 + T.SBs * 8;
              const int nfree = T.GS > nscan ? T.GS - nscan : T.GS; const int w0 = ((T.GS > nscan ? T.cs - nscan : T.cs)) * NWAVES + F.wave;
              if (w0 >= 0) for (int it = w0; it < T.SBs * (PP / 64); it += nfree * NWAVES) small_inproj_item(args, l, T.sb0 + it / (PP / 64), it % (PP / 64), F.lane);
              __syncthreads(); }
            pg8::Gemm g{(const bf16*)(ws + WS_XN) + (size_t)T.rowP0 * DM, (const bf16*)(ws + WS_WIN) + (size_t)l * PP * DM, T.rowsP, PP, DM};
            pg8::StaticOrder S; S.init(T.rowsP, PP, T.GS, T.cg);
            pg8::EpiIn E;
            E.proj = (bf16*)(ws + WS_PROJ); E.ks = (bf16*)(ws + WS_KS) + (size_t)l * SB * KSROWS * 512; E.vs = (bf16*)(ws + WS_VS) + (size_t)l * SB * KSROWS * 512;
            E.outk_p = out + O_KP + (size_t)l * MP * 512; E.outv_p = out + O_VP + (size_t)l * MP * 512;
            E.outk_s = out + O_KS + (size_t)l * MS * 512; E.outv_s = out + O_VS + (size_t)l * MS * 512;
            E.qg = args.in[10] + l * 64; E.kg = args.in[11] + l * 64; E.row0 = T.rowP0;
            for (int r_ = 0; r_ < REP_GIN; ++r_) pg8::gemm_phase<pg8::EpiIn, pg8::StaticOrder, true, true>(F.lds, g, S, E, F.tid);
        }
        SEAM(0);
        {
            FRAME_REFRESH(F);
            for (int r_ = 0; r_ < REP_MIX; ++r_) mixer_phase(F, args, l, T);
            __syncthreads();
            for (int r_ = 0; r_ < REP_ATTN; ++r_) attention_phase(F, args, l, (char*)lds, T);
        }
        SEAM(1);
        {
            FRAME_REFRESH(F);
            { const int gw = T.cs * NWAVES + F.wave;
              for (int it = gw; it < T.SBs * (DM / 64); it += T.GS * NWAVES) small_outproj_item(args, l, T.sb0 + it / (DM / 64), it % (DM / 64), F.lane, l == 0 ? args.in[1] : out + O_YS, out + O_YS);
              __syncthreads(); }
            pg8::Gemm g{(const bf16*)(ws + WS_XN) + (size_t)T.rowP0 * DM, (const bf16*)(ws + WS_WOUT) + (size_t)l * DM * DM, T.rowsP, DM, DM};
            pg8::StaticOrder S; S.init(T.rowsP, DM, T.GS, T.cg);
            if (l == 0) { pg8::EpiOutB E; E.base_p = args.in[0]; E.out_b = (bf16*)(ws + WS_X1B); E.row0 = T.rowP0;
                for (int r_ = 0; r_ < REP_GOUT0; ++r_) pg8::gemm_phase<pg8::EpiOutB, pg8::StaticOrder, true, true>(F.lds, g, S, E, F.tid); }
            else { pg8::EpiOutF E; E.base_b = (const bf16*)(ws + WS_X1B); E.out_p = out + O_YP; E.row0 = T.rowP0;
                pg8::gemm_phase<pg8::EpiOutF, pg8::StaticOrder, true, true>(F.lds, g, S, E, F.tid); }
        }
        if (l + 1 < NL) {
            SEAM(2);
            { FRAME_REFRESH(F); for (int r_ = 0; r_ < REP_PA; ++r_) pa_phase(F, args, l + 1, out + O_YP, out + O_YS, T, (const bf16*)(ws + WS_X1B)); }
            SEAM(3);
        }
    }
#undef SEAM
}

#ifndef MK_MULTI
#define MK_MULTI 0
#endif
constexpr int N_PHASES = 8;

extern "C" void kernel_launch(void* const* d_in, const int* in_sizes, int n_in, void* d_out, int out_size, void* d_ws, size_t ws_size, hipStream_t stream) {
    static int grid = 0;
    if (grid == 0) {
        if (n_in != 16 || (size_t)out_size != O_END || ws_size < WS_END) { fprintf(stderr, "kernel_launch: shape mismatch: n_in %d out %d (want %zu) ws %zu (want %zu)\n", n_in, out_size, (size_t)O_END, ws_size, (size_t)WS_END); grid = -1; return; }
        int dev = 0, cus = 0, per_cu = 0;
        if (hipGetDevice(&dev) != hipSuccess || hipDeviceGetAttribute(&cus, hipDeviceAttributeMultiprocessorCount, dev) != hipSuccess) { grid = -1; return; }
        if (hipFuncSetAttribute((const void*)mega_fwd, hipFuncAttributeMaxDynamicSharedMemorySize, LDS_BYTES) != hipSuccess) { fprintf(stderr, "kernel_launch: hipFuncSetAttribute failed\n"); grid = -1; return; }
        if (hipOccupancyMaxActiveBlocksPerMultiprocessor(&per_cu, (const void*)mega_fwd, NWAVES * 64, LDS_BYTES) != hipSuccess || per_cu < 1) { fprintf(stderr, "kernel_launch: occupancy query says %d\n", per_cu); per_cu = 1; }
        (void)hipGetLastError();
        grid = cus * 1;
    }
    if (grid < 0) return;
    Args a{};
    for (int i = 0; i < 16; ++i) a.in[i] = (const float*)d_in[i];
    a.out = (float*)d_out; a.ws = (unsigned char*)d_ws;
#if MK_MULTI
    for (int p = 0; p < N_PHASES; ++p) { a.ph_lo = p; a.ph_hi = p + 1; hipLaunchKernelGGL(mega_fwd, dim3(grid), dim3(NWAVES * 64), LDS_BYTES, stream, a); }
#else
    a.ph_lo = 0; a.ph_hi = N_PHASES;
    void* kargs[] = {&a};
    hipError_t e = hipLaunchCooperativeKernel((const void*)mega_fwd, dim3(grid), dim3(NWAVES * 64), kargs, LDS_BYTES, stream);
    if (e != hipSuccess) fprintf(stderr, "cooperative launch failed: %s (grid %d)\n", hipGetErrorString(e), grid);
#endif
}
```

```cpp
#include <hip/hip_runtime.h>
#include <hip/hip_cooperative_groups.h>
#include <hip/hip_bf16.h>
#include <cstdio>
#include <cstdint>
#include <cmath>
namespace pg8 {
#define PG8_LAS __attribute__((address_space(3)))
typedef unsigned short bf16_t;
typedef short bf16x8 __attribute__((ext_vector_type(8)));
typedef float f32x4 __attribute__((ext_vector_type(4)));
typedef unsigned u32x4 __attribute__((ext_vector_type(4)));
constexpr int BM = 256, BK = 64, HALF = 128, HTB = HALF * BK * 2  , STAGE_BYTES = 8 * HTB, NXCD = 8, WGM = 8;

__host__ __device__ __forceinline__ int lds_byte(int r, int c) { const int st = (r >> 4) * 2 + (c >> 5), rr = r & 15, cc = c & 31, ob = rr * 64 + cc * 2; return st * 1024 + (ob ^ (((ob >> 9) & 1) << 5)); }
__host__ __device__ __forceinline__ void stage_rc(int b, int& R, int& C) { const int st = b / 1024, sb = b % 1024, swz = sb ^ (((sb >> 9) & 1) << 5); R = (st >> 1) * 16 + swz / 64; C = (st & 1) * 32 + (swz % 64) / 2; }
__host__ __device__ __forceinline__ int perm32(int rho) { const int n = rho >> 4, i = rho & 15; return 8 * (i >> 2) + 4 * n + (i & 3); }

struct Unit { int pm, pn; };
struct Gemm { const bf16_t* A; const bf16_t* Bt; int M, N, K; };

struct StaticOrder {
    int nM, nN, nwg, G, c;
    __host__ __device__ void init(int M, int N, int G_, int c_) { nM = M / BM; nN = N / BM; nwg = nM * nN; G = G_; c = c_; }
    __host__ __device__ bool next(int i, Unit& u) const {
        const long L = (long)i * G + c; if (L >= nwg) return false;
        int wgid = (int)L; { const int q = nwg / NXCD, r = nwg % NXCD, xcd = wgid % NXCD, off = wgid / NXCD; wgid = (xcd < r ? xcd * (q + 1) : r * (q + 1) + (xcd - r) * q) + off; }
        const int nig = WGM * nN, gid = wgid / nig, fm = gid * WGM, gsz = (nM - fm) < WGM ? (nM - fm) : WGM;
        u.pm = fm + ((wgid % nig) % gsz); u.pn = (wgid % nig) / gsz;
        if (nN == 14) u.pn = (int)((0xD7CBA598362140ULL >> (4 * u.pn)) & 15ULL);
        return true;
    }
    __device__ __forceinline__ void a_ready(const Unit&) const {}
    __device__ __forceinline__ void done(const Unit&) const {}
};

__device__ __forceinline__ unsigned cvt_pk_bf16(float lo, float hi) { unsigned r; asm volatile("v_cvt_pk_bf16_f32 %0, %1, %2" : "=v"(r) : "v"(lo), "v"(hi)); return r; }
typedef float f32x2 __attribute__((ext_vector_type(2)));
constexpr int E_MP = 65536, E_PP = 3584, E_KSROWS = 2176, E_PAST = 2048;
constexpr float E_C2 = 0.125f * 1.4426950408889634f;
struct EpiIn {
    static constexpr bool PERM = true, AFTER_DRAIN = false;
    bf16_t* proj; bf16_t* ks; bf16_t* vs; float* outk_p; float* outv_p; float* outk_s; float* outv_s; const float* qg; const float* kg; int row0;
    __device__ __forceinline__ void operator()(const f32x4 (&acc)[2][2][4][2], const Unit& u, int wr, int wc, int fr, int fq) const {
        const int pn = u.pn; const bool samp = false;
        const int nai = samp ? 1 : 2;
        if (pn >= 2 && pn <= 5) {
            const bool isq = pn < 4; const int head = (pn & 1) * 4 + wc;
            const float* g = isq ? qg : kg;
            f32x4 gv[2][2];
#pragma unroll
            for (int bj = 0; bj < 2; ++bj)
#pragma unroll
                for (int n = 0; n < 2; ++n) gv[bj][n] = *(const f32x4*)(g + 32 * bj + 8 * fq + 4 * n);
#pragma unroll
            for (int ai = 0; ai < 2; ++ai) if (ai < nai)
#pragma unroll
                for (int m = 0; m < 4; ++m) {
                    const int row = row0 + u.pm * BM + ai * HALF + wr * 64 + m * 16 + fr;
                    float ss = 0.f;
#pragma unroll
                    for (int bj = 0; bj < 2; ++bj)
#pragma unroll
                        for (int n = 0; n < 2; ++n) { const f32x4 x = acc[ai][bj][m][n]; ss += (x[0] * x[0] + x[1] * x[1]) + (x[2] * x[2] + x[3] * x[3]); }
                    { const int ln = fr + 16 * fq; ss += __int_as_float(__builtin_amdgcn_ds_bpermute((ln ^ 16) << 2, __float_as_int(ss))); ss += __int_as_float(__builtin_amdgcn_ds_bpermute((ln ^ 32) << 2, __float_as_int(ss))); }
                    float rs = __builtin_amdgcn_rsqf(ss * (1.0f / 64.0f) + 1e-6f);
                    const float rq = rs * E_C2;
#pragma unroll
                    for (int bj = 0; bj < 2; ++bj) {
                        const f32x4 k0 = acc[ai][bj][m][0] * rs * gv[bj][0], k1 = acc[ai][bj][m][1] * rs * gv[bj][1];
                        const int col = head * 64 + 32 * bj + 8 * fq;
                        if (isq) { const f32x4 v0 = acc[ai][bj][m][0] * rq * gv[bj][0], v1 = acc[ai][bj][m][1] * rq * gv[bj][1];
                            u32x4 w; w.x = cvt_pk_bf16(v0[0], v0[1]); w.y = cvt_pk_bf16(v0[2], v0[3]); w.z = cvt_pk_bf16(v1[0], v1[1]); w.w = cvt_pk_bf16(v1[2], v1[3]);
                            *(u32x4*)(proj + (size_t)row * E_PP + 512 + col) = w; }
                        else { u32x4 w; w.x = cvt_pk_bf16(k0[0], k0[1]); w.y = cvt_pk_bf16(k0[2], k0[3]); w.z = cvt_pk_bf16(k1[0], k1[1]); w.w = cvt_pk_bf16(k1[2], k1[3]);
                            if (!samp) { *(u32x4*)(proj + (size_t)row * E_PP + 1024 + col) = w; float* o = outk_p + (size_t)row * 512 + col; __builtin_nontemporal_store(k0, (f32x4*)o); __builtin_nontemporal_store(k1, (f32x4*)(o + 4)); }
                            else { const int lr = row - E_MP, b = lr >> 4, t = lr & 15; *(u32x4*)(ks + ((size_t)b * E_KSROWS + E_PAST + t) * 512 + col) = w; float* o = outk_s + (size_t)lr * 512 + col; *(f32x4*)o = k0; *(f32x4*)(o + 4) = k1; } }
                    }
                }
        } else if (pn == 6 || pn == 7) {
#pragma unroll
            for (int ai = 0; ai < 2; ++ai) if (ai < nai)
#pragma unroll
                for (int m = 0; m < 4; ++m) {
                    const int row = row0 + u.pm * BM + ai * HALF + wr * 64 + m * 16 + fr;
#pragma unroll
                    for (int bj = 0; bj < 2; ++bj) {
                        const f32x4 v0 = acc[ai][bj][m][0], v1 = acc[ai][bj][m][1];
                        const int col = (pn - 6) * 256 + 128 * bj + 32 * wc + 8 * fq;
                        u32x4 w; w.x = cvt_pk_bf16(v0[0], v0[1]); w.y = cvt_pk_bf16(v0[2], v0[3]); w.z = cvt_pk_bf16(v1[0], v1[1]); w.w = cvt_pk_bf16(v1[2], v1[3]);
                        if (!samp) { *(u32x4*)(proj + (size_t)row * E_PP + 1536 + col) = w; float* o = outv_p + (size_t)row * 512 + col; __builtin_nontemporal_store(v0, (f32x4*)o); __builtin_nontemporal_store(v1, (f32x4*)(o + 4)); }
                        else { const int lr = row - E_MP, b = lr >> 4, t = lr & 15; *(u32x4*)(vs + ((size_t)b * E_KSROWS + E_PAST + t) * 512 + col) = w; float* o = outv_s + (size_t)lr * 512 + col; *(f32x4*)o = v0; *(f32x4*)(o + 4) = v1; }
                    }
                }
        } else {
#pragma unroll
            for (int ai = 0; ai < 2; ++ai) if (ai < nai)
#pragma unroll
                for (int m = 0; m < 4; ++m) {
                    bf16_t* rowp = proj + (size_t)(row0 + u.pm * BM + ai * HALF + wr * 64 + m * 16 + fr) * E_PP + pn * BM + wc * 32 + 8 * fq;
#pragma unroll
                    for (int bj = 0; bj < 2; ++bj) { const f32x4 v0 = acc[ai][bj][m][0], v1 = acc[ai][bj][m][1];
                        u32x4 w; w.x = cvt_pk_bf16(v0[0], v0[1]); w.y = cvt_pk_bf16(v0[2], v0[3]); w.z = cvt_pk_bf16(v1[0], v1[1]); w.w = cvt_pk_bf16(v1[2], v1[3]);
                        *(u32x4*)(rowp + bj * HALF) = w; }
                }
        }
    }
};
struct EpiOut {
    static constexpr bool PERM = false, AFTER_DRAIN = false;
    const float* base_p; const float* base_s; float* out_p; float* out_s; int row0;
    __device__ __forceinline__ void operator()(const f32x4 (&acc)[2][2][4][2], const Unit& u, int wr, int wc, int fr, int fq) const {
        const int col0 = u.pn * BM + wc * 32 + 4 * fq;
#pragma unroll
        for (int ai = 0; ai < 2; ++ai) {
            f32x4 pre[4][2][2];
            const size_t off0 = (size_t)(row0 + u.pm * BM + ai * HALF + wr * 64 + fr) * 1024 + col0;
#pragma unroll
            for (int m = 0; m < 4; ++m)
#pragma unroll
                for (int bj = 0; bj < 2; ++bj)
#pragma unroll
                    for (int n = 0; n < 2; ++n) pre[m][bj][n] = *(const f32x4*)(base_p + off0 + (size_t)m * 16 * 1024 + bj * HALF + n * 16);
            asm volatile("" ::: "memory");
#pragma unroll
            for (int m = 0; m < 4; ++m)
#pragma unroll
                for (int bj = 0; bj < 2; ++bj)
#pragma unroll
                    for (int n = 0; n < 2; ++n) *(f32x4*)(out_p + off0 + (size_t)m * 16 * 1024 + bj * HALF + n * 16) = pre[m][bj][n] + acc[ai][bj][m][n];
            asm volatile("" ::: "memory");
        }
    }
};

struct EpiOutB {
    static constexpr bool PERM = true, AFTER_DRAIN = false;
    const float* base_p; bf16_t* out_b; int row0;
    __device__ __forceinline__ void operator()(const f32x4 (&acc)[2][2][4][2], const Unit& u, int wr, int wc, int fr, int fq) const {
        const int col0 = u.pn * BM + wc * 32 + 8 * fq;
#pragma unroll
        for (int ai = 0; ai < 2; ++ai) {
            f32x4 pre[4][2][2];
            const size_t off0 = (size_t)(row0 + u.pm * BM + ai * HALF + wr * 64 + fr) * 1024 + col0;
#pragma unroll
            for (int m = 0; m < 4; ++m)
#pragma unroll
                for (int bj = 0; bj < 2; ++bj)
#pragma unroll
                    for (int n = 0; n < 2; ++n) pre[m][bj][n] = *(const f32x4*)(base_p + off0 + (size_t)m * 16 * 1024 + bj * HALF + n * 4);
            asm volatile("" ::: "memory");
#pragma unroll
            for (int m = 0; m < 4; ++m)
#pragma unroll
                for (int bj = 0; bj < 2; ++bj) { const f32x4 v0 = pre[m][bj][0] + acc[ai][bj][m][0], v1 = pre[m][bj][1] + acc[ai][bj][m][1];
                    u32x4 w; w.x = cvt_pk_bf16(v0[0], v0[1]); w.y = cvt_pk_bf16(v0[2], v0[3]); w.z = cvt_pk_bf16(v1[0], v1[1]); w.w = cvt_pk_bf16(v1[2], v1[3]);
                    *(u32x4*)(out_b + off0 + (size_t)m * 16 * 1024 + bj * HALF) = w; }
            asm volatile("" ::: "memory");
        }
    }
};
struct EpiOutF {
    static constexpr bool PERM = true, AFTER_DRAIN = false;
    const bf16_t* base_b; float* out_p; int row0;
    __device__ __forceinline__ void operator()(const f32x4 (&acc)[2][2][4][2], const Unit& u, int wr, int wc, int fr, int fq) const {
        const int col0 = u.pn * BM + wc * 32 + 8 * fq;
#pragma unroll
        for (int ai = 0; ai < 2; ++ai) {
            u32x4 pre[4][2];
            const size_t off0 = (size_t)(row0 + u.pm * BM + ai * HALF + wr * 64 + fr) * 1024 + col0;
#pragma unroll
            for (int m = 0; m < 4; ++m)
#pragma unroll
                for (int bj = 0; bj < 2; ++bj) pre[m][bj] = __builtin_nontemporal_load((const u32x4*)(base_b + off0 + (size_t)m * 16 * 1024 + bj * HALF));
            asm volatile("" ::: "memory");
#pragma unroll
            for (int m = 0; m < 4; ++m)
#pragma unroll
                for (int bj = 0; bj < 2; ++bj) { const u32x4 p = pre[m][bj];
                    const f32x4 b0 = (f32x4){__uint_as_float(p.x << 16), __uint_as_float(p.x & 0xffff0000u), __uint_as_float(p.y << 16), __uint_as_float(p.y & 0xffff0000u)};
                    const f32x4 b1 = (f32x4){__uint_as_float(p.z << 16), __uint_as_float(p.z & 0xffff0000u), __uint_as_float(p.w << 16), __uint_as_float(p.w & 0xffff0000u)};
                    float* o = out_p + off0 + (size_t)m * 16 * 1024 + bj * HALF;
                    *(f32x4*)o = b0 + acc[ai][bj][m][0]; *(f32x4*)(o + 4) = b1 + acc[ai][bj][m][1]; }
            asm volatile("" ::: "memory");
        }
    }
};
template <class Epi, class Sched, bool ALIGN_EPI = false, bool SP2 = false>
__device__ __forceinline__ void gemm_phase(PG8_LAS unsigned char* lds, const Gemm g, const Sched& S, const Epi& E, int tid_in) {
    int tid_ = tid_in; asm volatile("" : "+v"(tid_));
    const int tid = tid_, wid = __builtin_amdgcn_readfirstlane(tid >> 6), lane = tid & 63, wr = wid >> 2, wc = wid & 3, fr = lane & 15, fq = lane >> 4;
    const int K = g.K, nt = K / BK;
    unsigned voffA[2], voffB[2];
#pragma unroll
    for (int i = 0; i < 2; ++i) { int R, C; stage_rc(tid * 16 + i * 8192, R, C); const int Rb = Epi::PERM ? ((R & ~31) + perm32(R & 31)) : R;
        voffA[i] = (unsigned)(R * K + C) * 2u; voffB[i] = (unsigned)(Rb * K + C) * 2u; }
    const size_t kstep = (size_t)(BK * 2);
    const size_t hstep = (size_t)HALF * K * 2;
    const size_t tstep = 2 * hstep;
    const unsigned ldsw = (unsigned)wid * 1024u;
    const int aoff = lds_byte(wr * 64 + fr, fq * 8), boff = lds_byte(wc * 32 + fr, fq * 8);
#define PG8_SA(b, h) (((b) * 2 + (h)) * HTB)
#define PG8_SB(b, h) ((4 + (b) * 2 + (h)) * HTB)
#define PG8_STAGE(bufoff, gbase, voff) do { _Pragma("unroll") for (int _i = 0; _i < 2; ++_i) \
        __builtin_amdgcn_global_load_lds((const unsigned*)((const char*)(gbase) + (voff)[_i]), (PG8_LAS unsigned*)(lds + (bufoff) + ldsw + _i * 8192), 16, 0, 0); } while (0)
#define PG8_LDA(dst, b, h) do { _Pragma("unroll") for (int m = 0; m < 4; ++m) _Pragma("unroll") for (int k = 0; k < 2; ++k) dst[m][k] = *(const PG8_LAS bf16x8*)(lds + PG8_SA(b, h) + aoff + m * 2048 + k * 1024); } while (0)
#define PG8_LDB(dst, b, h) do { _Pragma("unroll") for (int n = 0; n < 2; ++n) _Pragma("unroll") for (int k = 0; k < 2; ++k) dst[n][k] = *(const PG8_LAS bf16x8*)(lds + PG8_SB(b, h) + boff + n * 2048 + k * 1024); } while (0)
#define PG8_MMA(ai, bj, At, Bt) do { __builtin_amdgcn_s_setprio(1); _Pragma("unroll") for (int m = 0; m < 4; ++m) _Pragma("unroll") for (int n = 0; n < 2; ++n) _Pragma("unroll") for (int k = 0; k < 2; ++k) \
        acc[ai][bj][m][n] = __builtin_amdgcn_mfma_f32_16x16x32_bf16(Bt[n][k], At[m][k], acc[ai][bj][m][n], 0, 0, 0); __builtin_amdgcn_s_setprio(0); } while (0)
#define PG8_WAIT_V(n) asm volatile("s_waitcnt vmcnt(" #n ")" ::: "memory")
#define PG8_WAIT_L(n) asm volatile("s_waitcnt lgkmcnt(" #n ")" ::: "memory")
#define PG8_BAR __builtin_amdgcn_s_barrier()
#define PG8_SCHED __builtin_amdgcn_sched_barrier(0)
    Unit cur, nxt; int ui = 0;
    if (!S.next(0, cur)) return;
    f32x4 acc[2][2][4][2];
#pragma unroll
    for (int a = 0; a < 2; ++a)
#pragma unroll
        for (int b = 0; b < 2; ++b)
#pragma unroll
            for (int m = 0; m < 4; ++m)
#pragma unroll
                for (int n = 0; n < 2; ++n) acc[a][b][m][n] = (f32x4){0.f, 0.f, 0.f, 0.f};
    bf16x8 At[4][2], B0[2][2], B1[2][2];
    const char* cA = (const char*)g.A + (size_t)cur.pm * tstep; const char* cB = (const char*)g.Bt + (size_t)cur.pn * tstep;
    S.a_ready(cur);
    if constexpr (SP2) {
        PG8_STAGE(PG8_SB(0, 0), cB, voffB); PG8_STAGE(PG8_SB(0, 1), cB + hstep, voffB); PG8_STAGE(PG8_SA(0, 0), cA, voffA); PG8_STAGE(PG8_SA(0, 1), cA + hstep, voffA);
        if (wr == 1) PG8_BAR;
        PG8_WAIT_V(2); PG8_BAR;
        PG8_STAGE(PG8_SB(1, 0), cB + kstep, voffB); PG8_STAGE(PG8_SA(1, 0), cA + kstep, voffA); PG8_STAGE(PG8_SB(1, 1), cB + hstep + kstep, voffB);
        PG8_WAIT_V(6); PG8_BAR;
    } else {
        PG8_STAGE(PG8_SB(0, 0), cB, voffB); PG8_STAGE(PG8_SA(0, 0), cA, voffA); PG8_STAGE(PG8_SB(0, 1), cB + hstep, voffB); PG8_STAGE(PG8_SA(0, 1), cA + hstep, voffA);
        if (wr == 1) PG8_BAR;
        PG8_WAIT_V(4); PG8_BAR;
        PG8_STAGE(PG8_SB(1, 0), cB + kstep, voffB); PG8_STAGE(PG8_SA(1, 0), cA + kstep, voffA); PG8_STAGE(PG8_SB(1, 1), cB + hstep + kstep, voffB);
        PG8_WAIT_V(6); PG8_BAR;
    }
    for (;;) {
        const bool has_next = S.next(ui + 1, nxt);
        const char* nA = has_next ? (const char*)g.A + (size_t)nxt.pm * tstep : cA; const char* nB = has_next ? (const char*)g.Bt + (size_t)nxt.pn * tstep : cB;
        for (int t = 0; t < nt; t += 2) {
            const bool last = (t == nt - 2);
            const char* a1 = cA + (size_t)(t + 1) * kstep;
            const char* a2 = last ? nA : cA + (size_t)(t + 2) * kstep; const char* b2 = last ? nB : cB + (size_t)(t + 2) * kstep;
            const char* a3 = a2 + kstep; const char* b3 = b2 + kstep;
            if (last && has_next) S.a_ready(nxt);
            if constexpr (SP2) {
            PG8_LDB(B0, 0, 0); PG8_LDB(B1, 0, 1); PG8_SCHED; PG8_LDA(At, 0, 0); PG8_STAGE(PG8_SA(1, 1), a1 + hstep, voffA);
            PG8_WAIT_V(8); PG8_WAIT_L(0); PG8_BAR; PG8_MMA(0, 0, At, B0); PG8_MMA(0, 1, At, B1); PG8_BAR; PG8_SCHED;
            PG8_LDA(At, 0, 1); PG8_STAGE(PG8_SB(0, 0), b2, voffB); PG8_STAGE(PG8_SB(0, 1), b2 + hstep, voffB); PG8_STAGE(PG8_SA(0, 0), a2, voffA);
            PG8_WAIT_V(8); PG8_WAIT_L(0); PG8_BAR; PG8_MMA(1, 0, At, B0); PG8_MMA(1, 1, At, B1); PG8_BAR; PG8_SCHED;
            PG8_LDB(B0, 1, 0); PG8_LDB(B1, 1, 1); PG8_SCHED; PG8_LDA(At, 1, 0); PG8_STAGE(PG8_SA(0, 1), a2 + hstep, voffA);
            PG8_WAIT_V(8); PG8_WAIT_L(0); PG8_BAR; PG8_MMA(0, 0, At, B0); PG8_MMA(0, 1, At, B1); PG8_BAR; PG8_SCHED;
            PG8_LDA(At, 1, 1); PG8_STAGE(PG8_SB(1, 0), b3, voffB); PG8_STAGE(PG8_SB(1, 1), b3 + hstep, voffB); PG8_STAGE(PG8_SA(1, 0), a3, voffA);
            PG8_WAIT_V(8); PG8_WAIT_L(0); PG8_BAR; PG8_MMA(1, 0, At, B0); PG8_MMA(1, 1, At, B1); PG8_BAR; PG8_SCHED;
            } else {
            PG8_LDB(B0, 0, 0); PG8_SCHED; PG8_LDA(At, 0, 0); PG8_STAGE(PG8_SA(1, 1), a1 + hstep, voffA);
            PG8_WAIT_L(8); PG8_BAR; PG8_WAIT_L(0); PG8_MMA(0, 0, At, B0); PG8_BAR; PG8_SCHED;
            PG8_LDB(B1, 0, 1); PG8_STAGE(PG8_SB(0, 0), b2, voffB);
            PG8_BAR; PG8_WAIT_L(0); PG8_MMA(0, 1, At, B1); PG8_BAR;
            PG8_LDA(At, 0, 1); PG8_STAGE(PG8_SA(0, 0), a2, voffA);
            PG8_BAR; PG8_WAIT_L(0); PG8_MMA(1, 0, At, B0); PG8_BAR; PG8_SCHED;
            PG8_STAGE(PG8_SB(0, 1), b2 + hstep, voffB);
            PG8_WAIT_V(6); PG8_BAR; PG8_MMA(1, 1, At, B1); PG8_BAR;
            PG8_LDB(B0, 1, 0); PG8_SCHED; PG8_LDA(At, 1, 0); PG8_STAGE(PG8_SA(0, 1), a2 + hstep, voffA);
            PG8_WAIT_L(8); PG8_BAR; PG8_WAIT_L(0); PG8_MMA(0, 0, At, B0); PG8_BAR; PG8_SCHED;
            PG8_LDB(B1, 1, 1); PG8_STAGE(PG8_SB(1, 0), b3, voffB);
            PG8_BAR; PG8_WAIT_L(0); PG8_MMA(0, 1, At, B1); PG8_BAR;
            PG8_LDA(At, 1, 1); PG8_STAGE(PG8_SA(1, 0), a3, voffA);
            PG8_BAR; PG8_WAIT_L(0); PG8_MMA(1, 0, At, B0); PG8_BAR; PG8_SCHED;
            PG8_STAGE(PG8_SB(1, 1), b3 + hstep, voffB);
            PG8_WAIT_V(6); PG8_BAR; PG8_MMA(1, 1, At, B1); PG8_BAR;
            }
        }
        if constexpr (ALIGN_EPI) { if (wr == 0) PG8_BAR; }
        if constexpr (!Epi::AFTER_DRAIN) { E(acc, cur, wr, wc, fr, fq); S.done(cur); }
        if (!has_next) break;
#pragma unroll
        for (int a = 0; a < 2; ++a)
#pragma unroll
            for (int b = 0; b < 2; ++b)
#pragma unroll
                for (int m = 0; m < 4; ++m)
#pragma unroll
                    for (int n = 0; n < 2; ++n) acc[a][b][m][n] = (f32x4){0.f, 0.f, 0.f, 0.f};
        cur = nxt; cA = nA; cB = nB; ++ui;
        if constexpr (ALIGN_EPI) { if (wr == 1) PG8_BAR; }
    }
    PG8_WAIT_V(0);
    if constexpr (!ALIGN_EPI) { if (wr == 0) PG8_BAR; }
    PG8_BAR;
    if constexpr (Epi::AFTER_DRAIN) { E.fused(acc, cur, wr, wc, fr, fq, lds, wid, lane); S.done(cur); }
#undef PG8_SA
#undef PG8_SB
#undef PG8_STAGE
#undef PG8_LDA
#undef PG8_LDB
#undef PG8_MMA
#undef PG8_WAIT_V
#undef PG8_WAIT_L
#undef PG8_BAR
#undef PG8_SCHED
}
}
namespace attn_body {
using bf16=__hip_bfloat16;
using bf16x8=__attribute__((ext_vector_type(8)))short;
using s16x4=__attribute__((ext_vector_type(4)))short;
using f32x16=__attribute__((ext_vector_type(16)))float;
using f32x4a=__attribute__((ext_vector_type(4)))float;
using u32x4=__attribute__((ext_vector_type(4)))unsigned;
constexpr int D=64;
constexpr int NW=8,QBLK=32,QB=QBLK*NW,KVBLK=64;
constexpr int QP=3584, OP=1024, GP=3584;
__device__ __forceinline__ int crow(int r,int hi){return (r&3)+8*(r>>2)+4*hi;}
#define SBAR() __builtin_amdgcn_sched_barrier(0)
__device__ __forceinline__ void cmask(f32x16&p0,f32x16&p1,int koff,int qrel,int hi){
  const float NEG=-INFINITY; int kb=koff+4*hi;
  #pragma unroll
  for(int r=0;r<16;++r){int kv=kb+(r&3)+8*(r>>2); if(kv>qrel)p0[r]=NEG; if(kv+32>qrel)p1[r]=NEG;}
}
constexpr int NSLOT=3, SLOTB=8192;
constexpr int LDS_K=0, LDS_V=NSLOT*SLOTB, LDS_WS=2*NSLOT*SLOTB, LDS_OST=LDS_WS+NW*64*4, LDS_BIAS=LDS_OST+NW*4096, LDS_BYTES=LDS_BIAS+NW*NSLOT*256;
constexpr float C2=0.125f*1.4426950408889634f;
__device__ __forceinline__ void glds16(const void*gsrc,unsigned lds_dst){unsigned keep;
  asm volatile("s_mov_b32 %0, m0\n\ts_mov_b32 m0, %2\n\ts_nop 0\n\tglobal_load_lds_dwordx4 %1, off\n\ts_mov_b32 m0, %0":"=&s"(keep):"v"(gsrc),"s"(lds_dst):"memory");}
__device__ __forceinline__ void glds4(const void*gsrc,unsigned lds_dst){unsigned keep;
  asm volatile("s_mov_b32 %0, m0\n\ts_mov_b32 m0, %2\n\ts_nop 0\n\tglobal_load_lds_dword %1, off\n\ts_mov_b32 m0, %0":"=&s"(keep):"v"(gsrc),"s"(lds_dst):"memory");}
typedef float f32x2_t __attribute__((ext_vector_type(2))); typedef __bf16 bf16x2_t __attribute__((ext_vector_type(2)));
__device__ __forceinline__ unsigned cvtpk_s(float lo,float hi){f32x2_t v={lo,hi};bf16x2_t b=__builtin_convertvector(v,bf16x2_t);return __builtin_bit_cast(unsigned,b);}
#define WAIT_BAR(N) asm volatile("s_waitcnt vmcnt(" #N ") lgkmcnt(0)\n\ts_barrier":::"memory")
typedef __attribute__((address_space(3))) const char* lds_cptr;
typedef short v4i16_t __attribute__((ext_vector_type(4)));
#define LDSV(T,p) (*(const __attribute__((address_space(3))) T*)(p))
__device__ __forceinline__ void kload8(bf16x8*kf,lds_cptr kp){
  kf[0]=LDSV(bf16x8,kp);      kf[1]=LDSV(bf16x8,kp+512);
  kf[2]=LDSV(bf16x8,kp+2048); kf[3]=LDSV(bf16x8,kp+2560);
  kf[4]=LDSV(bf16x8,kp+4096); kf[5]=LDSV(bf16x8,kp+4608);
  kf[6]=LDSV(bf16x8,kp+6144); kf[7]=LDSV(bf16x8,kp+6656);
}
__device__ __forceinline__ void kload2(bf16x8*kf,lds_cptr kp,int j){ kf[2*j]=LDSV(bf16x8,kp+j*2048); kf[2*j+1]=LDSV(bf16x8,kp+j*2048+512); }
__device__ __forceinline__ s16x4 vtr(lds_cptr p){ return __builtin_bit_cast(s16x4,__builtin_amdgcn_ds_read_tr16_b64_v4i16((__attribute__((address_space(3))) v4i16_t*)p)); }
#define MX3(a,b,c) __builtin_fmaxf(__builtin_fmaxf((a),(b)),(c))
__device__ __forceinline__ float rowmax(const f32x16&p0,const f32x16&p1){
  float a=MX3(p0[0],p0[1],p1[0]),b=MX3(p0[2],p0[3],p1[1]);a=MX3(a,p1[2],p1[3]);
  #pragma unroll
  for(int r=4;r<16;r+=4){a=MX3(a,p0[r],p0[r+1]);b=MX3(b,p0[r+2],p0[r+3]);a=MX3(a,p1[r],p1[r+1]);b=MX3(b,p1[r+2],p1[r+3]);}
  float m=__builtin_fmaxf(a,b);
  auto rr=__builtin_amdgcn_permlane32_swap(__float_as_uint(m),__float_as_uint(m),false,false);
  return __builtin_fmaxf(__uint_as_float(rr[0]),__uint_as_float(rr[1]));
}
__device__ __forceinline__ void pv(f32x16*o,int vb,bf16x8 pa0,bf16x8 pa1,bf16x8 pa2,bf16x8 pa3){
  #pragma unroll
  for(int d0=0;d0<2;++d0){s16x4 lo[4],hi[4];
    #pragma unroll
    for(int ks=0;ks<4;++ks){
      asm volatile("ds_read_b64_tr_b16 %0,%1 offset:%c2":"=&v"(lo[ks]):"v"(vb),"i"(d0*4096+ks*1024):"memory");
      asm volatile("ds_read_b64_tr_b16 %0,%1 offset:%c2":"=&v"(hi[ks]):"v"(vb),"i"(d0*4096+ks*1024+512):"memory");}
    asm volatile("s_waitcnt lgkmcnt(0)":::"memory");SBAR();
    #define PK(k) (bf16x8){lo[k][0],lo[k][1],lo[k][2],lo[k][3],hi[k][0],hi[k][1],hi[k][2],hi[k][3]}
    o[d0]=__builtin_amdgcn_mfma_f32_32x32x16_bf16(pa0,PK(0),o[d0],0,0,0);
    o[d0]=__builtin_amdgcn_mfma_f32_32x32x16_bf16(pa1,PK(1),o[d0],0,0,0);
    o[d0]=__builtin_amdgcn_mfma_f32_32x32x16_bf16(pa2,PK(2),o[d0],0,0,0);
    o[d0]=__builtin_amdgcn_mfma_f32_32x32x16_bf16(pa3,PK(3),o[d0],0,0,0);
    #undef PK
  }
}
struct AUnit {
  const bf16* Q;
  const bf16* K;
  const bf16* V;
  const float* nbk;
  bf16* O;
  const bf16* G;
  int kp;
  int NT, qoff, nvalid;
};
#define FLOORZ_LDS_OFF (131072+1040)
template<int THRL> __device__ __forceinline__ void attn_unit(const AUnit&U,char*shm,int wave0){
  int l__; asm volatile("v_mbcnt_lo_u32_b32 %0, -1, 0\n\tv_mbcnt_hi_u32_b32 %0, -1, %0":"=v"(l__)); int tid_=wave0*64+l__; const int tid=tid_,lane=tid&63,r32=lane&31,hi=lane>>5; const int wid=__builtin_amdgcn_readfirstlane(tid>>6);
  const int KP=U.kp;
  const bf16*Qw=U.Q+(long)(wid*QBLK)*QP;
  const bf16*Kh=U.K,*Vh=U.V;
  const unsigned lds0=(unsigned)(uintptr_t)shm;
  float*wsf=(float*)(shm+LDS_WS)+wid*64;
  const bf16*ksrc=Kh+(long)lane*KP+wid*8;
  const bf16*vsrc=Vh+(long)(16*(wid&3)+(lane>>2))*KP+(wid>>2)*32+(lane&3)*8;
  const float*bsrc=U.nbk+lane;
  const unsigned kdst=lds0+LDS_K+wid*1024, vdst=lds0+LDS_V+wid*1024, bdst=lds0+LDS_BIAS+wid*(NSLOT*256);
  #define DMA_K(t,slot) do{ glds16(ksrc+(long)(t)*KVBLK*KP,(unsigned)__builtin_amdgcn_readfirstlane(kdst+(slot))); glds4(bsrc+(t)*KVBLK,(unsigned)__builtin_amdgcn_readfirstlane(bdst+((slot)>>5))); }while(0)
  #define DMA_V(t,slot) glds16(vsrc+(long)(t)*KVBLK*KP,(unsigned)__builtin_amdgcn_readfirstlane(vdst+(slot)))
  bf16x8 kf[8];
  const lds_cptr shm3=(lds_cptr)shm; const lds_cptr kp0=shm3+LDS_K+hi*1024+r32*16; const lds_cptr vp0=shm3+LDS_V+((lane>>4)&1)*32+(lane&3)*8+(4*hi+((lane&15)>>2))*64;
  const lds_cptr bp0=shm3+LDS_BIAS+wid*(NSLOT*256)+hi*16;
  const int NT=U.NT;
  DMA_K(0,0);DMA_V(0,0);DMA_K(1,SLOTB);
  bf16x8 qr[4];
  #pragma unroll
  for(int d0=0;d0<4;++d0)qr[d0]=*reinterpret_cast<const bf16x8*>(&Qw[(long)r32*QP+d0*16+hi*8]);
  const int qrel=wid*QBLK+r32;
  const float bq=-U.nbk[U.qoff+qrel];
  float nm=0.f,l_reg=0.f;f32x16 o[2];o[0]=f32x16{};o[1]=f32x16{};
  const int qoff=U.qoff;
  #define CMASK(P0,P1,t) do{ if((t)>=NT-4)cmask(P0,P1,64*(t)-qoff,qrel,hi);}while(0)
  #define BLD1(P0,P1,bp,g) do{ const f32x4a a_=LDSV(f32x4a,(bp)+(g)*32); const f32x4a b_=LDSV(f32x4a,(bp)+128+(g)*32); \
      P0[4*(g)]=a_[0];P0[4*(g)+1]=a_[1];P0[4*(g)+2]=a_[2];P0[4*(g)+3]=a_[3]; P1[4*(g)]=b_[0];P1[4*(g)+1]=b_[1];P1[4*(g)+2]=b_[2];P1[4*(g)+3]=b_[3]; }while(0)
  bool resc=false;
  #define RESC() do{ if(resc){ asm volatile("s_waitcnt lgkmcnt(0)":::"memory"); \
      _Pragma("unroll") for(int d_=0;d_<2;++d_) _Pragma("unroll") for(int r=0;r<16;++r)o[d_][r]*=wsf[crow(r,hi)]; } }while(0)
  f32x16 pA0,pA1,pB0,pB1;
  int sl_prev=0,sl_cur=0,sl_next=SLOTB;
  #define ROT() do{sl_prev=sl_cur;sl_cur=sl_next;sl_next=(sl_next==(NSLOT-1)*SLOTB)?0:sl_next+SLOTB;}while(0)
  DMA_K(2,2*SLOTB);
  WAIT_BAR(2);
  { BLD1(pA0,pA1,bp0,0);BLD1(pA0,pA1,bp0,1);BLD1(pA0,pA1,bp0,2);BLD1(pA0,pA1,bp0,3);
    #pragma unroll
    for(int d0=0;d0<4;++d0){
      const bf16x8 b0=LDSV(bf16x8,kp0+d0*2048);
      const bf16x8 b1=LDSV(bf16x8,kp0+d0*2048+512);
      pA0=__builtin_amdgcn_mfma_f32_32x32x16_bf16(b0,qr[d0],pA0,0,0,0);pA1=__builtin_amdgcn_mfma_f32_32x32x16_bf16(b1,qr[d0],pA1,0,0,0);}
  }
  CMASK(pA0,pA1,0);
  { const float rm=rowmax(pA0,pA1); const float z=rm+bq; const float mh=__builtin_fmaxf(z,*(const float*)(shm+FLOORZ_LDS_OFF)); nm=bq-mh;
    _Pragma("unroll") for(int r=0;r<16;++r){pA0[r]=__builtin_amdgcn_exp2f(pA0[r]+nm);pA1[r]=__builtin_amdgcn_exp2f(pA1[r]+nm);} }
  WAIT_BAR(0);
  DMA_K(3,0);DMA_V(1,SLOTB);
  ROT();
  kload8(kf,kp0+sl_cur);
  { const lds_cptr bp_=bp0+(sl_cur>>5); BLD1(pB0,pB1,bp_,0);BLD1(pB0,pB1,bp_,1);BLD1(pB0,pB1,bp_,2);BLD1(pB0,pB1,bp_,3); }
  WAIT_BAR(3);
  s16x4 vlo[8],vhi[8]; u32x4 pw0,pw1,pw2,pw3;
  #define PKW(P,B) cvtpk_s(P[B],P[B+1])
  #define PAF(k) __builtin_bit_cast(bf16x8,pw##k)
  #define VFR(i) (bf16x8){vlo[i][0],vlo[i][1],vlo[i][2],vlo[i][3],vhi[i][0],vhi[i][1],vhi[i][2],vhi[i][3]}
  #define PIN(x) asm volatile("":"+v"(x))
  #define GAPA(MF,A0,A1,A2,A3,W0,W1,PW) do{ MF; sacc+=A0; sacc+=A1; sacc+=A2; sacc+=A3; PIN(sacc); W0; W1; PIN(PW); SBAR(); }while(0)
  #define EX(v) __builtin_amdgcn_exp2f((v)+nm)
  #define GAPB(MF,X,B) do{ MF; X[B]=EX(X[B]); X[B+1]=EX(X[B+1]); X[B+2]=EX(X[B+2]); X[B+3]=EX(X[B+3]); PIN(X); SBAR(); }while(0)
  #define VRD(i) do{ vlo[i]=vtr(vp_+(((i)>>2)*4096+((i)&3)*1024)); vhi[i]=vtr(vp_+(((i)>>2)*4096+((i)&3)*1024+512)); }while(0)
  #define KRD(G,j) do{ if(G){ kload2(kf,kp0+sl_next,j); SBAR(); } }while(0)
  #define BRD(G,P0,P1,g) do{ if(G){ BLD1(P0,P1,bpn_,g); SBAR(); } }while(0)
  #define STEP(C0,C1,P0,P1,t,GK,GV,GL) do{ SBAR(); \
    const lds_cptr vp_=vp0+sl_prev; const lds_cptr bpn_=bp0+(sl_next>>5); \
    VRD(0); SBAR(); float sacc=(P0[0]+P0[1]); \
    GAPA(C0=__builtin_amdgcn_mfma_f32_32x32x16_bf16(kf[0],qr[0],C0,0,0,0), P0[2],P0[3],P0[4],P0[5],     pw0[0]=PKW(P0,0), pw0[1]=PKW(P0,2), pw0); \
    VRD(4); SBAR(); GAPA(C1=__builtin_amdgcn_mfma_f32_32x32x16_bf16(kf[1],qr[0],C1,0,0,0), P0[6],P0[7],P0[8],P0[9],     pw0[2]=PKW(P0,4), pw0[3]=PKW(P0,6), pw0); \
    VRD(1); SBAR(); GAPA(C0=__builtin_amdgcn_mfma_f32_32x32x16_bf16(kf[2],qr[1],C0,0,0,0),   P0[10],P0[11],P0[12],P0[13], pw1[0]=PKW(P0,8), pw1[1]=PKW(P0,10), pw1); \
    VRD(5); SBAR(); GAPA(C1=__builtin_amdgcn_mfma_f32_32x32x16_bf16(kf[3],qr[1],C1,0,0,0),   P0[14],P0[15],P1[0],P1[1],   pw1[2]=PKW(P0,12),pw1[3]=PKW(P0,14), pw1); \
    VRD(2); SBAR(); GAPA(C0=__builtin_amdgcn_mfma_f32_32x32x16_bf16(kf[4],qr[2],C0,0,0,0),   P1[2],P1[3],P1[4],P1[5],     pw2[0]=PKW(P1,0), pw2[1]=PKW(P1,2), pw2); \
    VRD(6); SBAR(); GAPA(C1=__builtin_amdgcn_mfma_f32_32x32x16_bf16(kf[5],qr[2],C1,0,0,0),   P1[6],P1[7],P1[8],P1[9],     pw2[2]=PKW(P1,4), pw2[3]=PKW(P1,6), pw2); \
    VRD(3); SBAR(); GAPA(C0=__builtin_amdgcn_mfma_f32_32x32x16_bf16(kf[6],qr[3],C0,0,0,0),   P1[10],P1[11],P1[12],P1[13], pw3[0]=PKW(P1,8), pw3[1]=PKW(P1,10), pw3); \
    VRD(7); SBAR(); GAPA(C1=__builtin_amdgcn_mfma_f32_32x32x16_bf16(kf[7],qr[3],C1,0,0,0),   P1[14],P1[15],0.f,0.f,       pw3[2]=PKW(P1,12),pw3[3]=PKW(P1,14), pw3); \
    l_reg+=sacc; \
    if(GK){DMA_K((t)+3,sl_cur);} if(GV){DMA_V((t)+1,sl_next);} \
    CMASK(C0,C1,t); \
    { float a=MX3(C0[0],C0[1],C1[0]),b=MX3(C0[2],C0[3],C1[1]); a=MX3(a,C1[2],C1[3]); \
      _Pragma("unroll") for(int r=4;r<16;r+=4){a=MX3(a,C0[r],C0[r+1]);b=MX3(b,C0[r+2],C0[r+3]);a=MX3(a,C1[r],C1[r+1]);b=MX3(b,C1[r+2],C1[r+3]);} \
      float rm=__builtin_fmaxf(a,b); { auto rr=__builtin_amdgcn_permlane32_swap(__float_as_uint(rm),__float_as_uint(rm),false,false); rm=__builtin_fmaxf(__uint_as_float(rr[0]),__uint_as_float(rr[1])); } \
      rm+=nm; resc=false; \
      if(__builtin_expect(__any(rm>(float)THRL),0)){ const float dl=__builtin_fmaxf(rm,0.f); nm-=dl; \
        const float f=__builtin_amdgcn_exp2f(-dl); l_reg*=f; { int l2_; asm volatile("v_mbcnt_lo_u32_b32 %0, -1, 0\n\tv_mbcnt_hi_u32_b32 %0, -1, %0":"=v"(l2_)); if(l2_<32)((float*)(shm+LDS_WS))[wid*64+l2_]=f; } resc=true; } } \
    SBAR(); \
    BRD(GL,P0,P1,0); GAPB(o[0]=__builtin_amdgcn_mfma_f32_32x32x16_bf16(PAF(0),VFR(0),o[0],0,0,0), C0,0); \
    BRD(GL,P0,P1,1); GAPB(o[1]=__builtin_amdgcn_mfma_f32_32x32x16_bf16(PAF(0),VFR(4),o[1],0,0,0), C0,4); \
    KRD(GL,0); GAPB(o[0]=__builtin_amdgcn_mfma_f32_32x32x16_bf16(PAF(1),VFR(1),o[0],0,0,0), C0,8); \
    KRD(GL,1); GAPB(o[1]=__builtin_amdgcn_mfma_f32_32x32x16_bf16(PAF(1),VFR(5),o[1],0,0,0), C0,12); \
    KRD(GL,2); GAPB(o[0]=__builtin_amdgcn_mfma_f32_32x32x16_bf16(PAF(2),VFR(2),o[0],0,0,0), C1,0); \
    KRD(GL,3); GAPB(o[1]=__builtin_amdgcn_mfma_f32_32x32x16_bf16(PAF(2),VFR(6),o[1],0,0,0), C1,4); \
    BRD(GL,P0,P1,2); GAPB(o[0]=__builtin_amdgcn_mfma_f32_32x32x16_bf16(PAF(3),VFR(3),o[0],0,0,0), C1,8); \
    BRD(GL,P0,P1,3); GAPB(o[1]=__builtin_amdgcn_mfma_f32_32x32x16_bf16(PAF(3),VFR(7),o[1],0,0,0), C1,12); \
    }while(0)
  int t=1;
  #undef CMASK
  #define CMASK(P0,P1,t) do{}while(0)
  for(;t+5<NT;t+=2){
    STEP(pB0,pB1,pA0,pA1,t,true,true,true);     WAIT_BAR(3); RESC(); ROT();
    STEP(pA0,pA1,pB0,pB1,t+1,true,true,true);   WAIT_BAR(3); RESC(); ROT();
  }
  #undef CMASK
  #define CMASK(P0,P1,t) do{ if((t)>=NT-4)cmask(P0,P1,64*(t)-qoff,qrel,hi);}while(0)
  #define ENDW(tt) do{ if((tt)+3<NT){WAIT_BAR(3);} else if((tt)+2<NT){WAIT_BAR(1);} else {WAIT_BAR(0);} }while(0)
  for(;t+1<NT;t+=2){
    STEP(pB0,pB1,pA0,pA1,t,(t+3<NT),(t+1<NT),(t+1<NT));       ENDW(t);   RESC(); ROT();
    STEP(pA0,pA1,pB0,pB1,t+1,(t+4<NT),(t+2<NT),(t+2<NT));     ENDW(t+1); RESC(); ROT();
  }
  STEP(pB0,pB1,pA0,pA1,NT-1,false,false,false); RESC();
  { float sacc=pB0[0]+pB0[1]; _Pragma("unroll") for(int r=2;r<16;++r)sacc+=pB0[r]; _Pragma("unroll") for(int r=0;r<16;++r)sacc+=pB1[r]; l_reg+=sacc;
    pw0=(u32x4){PKW(pB0,0),PKW(pB0,2),PKW(pB0,4),PKW(pB0,6)};pw1=(u32x4){PKW(pB0,8),PKW(pB0,10),PKW(pB0,12),PKW(pB0,14)};pw2=(u32x4){PKW(pB1,0),PKW(pB1,2),PKW(pB1,4),PKW(pB1,6)};pw3=(u32x4){PKW(pB1,8),PKW(pB1,10),PKW(pB1,12),PKW(pB1,14)};
    SBAR(); pv(o,(int)(unsigned)(uintptr_t)vp0+sl_cur,PAF(0),PAF(1),PAF(2),PAF(3)); }
  #undef PKW
  #undef PAF
  #undef VFR
  #undef PIN
  #undef GAPA
  #undef GAPB
  #undef EX
  #undef VRD
  #undef KRD
  #undef BRD
  #undef STEP
  #undef ENDW
  const bf16*Gw=U.G+(long)(wid*QBLK)*GP; u32x4 gvv[4];
  #pragma unroll
  for(int i=0;i<4;++i){const int row=i*8+(lane>>3),ch=lane&7; gvv[i]=(wid*QBLK+row<U.nvalid)?*(const u32x4*)(Gw+(long)row*GP+ch*8):(u32x4){0u,0u,0u,0u};}
  __builtin_amdgcn_sched_barrier(0);
  {auto rr=__builtin_amdgcn_permlane32_swap(__float_as_uint(l_reg),__float_as_uint(l_reg),false,false);l_reg=__uint_as_float(rr[0])+__uint_as_float(rr[1]);}
  if(hi==0)wsf[32+r32]=l_reg;asm volatile("s_waitcnt lgkmcnt(0)":::"memory");
  float rli[16];
  #pragma unroll
  for(int r=0;r<16;++r)rli[r]=__builtin_amdgcn_rcpf(wsf[32+crow(r,hi)]);
  bf16*Ow=U.O+(long)(wid*QBLK)*OP;
  { bf16*stg=(bf16*)(shm+LDS_OST)+wid*2048;
    #pragma unroll
    for(int r=0;r<16;++r){const int orow=crow(r,hi);
      #pragma unroll
      for(int d0=0;d0<2;++d0)stg[orow*64+d0*32+r32]=__float2bfloat16(o[d0][r]*rli[r]);}
    asm volatile("s_waitcnt lgkmcnt(0)":::"memory");
    #pragma unroll
    for(int i=0;i<4;++i){const int row=i*8+(lane>>3),ch=lane&7; const u32x4 v=*(const u32x4*)(stg+row*64+ch*8);
      if(wid*QBLK+row<U.nvalid){
        const u32x4 gv=gvv[i]; u32x4 ov;
        #pragma unroll
        for(int e=0;e<4;++e){
          const float o0=__uint_as_float(v[e]<<16), o1=__uint_as_float(v[e]&0xffff0000u);
          const float g0=__uint_as_float(gv[e]<<16), g1=__uint_as_float(gv[e]&0xffff0000u);
          const float s0=g0*__builtin_amdgcn_rcpf(1.f+__expf(-g0)), s1=g1*__builtin_amdgcn_rcpf(1.f+__expf(-g1));
          ov[e]=cvtpk_s(o0*s0,o1*s1); }
        *(u32x4*)(Ow+(long)row*OP+ch*8)=ov; } } }
  asm volatile("s_waitcnt lgkmcnt(0)\n\ts_barrier":::"memory");
  #undef DMA_K
  #undef DMA_V
  #undef CMASK
  #undef RESC
  #undef ROT
  #undef BLD1
}
__device__ __forceinline__ void attn_unit_helper(const AUnit&U,char*shm,int wave0){
  int l__; asm volatile("v_mbcnt_lo_u32_b32 %0, -1, 0\n\tv_mbcnt_hi_u32_b32 %0, -1, %0":"=v"(l__)); const int tid=wave0*64+l__,lane=tid&63; const int wid=__builtin_amdgcn_readfirstlane(tid>>6);
  const int KP=U.kp;
  const unsigned lds0=(unsigned)(uintptr_t)shm;
  const bf16*ksrc=U.K+(long)lane*KP+wid*8;
  const bf16*vsrc=U.V+(long)(16*(wid&3)+(lane>>2))*KP+(wid>>2)*32+(lane&3)*8;
  const float*bsrc=U.nbk+lane;
  const unsigned kdst=lds0+LDS_K+wid*1024, vdst=lds0+LDS_V+wid*1024, bdst=lds0+LDS_BIAS+wid*(NSLOT*256);
  #define DMA_K(t,slot) do{ glds16(ksrc+(long)(t)*KVBLK*KP,(unsigned)__builtin_amdgcn_readfirstlane(kdst+(slot))); glds4(bsrc+(t)*KVBLK,(unsigned)__builtin_amdgcn_readfirstlane(bdst+((slot)>>5))); }while(0)
  #define DMA_V(t,slot) glds16(vsrc+(long)(t)*KVBLK*KP,(unsigned)__builtin_amdgcn_readfirstlane(vdst+(slot)))
  const int NT=U.NT;
  int sl_cur=0,sl_next=SLOTB;
  #define ROT() do{sl_cur=sl_next;sl_next=(sl_next==(NSLOT-1)*SLOTB)?0:sl_next+SLOTB;}while(0)
  DMA_K(0,0);DMA_V(0,0);DMA_K(1,SLOTB);DMA_K(2,2*SLOTB);
  WAIT_BAR(2);
  WAIT_BAR(0);
  DMA_K(3,0);DMA_V(1,SLOTB);
  ROT();
  WAIT_BAR(3);
  for(int t=1;t<NT-1;++t){
    if(t+3<NT){DMA_K(t+3,sl_cur);} if(t+1<NT){DMA_V(t+1,sl_next);}
    if(t+3<NT){WAIT_BAR(3);} else if(t+2<NT){WAIT_BAR(1);} else {WAIT_BAR(0);}
    ROT();
  }
  asm volatile("s_waitcnt lgkmcnt(0)\n\ts_barrier":::"memory");
  #undef DMA_K
  #undef DMA_V
  #undef ROT
}
constexpr int ATTN_LDS_BYTES=LDS_BYTES;
#undef SBAR
#undef WAIT_BAR
#undef MX3
#undef LDSV
#undef FLOORZ_LDS_OFF
}

namespace cg = cooperative_groups;
#define GAS __attribute__((address_space(1)))
#define LAS __attribute__((address_space(3)))
typedef unsigned short bf16;
typedef unsigned v4u __attribute__((ext_vector_type(4)));
typedef unsigned v2u __attribute__((ext_vector_type(2)));
typedef float f32x4 __attribute__((ext_vector_type(4)));
typedef short bf16x8 __attribute__((ext_vector_type(8)));
constexpr int NWAVES = 8;
#define SCHED_FENCE() __builtin_amdgcn_sched_barrier(0)

constexpr int DM = 1024, NB = 16, SEQ = 4096, NL = 2, SB = 8, ST = 16, PAST = 2048, NH = 8, HD = 64;
constexpr int MP = NB * SEQ;
constexpr int MS = SB * ST;
constexpr int MV = MP + MS;
constexpr int MPAD = 257 * 256;
constexpr int INC = 3592;
constexpr int PP = 3584;
constexpr int C_PU = 0, C_PG = 256, C_Q = 512, C_K = 1024, C_V = 1536, C_AG = 2048, C_CB = 2560, C_CC = 2816, C_CX = 3072, C_CG = 3328;
constexpr int KSROWS = 2176;
constexpr int NBKS = 2432;
constexpr float EPS = 1e-6f;
constexpr float LOG2E = 1.4426950408889634f;

constexpr size_t O_YP = 0;
constexpr size_t O_YS = O_YP + (size_t)MP * DM;
constexpr size_t O_KP = O_YS + (size_t)MS * DM;
constexpr size_t O_VP = O_KP + (size_t)NL * MP * 512;
constexpr size_t O_FP = O_VP + (size_t)NL * MP * 512;
constexpr size_t O_PP = O_FP + (size_t)NL * MP * 8;
constexpr size_t O_CP = O_PP + (size_t)NL * NB * 15 * 256;
constexpr size_t O_KS = O_CP + (size_t)NL * NB * 2 * 256;
constexpr size_t O_VS = O_KS + (size_t)NL * MS * 512;
constexpr size_t O_FS = O_VS + (size_t)NL * MS * 512;
constexpr size_t O_PS = O_FS + (size_t)NL * MS * 8;
constexpr size_t O_CS = O_PS + (size_t)NL * SB * 15 * 256;
constexpr size_t O_END = O_CS + (size_t)NL * SB * 2 * 256;

constexpr size_t MiB = 1u << 20;
constexpr size_t WS_WIN = 0;
constexpr size_t WS_WOUT = 16 * MiB;
constexpr size_t WS_PWT = 20 * MiB;
constexpr size_t WS_NBKP = 21 * MiB;
constexpr size_t WS_NBKS = 23 * MiB;
constexpr size_t WS_BAR = 23 * MiB + 768 * 1024;
constexpr size_t WS_KS = 24 * MiB;
constexpr size_t WS_VS = 60 * MiB;
constexpr size_t WS_XN = 96 * MiB;
constexpr size_t WS_PROJ = 226 * MiB;
constexpr size_t WS_X1B = WS_PROJ + (size_t)(MPAD + 512) * PP * 2;
constexpr size_t WS_END = WS_X1B + (size_t)MP * DM * 2;
static_assert(WS_KS + (size_t)NL * SB * KSROWS * 512 * 2 <= WS_VS && WS_VS + (size_t)NL * SB * KSROWS * 512 * 2 <= WS_XN && WS_XN + (size_t)(MPAD + 256) * DM * 2 <= WS_PROJ, "ws map");

constexpr int REP_CONV = 1, REP_POOL = 1; constexpr int REP_P0 = 1, REP_PA = 1, REP_GIN = 1, REP_MIX = 1, REP_ATTN = 1, REP_GOUT0 = 1;
constexpr int STAGGER_TICKS = 1600;
constexpr int RING_BYTES = 131072;
constexpr int LDS_BYTES = 147456;

__device__ __forceinline__ unsigned f2bf(float f) { unsigned u = __builtin_bit_cast(unsigned, f); return (u + 0x7fffu + ((u >> 16) & 1u)) >> 16; }
__device__ __forceinline__ unsigned pk2(float lo, float hi) { return attn_body::cvtpk_s(lo, hi); }
__device__ __forceinline__ float bflo(unsigned w) { return __uint_as_float(w << 16); }
__device__ __forceinline__ float bfhi(unsigned w) { return __uint_as_float(w & 0xffff0000u); }
__device__ __forceinline__ void stagger_wait(int steps) { const unsigned long long t0 = __builtin_amdgcn_s_memrealtime(); const unsigned long long d = (unsigned long long)steps * STAGGER_TICKS; while (__builtin_amdgcn_s_memrealtime() - t0 < d) __builtin_amdgcn_s_sleep(16); }
__device__ __forceinline__ float silu_f(float x) { return x * __builtin_amdgcn_rcpf(1.f + __expf(-x)); }
__device__ __forceinline__ float shx(float v, int m, int lane) { return __int_as_float(__builtin_amdgcn_ds_bpermute((lane ^ m) << 2, __float_as_int(v))); }
__device__ __forceinline__ float wave_sum(float v, int lane) {
#pragma unroll
    for (int o = 1; o < 64; o <<= 1) v += shx(v, o, lane);
    return v;
}

struct Args {
    const float* in[16]; float* out; unsigned char* ws; int ph_lo, ph_hi;
};

struct Str { int s, cs, GS, cg, rowP0, rowsP, sb0, SBs; };
struct Frame {
    LAS unsigned char* lds;
    int tid, lane, wave, vcu, G, wave0;
};
#define FRAME_REFRESH(F) do { int l_; asm volatile("v_mbcnt_lo_u32_b32 %0, -1, 0\n\tv_mbcnt_hi_u32_b32 %0, -1, %0" : "=v"(l_)); int t_ = (F).wave0 * 64 + l_; (F).tid = t_; (F).lane = t_ & 63; (F).wave = __builtin_amdgcn_readfirstlane(t_ >> 6); } while (0)

__host__ __device__ __forceinline__ int win_logical_col(int p) {
    if (p < 512) return p;
    if (p < 1536) { const int reg = (p - 512) >> 8, q = (p - 512) & 255; return 512 + reg * 256 + 64 * ((q >> 5) & 3) + 32 * (q >> 7) + (q & 31); }
    if (p < 2560) return p;
    return p + 8;
}

__device__ __forceinline__ void transpose_item(const float* W, int K, int Nsrc, int srccol0, bf16* WT, int n0, int k0, LAS float* scr, int lane) {
    float tv[32];
#pragma unroll
    for (int i = 0; i < 32; ++i) { const int kk = 2 * i + (lane >> 5); tv[i] = W[(size_t)(k0 + kk) * Nsrc + srccol0 + (lane & 31)]; }
    SCHED_FENCE();
#pragma unroll
    for (int i = 0; i < 32; ++i) { const int kk = 2 * i + (lane >> 5); scr[kk * 33 + (lane & 31)] = tv[i]; }
    asm volatile("s_waitcnt lgkmcnt(0)" ::: "memory");
    const int c = lane & 7;
#pragma unroll
    for (int j = 0; j < 4; ++j) { const int n = (lane >> 3) + 8 * j; const LAS float* s = scr + (8 * c) * 33 + n;
        v4u o; o.x = pk2(s[0 * 33], s[1 * 33]); o.y = pk2(s[2 * 33], s[3 * 33]); o.z = pk2(s[4 * 33], s[5 * 33]); o.w = pk2(s[6 * 33], s[7 * 33]);
        *(v4u*)(WT + (size_t)(n0 + n) * K + k0 + 8 * c) = o; }
    asm volatile("s_waitcnt lgkmcnt(0)" ::: "memory");
}

__device__ __forceinline__ void p0_prologue(Frame& F, const Args& a) {
    LAS float* scr = (LAS float*)(F.lds + F.wave * 16384);
    const int gw = F.vcu * NWAVES + F.wave, NGW = F.G * NWAVES;
    unsigned char* ws = a.ws;
    constexpr int I_IN = (DM / 64) * (PP / 32), I_OUT = (DM / 64) * (DM / 32);
    for (int it = gw; it < NL * (I_IN + I_OUT); it += NGW) {
        const int l = it / (I_IN + I_OUT); int r = it % (I_IN + I_OUT);
        if (r < I_IN) { const int kb = r / (PP / 32), nb = r % (PP / 32);
            transpose_item(a.in[8] + (size_t)l * DM * INC, DM, INC, win_logical_col(32 * nb), (bf16*)(ws + WS_WIN) + (size_t)l * PP * DM, 32 * nb, 64 * kb, scr, F.lane); }
        else { r -= I_IN; const int kb = r / (DM / 32), nb = r % (DM / 32);
            transpose_item(a.in[15] + (size_t)l * DM * DM, DM, DM, 32 * nb, (bf16*)(ws + WS_WOUT) + (size_t)l * DM * DM, 32 * nb, 64 * kb, scr, F.lane); }
    }
    { const int gt = F.vcu * 512 + F.tid, NT_ = F.G * 512; bf16* pwt = (bf16*)(ws + WS_PWT);
      for (int i = gt; i < NL * 4 * 64 * 64; i += NT_) { const int c = i & 63, d = (i >> 6) & 63, lg = i >> 12; pwt[i] = (bf16)f2bf(a.in[12][(size_t)lg * 4096 + c * 64 + d]); } }
    { const size_t gt = (size_t)F.vcu * 512 + F.tid, NT_ = (size_t)F.G * 512;
      const size_t nchunk = (size_t)NL * SB * PAST * 64;
      for (size_t i0 = gt; i0 < 2 * nchunk; i0 += 4 * NT_) {
          f32x4 x0[4], x1[4];
#pragma unroll
          for (int q = 0; q < 4; ++q) { const size_t i = i0 + q * NT_; if (i < 2 * nchunk) { const int which = i >= nchunk; const size_t j = which ? i - nchunk : i;
              const float* src = a.in[2 + which] + (j >> 6) * 512 + (int)(j & 63) * 8; x0[q] = *(const f32x4*)src; x1[q] = *(const f32x4*)(src + 4); } }
          SCHED_FENCE();
#pragma unroll
          for (int q = 0; q < 4; ++q) { const size_t i = i0 + q * NT_; if (i < 2 * nchunk) { const int which = i >= nchunk; const size_t j = which ? i - nchunk : i;
              const size_t rowg = j >> 6; const int c8 = (int)(j & 63) * 8; const size_t lb = rowg / PAST; const int r = (int)(rowg % PAST);
              v4u o; o.x = pk2(x0[q][0], x0[q][1]); o.y = pk2(x0[q][2], x0[q][3]); o.z = pk2(x1[q][0], x1[q][1]); o.w = pk2(x1[q][2], x1[q][3]);
              *(v4u*)((bf16*)(ws + (which ? WS_VS : WS_KS)) + (lb * KSROWS + r) * 512 + c8) = o; } }
          SCHED_FENCE(); }
      const size_t nz = (size_t)NL * SB * (KSROWS - PAST - ST) * 64;
      for (size_t i = gt; i < 2 * nz; i += NT_) {
          const int which = i >= nz; const size_t j = which ? i - nz : i;
          const size_t rowg = j >> 6; const int c8 = (int)(j & 63) * 8; const size_t lb = rowg / (KSROWS - PAST - ST); const int r = (int)(rowg % (KSROWS - PAST - ST)) + PAST + ST;
          bf16* dst = (bf16*)(ws + (which ? WS_VS : WS_KS)) + (lb * KSROWS + r) * 512 + c8;
          *(v4u*)dst = (v4u){0u, 0u, 0u, 0u}; } }
    { const int gt = F.vcu * 512 + F.tid, NT_ = F.G * 512; v4u* p = (v4u*)((bf16*)(ws + WS_XN) + (size_t)MV * DM);
      for (int i = gt; i < (MPAD - MV) * DM / 8; i += NT_) p[i] = (v4u){0u, 0u, 0u, 0u}; }
}

__device__ __forceinline__ void pa_phase(Frame& F, const Args& a, int l, const float* xp, const float* xs, const Str& T, const bf16* xpb = nullptr) {
    LAS float* wg = (LAS float*)F.lds;
    __syncthreads();
    const float* ng = a.in[7] + (size_t)l * DM;
    { const float* wf = a.in[8] + (size_t)l * DM * INC + 2560;
      for (int k = F.tid; k < DM; k += 512) { const f32x4 w0 = *(const f32x4*)(wf + (size_t)k * INC), w1 = *(const f32x4*)(wf + (size_t)k * INC + 4); const float g = ng[k];
          wg[0 * 1024 + k] = w0[0] * g; wg[1 * 1024 + k] = w0[1] * g; wg[2 * 1024 + k] = w0[2] * g; wg[3 * 1024 + k] = w0[3] * g;
          wg[4 * 1024 + k] = w1[0] * g; wg[5 * 1024 + k] = w1[1] * g; wg[6 * 1024 + k] = w1[2] * g; wg[7 * 1024 + k] = w1[3] * g; } }
    __syncthreads();
    const int lane = F.lane;
    f32x4 gv[4];
#pragma unroll
    for (int j = 0; j < 4; ++j) gv[j] = *(const f32x4*)(ng + 4 * lane + 256 * j);
    const float* bfp = a.in[9] + l * 8;
    bf16* XN = (bf16*)(a.ws + WS_XN);
    float* outfp = a.out + O_FP + (size_t)l * MP * 8; float* outfs = a.out + O_FS + (size_t)l * MS * 8;
    const int gw = T.cs * NWAVES + F.wave, NGW = T.GS * NWAVES;
    for (int rg = gw; rg < (T.rowsP + T.SBs * ST) / 4; rg += NGW) {
        const int row0 = rg < T.rowsP / 4 ? T.rowP0 + rg * 4 : MP + T.sb0 * ST + (rg - T.rowsP / 4) * 4;
        const float* src = row0 < MP ? xp + (size_t)row0 * DM : xs + (size_t)(row0 - MP) * DM;
        f32x4 v[4][4]; float rstd[4];
        if (xpb != nullptr && row0 < MP) {
            const bf16* sb = xpb + (size_t)row0 * DM;
#pragma unroll
            for (int r = 0; r < 4; ++r)
#pragma unroll
                for (int j = 0; j < 4; ++j) { const v2u p = *(const v2u*)(sb + (size_t)r * DM + 4 * lane + 256 * j); v[r][j] = (f32x4){bflo(p.x), bfhi(p.x), bflo(p.y), bfhi(p.y)}; }
        } else {
#pragma unroll
            for (int r = 0; r < 4; ++r)
#pragma unroll
                for (int j = 0; j < 4; ++j) v[r][j] = __builtin_nontemporal_load((const f32x4*)(src + (size_t)r * DM + 4 * lane + 256 * j));
        }
#pragma unroll
        for (int r = 0; r < 4; ++r) { float s = 0.f;
#pragma unroll
            for (int j = 0; j < 4; ++j) s += (v[r][j][0] * v[r][j][0] + v[r][j][1] * v[r][j][1]) + (v[r][j][2] * v[r][j][2] + v[r][j][3] * v[r][j][3]);
            rstd[r] = 1.0f / sqrtf(wave_sum(s, lane) * (1.f / DM) + EPS); }
        float acc[32];
#pragma unroll
        for (int i = 0; i < 32; ++i) acc[i] = 0.f;
#pragma unroll
        for (int h = 0; h < 8; ++h) {
#pragma unroll
            for (int j = 0; j < 4; ++j) { const f32x4 w = *(const LAS f32x4*)(wg + h * 1024 + 4 * lane + 256 * j);
#pragma unroll
                for (int r = 0; r < 4; ++r) acc[r * 8 + h] += (v[r][j][0] * w[0] + v[r][j][1] * w[1]) + (v[r][j][2] * w[2] + v[r][j][3] * w[3]); }
            asm volatile("" ::: "memory"); }
#define RS_STAGE(M_, N_) { const bool up = (lane & (M_)) != 0; _Pragma("unroll") for (int i = 0; i < (N_); ++i) { const float send = up ? acc[i] : acc[i + (N_)], keep = up ? acc[i + (N_)] : acc[i]; acc[i] = keep + shx(send, (M_), lane); } }
        RS_STAGE(32, 16) RS_STAGE(16, 8) RS_STAGE(8, 4) RS_STAGE(4, 2) RS_STAGE(2, 1)
#undef RS_STAGE
        acc[0] += shx(acc[0], 1, lane);
        { const int idx = lane >> 1, r = idx >> 3, h = idx & 7;
          const float rs = r == 0 ? rstd[0] : r == 1 ? rstd[1] : r == 2 ? rstd[2] : rstd[3];
          const float xx = acc[0] * rs + bfp[h];
          const float lf = fminf(xx, 0.f) - __logf(1.f + __expf(-fabsf(xx)));
          if ((lane & 1) == 0) { const int row = row0 + r; if (row < MP) outfp[(size_t)row * 8 + h] = lf; else outfs[(size_t)(row - MP) * 8 + h] = lf; } }
#pragma unroll
        for (int r = 0; r < 4; ++r) { unsigned long long* o8 = (unsigned long long*)(XN + (size_t)(row0 + r) * DM) + lane;
#pragma unroll
            for (int j = 0; j < 4; ++j) { const f32x4 y = v[r][j] * rstd[r] * gv[j];
                o8[64 * j] = (unsigned long long)pk2(y[0], y[1]) | ((unsigned long long)pk2(y[2], y[3]) << 32); } }
    }
    __syncthreads();
}

__device__ __forceinline__ void scan_phase(Frame& F, const Args& a, int l, const Str& T) {
    LAS float* sc = (LAS float*)F.lds;
    const float* lfp = a.out + O_FP + (size_t)l * MP * 8; const float* lfs = a.out + O_FS + (size_t)l * MS * 8;
    const float* clf = a.in[4] + (size_t)l * SB * PAST * 8;
    float* nbkp = (float*)(a.ws + WS_NBKP); float* nbks = (float*)(a.ws + WS_NBKS);
    const int nbhp = (T.rowsP / SEQ) * 8, nbhs = T.SBs * 8;
    for (int s = T.cs; s < nbhp + nbhs; s += T.GS) {
        const bool samp = s >= nbhp; const int bh = samp ? T.sb0 * 8 + (s - nbhp) : (T.rowP0 / SEQ) * 8 + s, b = bh >> 3, h = bh & 7;
        const int n = samp ? PAST + ST : SEQ;
        float v[8]; float run = 0.f;
#pragma unroll
        for (int j = 0; j < 8; ++j) { const int t = 8 * F.tid + j; float x = 0.f;
            if (t < n) x = samp ? (t < PAST ? clf[((size_t)b * PAST + t) * 8 + h] : lfs[((size_t)b * ST + (t - PAST)) * 8 + h]) : lfp[((size_t)b * SEQ + t) * 8 + h];
            run += x; v[j] = run; }
        float inc = run;
#pragma unroll
        for (int o = 1; o < 64; o <<= 1) { const int src = F.lane >= o ? F.lane - o : F.lane; const float y = __int_as_float(__builtin_amdgcn_ds_bpermute(src << 2, __float_as_int(inc))); if (F.lane >= o) inc += y; }
        if (F.lane == 63) sc[F.wave] = inc;
        __syncthreads();
        float base = inc - run;
        for (int w = 0; w < F.wave; ++w) base += sc[w];
        float* dst = samp ? nbks + (size_t)bh * NBKS : nbkp + (size_t)bh * SEQ;
        const int t0 = 8 * F.tid;
        if (t0 < n) {
            *(f32x4*)(dst + t0) = (f32x4){-(base + v[0]) * LOG2E, -(base + v[1]) * LOG2E, -(base + v[2]) * LOG2E, -(base + v[3]) * LOG2E};
            *(f32x4*)(dst + t0 + 4) = (f32x4){-(base + v[4]) * LOG2E, -(base + v[5]) * LOG2E, -(base + v[6]) * LOG2E, -(base + v[7]) * LOG2E};
        } else if (samp && t0 < NBKS) {
            *(f32x4*)(dst + t0) = (f32x4){0.f, 0.f, 0.f, 0.f}; *(f32x4*)(dst + t0 + 4) = (f32x4){0.f, 0.f, 0.f, 0.f};
        }
        __syncthreads();
    }
}

template <int W> __device__ __forceinline__ void pool_task(const Args& a, int l, int rt, int g, int lane) {
    const int fr = lane & 15, fq = lane >> 4;
    const bool samp = rt >= MP / 16;
    const int row = rt * 16 + fr;
    const int t = samp ? fr : (row & (SEQ - 1));
    const int b = samp ? (rt - MP / 16) : (row >> 12);
    const bf16* proj = (const bf16*)(a.ws + WS_PROJ);
    const bf16* pu = proj + (size_t)row * PP + C_PU + g * 64;
    const float* sp = a.in[5] + ((size_t)(l * SB + (samp ? b : 0)) * 15) * 256 + g * 64;
    const float inv = 1.0f / (float)(samp ? W : (t + 1 < W ? t + 1 : W));
    const bf16* pwt = (const bf16*)(a.ws + WS_PWT) + (size_t)(l * 4 + g) * 4096;
    const float* psc = a.in[13] + l * 256 + g * 64;
    const bf16* pg = proj + (size_t)row * PP + C_PG + g * 64;
    bf16x8 bfr[4][2]; f32x4 sc[4]; v2u gg[4];
    bf16x8 af[2];
    float* outp = samp ? a.out + O_PS + ((size_t)(l * SB + b) * 15) * 256 + g * 64 : a.out + O_PP + ((size_t)(l * NB + b) * 15) * 256 + g * 64;
#pragma unroll
    for (int kk = 0; kk < 2; ++kk) {
        const int ch = 32 * kk + 8 * fq;
        v4u xs[W];
#pragma unroll
        for (int j = 0; j < W; ++j) { const int jj = (t - j >= 0) ? j : 0; xs[j] = *(const v4u*)(pu - (size_t)jj * PP + ch); }
        if (kk == 0) {
#pragma unroll
            for (int n = 0; n < 4; ++n) {
#pragma unroll
                for (int k2 = 0; k2 < 2; ++k2) bfr[n][k2] = *(const bf16x8*)(pwt + (16 * n + fr) * 64 + 32 * k2 + 8 * fq);
                sc[n] = *(const f32x4*)(psc + 16 * n + 4 * fq); gg[n] = *(const v2u*)(pg + 16 * n + 4 * fq); }
        }
        SCHED_FENCE();
        float s[8], u[8];
#pragma unroll
        for (int e = 0; e < 4; ++e) { u[2 * e] = bflo(xs[0][e]); u[2 * e + 1] = bfhi(xs[0][e]); s[2 * e] = 0.f; s[2 * e + 1] = 0.f; }
#pragma unroll
        for (int j = 0; j < W; ++j) { const bool ok = (t - j >= 0);
#pragma unroll
            for (int e = 0; e < 4; ++e) { s[2 * e] += ok ? bflo(xs[j][e]) : 0.f; s[2 * e + 1] += ok ? bfhi(xs[j][e]) : 0.f; } }
        if (samp) {
#pragma unroll 1
            for (int j = 1; j < W; ++j) { const int tt = t - j;
                if (tt < 0) { const float* q = sp + (size_t)(15 + tt) * 256 + ch; const f32x4 x0 = *(const f32x4*)q, x1 = *(const f32x4*)(q + 4);
                    s[0] += x0[0]; s[1] += x0[1]; s[2] += x0[2]; s[3] += x0[3]; s[4] += x1[0]; s[5] += x1[1]; s[6] += x1[2]; s[7] += x1[3]; } }
        }
        v4u pk; pk.x = pk2(s[0] * inv - u[0], s[1] * inv - u[1]); pk.y = pk2(s[2] * inv - u[2], s[3] * inv - u[3]); pk.z = pk2(s[4] * inv - u[4], s[5] * inv - u[5]); pk.w = pk2(s[6] * inv - u[6], s[7] * inv - u[7]);
        af[kk] = __builtin_bit_cast(bf16x8, pk);
        const int orow = samp ? t - 1 : t - (SEQ - 15);
        if (orow >= 0) { float* q = outp + (size_t)orow * 256 + ch; *(f32x4*)q = (f32x4){u[0], u[1], u[2], u[3]}; *(f32x4*)(q + 4) = (f32x4){u[4], u[5], u[6], u[7]}; }
        SCHED_FENCE();
    }
    f32x4 acc[4];
#pragma unroll
    for (int n = 0; n < 4; ++n) { acc[n] = (f32x4){0.f, 0.f, 0.f, 0.f};
#pragma unroll
        for (int kk = 0; kk < 2; ++kk) acc[n] = __builtin_amdgcn_mfma_f32_16x16x32_bf16(bfr[n][kk], af[kk], acc[n], 0, 0, 0); }
    bf16* mix = (bf16*)(a.ws + WS_XN) + (size_t)row * DM + g * 64;
#pragma unroll
    for (int n = 0; n < 4; ++n) { const int d = 16 * n + 4 * fq;
        const float o0 = acc[n][0] * sc[n][0] * silu_f(bflo(gg[n].x)), o1 = acc[n][1] * sc[n][1] * silu_f(bfhi(gg[n].x)), o2 = acc[n][2] * sc[n][2] * silu_f(bflo(gg[n].y)), o3 = acc[n][3] * sc[n][3] * silu_f(bfhi(gg[n].y));
        v2u o; o.x = pk2(o0, o1); o.y = pk2(o2, o3); *(v2u*)(mix + d) = o; }
}

__device__ __forceinline__ void conv_item(const Args& a, int l, int rb, int tid, const Str& T) {
    const int chunk = tid & 31, run = tid >> 5, ch = chunk * 8;
    const bool samp = rb == MP / 128;
    const int row0 = rb * 128 + run * 8;
    const int t0 = samp ? (run & 1) * 8 : (row0 & (SEQ - 1));
    const int b = samp ? (run >> 1) : (row0 >> 12);
    if (samp && (b < T.sb0 || b >= T.sb0 + T.SBs)) return;
    const bf16* proj = (const bf16*)(a.ws + WS_PROJ);
    bf16* mix = (bf16*)(a.ws + WS_XN);
    float zm2[8], zm1[8], w0[8], w1[8], w2[8];
    { const float* cw = a.in[14] + (size_t)l * 3 * 256 + ch;
#pragma unroll
      for (int e = 0; e < 8; ++e) { w0[e] = cw[e]; w1[e] = cw[256 + e]; w2[e] = cw[512 + e]; } }
    const bool first = (t0 == 0);
    v4u hc2, hx2, hc1, hx1;
    { const bf16* p2 = proj + (size_t)(first ? row0 : row0 - 2) * PP; const bf16* p1 = proj + (size_t)(first ? row0 : row0 - 1) * PP;
      hc2 = *(const v4u*)(p2 + C_CC + ch); hx2 = *(const v4u*)(p2 + C_CX + ch); hc1 = *(const v4u*)(p1 + C_CC + ch); hx1 = *(const v4u*)(p1 + C_CX + ch); }
    float* outc = samp ? a.out + O_CS + ((size_t)(l * SB + b) * 2) * 256 + ch : a.out + O_CP + ((size_t)(l * NB + b) * 2) * 256 + ch;
    const int tlast = samp ? ST - 2 : SEQ - 2;
    v4u lcb[8], lcc[8], lcx[8], lcg[8];
#pragma unroll
    for (int i = 0; i < 8; ++i) { const bf16* p = proj + (size_t)(row0 + i) * PP;
        lcb[i] = *(const v4u*)(p + C_CB + ch); lcc[i] = *(const v4u*)(p + C_CC + ch); lcx[i] = *(const v4u*)(p + C_CX + ch); lcg[i] = *(const v4u*)(p + C_CG + ch); }
    SCHED_FENCE();
    if (first) {
        if (samp) { const float* sc = a.in[6] + ((size_t)(l * SB + b) * 2) * 256 + ch;
#pragma unroll
            for (int e = 0; e < 8; ++e) { zm2[e] = sc[e]; zm1[e] = sc[256 + e]; } }
        else {
#pragma unroll
            for (int e = 0; e < 8; ++e) { zm2[e] = 0.f; zm1[e] = 0.f; } }
    } else {
#pragma unroll
        for (int e = 0; e < 4; ++e) { zm2[2 * e] = bflo(hc2[e]) * bflo(hx2[e]); zm2[2 * e + 1] = bfhi(hc2[e]) * bfhi(hx2[e]); zm1[2 * e] = bflo(hc1[e]) * bflo(hx1[e]); zm1[2 * e + 1] = bfhi(hc1[e]) * bfhi(hx1[e]); }
    }
#pragma unroll
    for (int i = 0; i < 8; ++i) {
        const v4u cb = lcb[i], cc = lcc[i], cx = lcx[i], cgt = lcg[i];
        float z[8], o[8];
#pragma unroll
        for (int e = 0; e < 4; ++e) { z[2 * e] = bflo(cc[e]) * bflo(cx[e]); z[2 * e + 1] = bfhi(cc[e]) * bfhi(cx[e]); }
#pragma unroll
        for (int e = 0; e < 8; ++e) { const float y = w0[e] * zm2[e] + w1[e] * zm1[e] + w2[e] * z[e]; o[e] = y; zm2[e] = zm1[e]; zm1[e] = z[e]; }
#pragma unroll
        for (int e = 0; e < 4; ++e) { o[2 * e] *= bflo(cb[e]) * silu_f(bflo(cgt[e])); o[2 * e + 1] *= bfhi(cb[e]) * silu_f(bfhi(cgt[e])); }
        v4u ov; ov.x = pk2(o[0], o[1]); ov.y = pk2(o[2], o[3]); ov.z = pk2(o[4], o[5]); ov.w = pk2(o[6], o[7]);
        *(v4u*)(mix + (size_t)(row0 + i) * DM + 768 + ch) = ov;
        const int t = t0 + i;
        if (t >= tlast) { float* q = outc + (size_t)(t - tlast) * 256; *(f32x4*)q = (f32x4){z[0], z[1], z[2], z[3]}; *(f32x4*)(q + 4) = (f32x4){z[4], z[5], z[6], z[7]}; }
    }
}

__device__ __forceinline__ void mixer_phase(Frame& F, const Args& a, int l, const Str& T) {
    for (int r2_ = 0; r2_ < REP_CONV; ++r2_) { const int nb = T.rowsP / 128;
      for (int k = T.cs; k < nb + 1; k += T.GS) conv_item(a, l, k < nb ? T.rowP0 / 128 + k : MP / 128, F.tid, T); }
    const int gw = T.cs * NWAVES + F.wave, NGW = T.GS * NWAVES;
    const int ntp = T.rowsP / 16, NTs = ntp + T.SBs;
    for (int r3_ = 0; r3_ < REP_POOL; ++r3_) for (int k = gw; k < NTs * 4; k += NGW) { const int j = k % NTs, g = 3 - k / NTs; const int rt = j < ntp ? T.rowP0 / 16 + j : MP / 16 + T.sb0 + (j - ntp);
        if (g == 0) pool_task<2>(a, l, rt, 0, F.lane); else if (g == 1) pool_task<4>(a, l, rt, 1, F.lane); else if (g == 2) pool_task<8>(a, l, rt, 2, F.lane); else pool_task<16>(a, l, rt, 3, F.lane); }
}

__device__ __forceinline__ void small_mm(const bf16* A, const bf16* Bt, const int (&boff)[4], int lane, f32x4 (&acc)[4]) {
    const int fr = lane & 15, fq = lane >> 4;
    const bf16* ap = A + (size_t)fr * DM + 8 * fq;
    const bf16* bp[4];
#pragma unroll
    for (int n = 0; n < 4; ++n) { bp[n] = Bt + (size_t)(boff[n] + fr) * DM + 8 * fq; acc[n] = (f32x4){0.f, 0.f, 0.f, 0.f}; }
#pragma unroll 1
    for (int k0 = 0; k0 < DM / 32; k0 += 8) {
        bf16x8 av[8], bv[8][4];
#pragma unroll
        for (int i = 0; i < 8; ++i) { av[i] = *(const bf16x8*)(ap + 32 * (k0 + i));
#pragma unroll
            for (int n = 0; n < 4; ++n) bv[i][n] = *(const bf16x8*)(bp[n] + 32 * (k0 + i)); }
        SCHED_FENCE();
#pragma unroll
        for (int i = 0; i < 8; ++i)
#pragma unroll
            for (int n = 0; n < 4; ++n) acc[n] = __builtin_amdgcn_mfma_f32_16x16x32_bf16(bv[i][n], av[i], acc[n], 0, 0, 0);
        SCHED_FENCE();
    }
}
__device__ __forceinline__ void small_inproj_item(const Args& a, int l, int rb, int cb, int lane) {
    const int fr = lane & 15, fq = lane >> 4, pn = cb >> 2, hh = cb & 3;
    const bool headed = (pn >= 2 && pn <= 5);
    int boff[4];
#pragma unroll
    for (int n = 0; n < 4; ++n) boff[n] = headed ? pn * 256 + 32 * hh + (n & 1) * 16 + (n >> 1) * 128 : cb * 64 + 16 * n;
    f32x4 acc[4];
    small_mm((const bf16*)(a.ws + WS_XN) + (size_t)(MP + rb * 16) * DM, (const bf16*)(a.ws + WS_WIN) + (size_t)l * PP * DM, boff, lane, acc);
    const int lr = rb * 16 + fr;
    bf16* proj = (bf16*)(a.ws + WS_PROJ) + (size_t)(MP + lr) * PP;
    if (headed) {
        const bool isq = pn < 4; const int head = (pn & 1) * 4 + hh;
        const float* g = (isq ? a.in[10] : a.in[11]) + l * 64;
        float ss = 0.f;
#pragma unroll
        for (int n = 0; n < 4; ++n) ss += (acc[n][0] * acc[n][0] + acc[n][1] * acc[n][1]) + (acc[n][2] * acc[n][2] + acc[n][3] * acc[n][3]);
        ss += shx(ss, 16, lane); ss += shx(ss, 32, lane);
        const float rs = 1.0f / sqrtf(ss * (1.0f / 64.0f) + EPS) * (isq ? attn_body::C2 : 1.0f);
        bf16* kd = (bf16*)(a.ws + WS_KS) + ((size_t)(l * SB + rb) * KSROWS + PAST + fr) * 512 + head * 64;
        float* ko = a.out + O_KS + (size_t)l * MS * 512 + (size_t)lr * 512 + head * 64;
#pragma unroll
        for (int n = 0; n < 4; ++n) { const int d = 16 * n + 4 * fq; const f32x4 gv = *(const f32x4*)(g + d); const f32x4 y = acc[n] * rs * gv;
            v2u w; w.x = pk2(y[0], y[1]); w.y = pk2(y[2], y[3]);
            if (isq) *(v2u*)(proj + C_Q + head * 64 + d) = w;
            else { *(v2u*)(kd + d) = w; *(f32x4*)(ko + d) = y; } }
    } else if (pn == 6 || pn == 7) {
        const int c0 = cb * 64 - C_V;
        bf16* vd = (bf16*)(a.ws + WS_VS) + ((size_t)(l * SB + rb) * KSROWS + PAST + fr) * 512 + c0;
        float* vo = a.out + O_VS + (size_t)l * MS * 512 + (size_t)lr * 512 + c0;
#pragma unroll
        for (int n = 0; n < 4; ++n) { const int d = 16 * n + 4 * fq; v2u w; w.x = pk2(acc[n][0], acc[n][1]); w.y = pk2(acc[n][2], acc[n][3]); *(v2u*)(vd + d) = w; *(f32x4*)(vo + d) = acc[n]; }
    } else {
#pragma unroll
        for (int n = 0; n < 4; ++n) { const int d = cb * 64 + 16 * n + 4 * fq; v2u w; w.x = pk2(acc[n][0], acc[n][1]); w.y = pk2(acc[n][2], acc[n][3]); *(v2u*)(proj + d) = w; }
    }
}
__device__ __forceinline__ void small_outproj_item(const Args& a, int l, int rb, int cb, int lane, const float* base_s, float* out_s) {
    const int fr = lane & 15, fq = lane >> 4;
    int boff[4];
#pragma unroll
    for (int n = 0; n < 4; ++n) boff[n] = cb * 64 + 16 * n;
    f32x4 acc[4];
    small_mm((const bf16*)(a.ws + WS_XN) + (size_t)(MP + rb * 16) * DM, (const bf16*)(a.ws + WS_WOUT) + (size_t)l * DM * DM, boff, lane, acc);
    const size_t off = (size_t)(rb * 16 + fr) * DM + cb * 64 + 4 * fq;
#pragma unroll
    for (int n = 0; n < 4; ++n) { const f32x4 bs = *(const f32x4*)(base_s + off + 16 * n); *(f32x4*)(out_s + off + 16 * n) = bs + acc[n]; }
}

#define XB_TMO      128
#define XB_XCNT(j)  (256  + 64 * (j))
#define XB_XSUB(j)  (1280 + 64 * (j))
#define XB_XGEN(j)  (2304 + 64 * (j))
#define XB_TOP      3328
#define XB_TOPGEN   3392
#define XCD_BAR_WORDS 3456
#define XB_SPIN_CAP (1u << 18)

__device__ __forceinline__ unsigned xb_ld(unsigned* p)              { return __hip_atomic_load(p, __ATOMIC_RELAXED, __HIP_MEMORY_SCOPE_AGENT); }
__device__ __forceinline__ unsigned xb_add(unsigned* p, unsigned v) { return __hip_atomic_fetch_add(p, v, __ATOMIC_RELAXED, __HIP_MEMORY_SCOPE_AGENT); }
__device__ __forceinline__ unsigned xb_xcc_id() { return (unsigned)__builtin_amdgcn_s_getreg((3 << 11) | 20) & 0xFu; }
#define XB_SPIN(cond, bar) do { unsigned _sp = 0; while (cond) { __builtin_amdgcn_s_sleep(1); \
    if ((++_sp & 255u) == 0u) { if (xb_ld(&(bar)[XB_TMO])) break; if (_sp > XB_SPIN_CAP) { atomicAdd(&(bar)[XB_TMO], 1u); break; } } } } while (0)

__device__ __forceinline__ bool xb_is_t0(int w0) { int l_; asm volatile("v_mbcnt_lo_u32_b32 %0, -1, 0\n\tv_mbcnt_hi_u32_b32 %0, -1, %0" : "=v"(l_)); return w0 == 0 && l_ == 0; }
struct XcdBarrier {
    int w0; unsigned G; unsigned* bar; unsigned x;
    volatile LAS unsigned* st;
};

__device__ __forceinline__ XcdBarrier xcd_barrier_post(unsigned* bar, volatile LAS unsigned* st, int w0, unsigned G) {
    XcdBarrier b; b.w0 = w0; b.G = G; b.bar = bar; b.x = xb_xcc_id(); b.st = st;
    if (xb_is_t0(w0)) (void)xb_add(&bar[XB_XCNT(b.x)], 1u);
    return b;
}
__device__ __forceinline__ void xcd_barrier_complete(unsigned* bar, unsigned x, unsigned& nloc, unsigned& nx, unsigned G) {
    unsigned sum, cnt, mine, sp = 0u;
    for (;;) {
        sum = 0u; cnt = 0u; mine = 0u;
#pragma unroll
        for (unsigned j = 0; j < 16; ++j) { const unsigned c = xb_ld(&bar[XB_XCNT(j)]); sum += c; cnt += (c > 0u) ? 1u : 0u; mine = (j == x) ? c : mine; }
        if (sum == G) break;
        __builtin_amdgcn_s_sleep(1);
        if ((++sp & 255u) == 0u) { if (xb_ld(&bar[XB_TMO])) break; if (sp > XB_SPIN_CAP) { atomicAdd(&bar[XB_TMO], 1u); break; } }
    }
    nloc = mine > 0u ? mine : 1u; nx = cnt > 0u ? cnt : 1u;
}

__device__ __forceinline__ void xcd_barrier(const XcdBarrier& b) {
    asm volatile("s_waitcnt vmcnt(0)" ::: "memory");
    __syncthreads();
    if (xb_is_t0(b.w0)) {
        unsigned* bar = b.bar;
        __builtin_amdgcn_s_waitcnt(0);
        unsigned nloc = b.st[0], nx = b.st[1];
        if (nloc == 0u) { xcd_barrier_complete(bar, b.x, nloc, nx, b.G); b.st[0] = nloc; b.st[1] = nx; }
        const unsigned old = xb_add(&bar[XB_XSUB(b.x)], 1u);
        const unsigned gen = old / nloc;
        if (old + 1u == (gen + 1u) * nloc) {
            __builtin_amdgcn_fence(__ATOMIC_RELEASE, "agent");
            asm volatile("s_waitcnt vmcnt(0)" ::: "memory");
            const unsigned og = xb_add(&bar[XB_TOP], 1u);
            const unsigned tg = og / nx;
            if (og + 1u == (tg + 1u) * nx) xb_add(&bar[XB_TOPGEN], 1u);
            else XB_SPIN(xb_ld(&bar[XB_TOPGEN]) == tg, bar);
            __builtin_amdgcn_fence(__ATOMIC_ACQUIRE, "agent");
            xb_add(&bar[XB_XGEN(b.x)], 1u);
            asm volatile("s_waitcnt vmcnt(0)" ::: "memory");
        } else {
            XB_SPIN(xb_ld(&bar[XB_XGEN(b.x)]) == gen, bar);
            __builtin_amdgcn_fence(__ATOMIC_ACQUIRE, "agent");
            asm volatile("s_waitcnt vmcnt(0)" ::: "memory");
        }
    }
    __syncthreads();
}


__device__ __forceinline__ void attention_phase(Frame& F, const Args& a, int l, char* lds, const Str& T) {
    using abf = attn_body::bf16;
    const abf* proj = (const abf*)(a.ws + WS_PROJ);
    abf* mix = (abf*)(a.ws + WS_XN);
    const float* nbkp = (const float*)(a.ws + WS_NBKP); const float* nbks = (const float*)(a.ws + WS_NBKS);
    const int nsu = (T.rowsP / SEQ) * 16, bh0 = (T.rowP0 / SEQ) * 8;
    float skip_thr, floorz;
    { float gq = fabsf(a.in[10][l * 64 + F.lane]), gk = fabsf(a.in[11][l * 64 + F.lane]);
#pragma unroll
      for (int o = 1; o < 64; o <<= 1) { gq = fmaxf(gq, shx(gq, o, F.lane)); gk = fmaxf(gk, shx(gk, o, F.lane)); }
      const float qkmax = attn_body::C2 * 64.0f * gq * gk * 1.02f; floorz = fminf(0.0f, 100.0f - qkmax); skip_thr = qkmax - floorz + 134.0f + 2.0f; }
    const int NX = (T.GS % 8 == 0) ? 8 : 1;
    const int x = (NX == 8) ? (T.cs / (T.GS / 8)) : 0;
    const int nbh = (T.rowsP / SEQ) * 8 / NX, nbs = T.SBs * 8 / NX;
    const int NU = nbs + nbh * 16;
    unsigned* qcnt = (unsigned*)(a.ws + WS_BAR) + 8192 + (l * 8 + x) * 64 + T.s * 1024;
    volatile LAS int* slot = (volatile LAS int*)(F.lds + RING_BYTES + 1024);
    if (xb_is_t0(F.wave0)) *(volatile LAS float*)(F.lds + RING_BYTES + 1040) = floorz;
    (void)nsu;
#pragma unroll 1
    for (int it = 0;; ++it) {
        if (xb_is_t0(F.wave0)) slot[it & 1] = (int)__hip_atomic_fetch_add(qcnt, 1u, __ATOMIC_RELAXED, __HIP_MEMORY_SCOPE_AGENT);
        __syncthreads();
        const int j = slot[it & 1];
        if (j >= NU) break;
        {
            attn_body::AUnit U;
            if (j >= nbs) {
                const int jj = j - nbs, qb = 15 - jj / nbh;
                const int bh = bh0 + x * nbh + jj % nbh, b = bh >> 3, h = bh & 7;
                const size_t r0 = (size_t)b * SEQ + (size_t)qb * 256;
                U.Q = proj + r0 * PP + C_Q + h * 64; U.K = proj + (size_t)b * SEQ * PP + C_K + h * 64; U.V = proj + (size_t)b * SEQ * PP + C_V + h * 64;
                U.nbk = nbkp + (size_t)bh * SEQ; U.O = mix + r0 * DM + 256 + h * 64; U.G = proj + r0 * PP + C_AG + h * 64;
                U.kp = PP; U.NT = 4 * qb + 4; U.qoff = qb * 256; U.nvalid = 256;
            } else {
                const int bh = T.sb0 * 8 + x * nbs + j, b = bh >> 3, h = bh & 7;
                const size_t r0 = (size_t)MP + (size_t)b * ST;
                const size_t kb = ((size_t)(l * SB + b) * KSROWS) * 512 + h * 64;
                U.Q = proj + r0 * PP + C_Q + h * 64; U.K = (const abf*)(a.ws + WS_KS) + kb; U.V = (const abf*)(a.ws + WS_VS) + kb;
                U.nbk = nbks + (size_t)bh * NBKS; U.O = mix + r0 * DM + 256 + h * 64; U.G = proj + r0 * PP + C_AG + h * 64;
                U.kp = 512; U.NT = KSROWS / 64; U.qoff = PAST; U.nvalid = ST;
            }
            { const int tl = F.lane; const float ref = U.nbk[U.qoff];
              const float far = (tl < U.NT - 4) ? U.nbk[64 * tl + 63] : ref;
              const unsigned long long dead = __ballot((tl < U.NT - 4) && (ref - far > skip_thr));
              int D = (int)__builtin_ctzll(~dead) & ~1; D = __builtin_amdgcn_readfirstlane(D);
              if (D > U.NT - 4) D = (U.NT - 4) & ~1;
              U.K += (size_t)D * 64 * U.kp; U.V += (size_t)D * 64 * U.kp; U.nbk += D * 64; U.NT -= D; U.qoff -= D * 64; }
            if (F.wave0 * 32 < U.nvalid) attn_body::attn_unit<8>(U, lds, F.wave0); else attn_body::attn_unit_helper(U, lds, F.wave0);
        }
    }
    __syncthreads();
}

__global__ void __launch_bounds__(NWAVES * 64, 2) mega_fwd(Args args) {
    extern __shared__ __attribute__((aligned(16))) unsigned char lds[];
    cg::grid_group grid = cg::this_grid();
    Frame F;
    F.lds = (LAS unsigned char*)lds;
    F.wave0 = __builtin_amdgcn_readfirstlane((int)threadIdx.x >> 6); FRAME_REFRESH(F);
    F.G = gridDim.x; { const int bx = blockIdx.x; F.vcu = (F.G % 8 == 0) ? (bx % 8) * (F.G / 8) + bx / 8 : bx; }
    const int NS = 1;
    Str T; Str T0;
    { const int bx = blockIdx.x, xi = bx / 8, xc = bx % 8;
      T.s = NS == 2 ? (xi & 1) : 0; T.GS = F.G / NS; T.cs = NS == 2 ? (xc * (F.G / 16) + (xi >> 1)) : F.vcu; T.cg = NS == 2 ? ((xi >> 1) * 8 + xc) : bx;
      T.rowsP = MP / NS; T.rowP0 = T.s * T.rowsP; T.SBs = SB / NS; T.sb0 = T.s * T.SBs;
      T0.s = 0; T0.GS = F.G; T0.cs = F.vcu; T0.cg = bx; T0.rowsP = MP; T0.rowP0 = 0; T0.SBs = SB; T0.sb0 = 0; }
    unsigned* barw = (unsigned*)(args.ws + WS_BAR) + T.s * 4096;
    volatile LAS unsigned* barst = (volatile LAS unsigned*)(F.lds + RING_BYTES + 512);
#define SEAM(k) do { xcd_barrier(bar); } while (0)
    XcdBarrier bar; bar.w0 = F.wave0; bar.bar = barw; bar.x = 0; bar.st = barst; bar.G = (unsigned)T.GS;
    if (threadIdx.x < 2) barst[threadIdx.x] = 0u;
    if (blockIdx.x == 0) for (int i_ = threadIdx.x; i_ < 2 * 4096 + 2048; i_ += NWAVES * 64) ((unsigned*)(args.ws + WS_BAR))[i_] = 0u;
    __syncthreads();
    unsigned char* ws = args.ws;
    float* out = args.out;

    for (int r_ = 0; r_ < REP_P0; ++r_) { p0_prologue(F, args); __syncthreads(); }
    for (int r_ = 0; r_ < REP_PA; ++r_) pa_phase(F, args, 0, args.in[0], args.in[1], T0);
    grid.sync();
    bar = xcd_barrier_post(barw, barst, F.wave0, (unsigned)T.GS);
    if (T.s == 1) stagger_wait(1);
#pragma unroll 1
    for (int l = 0; l < NL; ++l) {
        {
            FRAME_REFRESH(F);
            scan_phase(F, args, l, T);
            { const int nscan = (T.rowsP / SEQ) * 8 + T.SBs * 8;
              const int nfree = T.GS > nscan ? T.GS - nscan : T.GS; const int w0 = ((T.GS > nscan ? T.cs - nscan : T.cs)) * NWAVES + F.wave;
              if (w0 >= 0) for (int it = w0; it < T.SBs * (PP / 64); it += nfree * NWAVES) small_inproj_item(args, l, T.sb0 + it / (PP / 64), it % (PP / 64), F.lane);
              __syncthreads(); }
            pg8::Gemm g{(const bf16*)(ws + WS_XN) + (size_t)T.rowP0 * DM, (const bf16*)(ws + WS_WIN) + (size_t)l * PP * DM, T.rowsP, PP, DM};
            pg8::StaticOrder S; S.init(T.rowsP, PP, T.GS, T.cg);
            pg8::EpiIn E;
            E.proj = (bf16*)(ws + WS_PROJ); E.ks = (bf16*)(ws + WS_KS) + (size_t)l * SB * KSROWS * 512; E.vs = (bf16*)(ws + WS_VS) + (size_t)l * SB * KSROWS * 512;
            E.outk_p = out + O_KP + (size_t)l * MP * 512; E.outv_p = out + O_VP + (size_t)l * MP * 512;
            E.outk_s = out + O_KS + (size_t)l * MS * 512; E.outv_s = out + O_VS + (size_t)l * MS * 512;
            E.qg = args.in[10] + l * 64; E.kg = args.in[11] + l * 64; E.row0 = T.rowP0;
            for (int r_ = 0; r_ < REP_GIN; ++r_) pg8::gemm_phase<pg8::EpiIn, pg8::StaticOrder, true, true>(F.lds, g, S, E, F.tid);
        }
        SEAM(0);
        {
            FRAME_REFRESH(F);
            for (int r_ = 0; r_ < REP_MIX; ++r_) mixer_phase(F, args, l, T);
            __syncthreads();
            for (int r_ = 0; r_ < REP_ATTN; ++r_) attention_phase(F, args, l, (char*)lds, T);
        }
        SEAM(1);
        {
            FRAME_REFRESH(F);
            { const int gw = T.cs * NWAVES + F.wave;
              for (int it = gw; it < T.SBs * (DM / 64); it += T.GS * NWAVES) small_outproj_item(args, l, T.sb0 + it / (DM / 64), it % (DM / 64), F.lane, l == 0 ? args.in[1] : out + O_YS, out + O_YS);
              __syncthreads(); }
            pg8::Gemm g{(const bf16*)(ws + WS_XN) + (size_t)T.rowP0 * DM, (const bf16*)(ws + WS_WOUT) + (size_t)l * DM * DM, T.rowsP, DM, DM};
            pg8::StaticOrder S; S.init(T.rowsP, DM, T.GS, T.cg);
            if (l == 0) { pg8::EpiOutB E; E.base_p = args.in[0]; E.out_b = (bf16*)(ws + WS_X1B); E.row0 = T.rowP0;
                for (int r_ = 0; r_ < REP_GOUT0; ++r_) pg8::gemm_phase<pg8::EpiOutB, pg8::StaticOrder, true, true>(F.lds, g, S, E, F.tid); }
            else { pg8::EpiOutF E; E.base_b = (const bf16*)(ws + WS_X1B); E.out_p = out + O_YP; E.row0 = T.rowP0;
                pg8::gemm_phase<pg8::EpiOutF, pg8::StaticOrder, true, true>(F.lds, g, S, E, F.tid); }
        }
        if (l + 1 < NL) {
            SEAM(2);
            { FRAME_REFRESH(F); for (int r_ = 0; r_ < REP_PA; ++r_) pa_phase(F, args, l + 1, out + O_YP, out + O_YS, T, (const bf16*)(ws + WS_X1B)); }
            SEAM(3);
        }
    }
#undef SEAM
}

#ifndef MK_MULTI
#define MK_MULTI 0
#endif
constexpr int N_PHASES = 8;

extern "C" void kernel_launch(void* const* d_in, const int* in_sizes, int n_in, void* d_out, int out_size, void* d_ws, size_t ws_size, hipStream_t stream) {
    static int grid = 0;
    if (grid == 0) {
        if (n_in != 16 || (size_t)out_size != O_END || ws_size < WS_END) { fprintf(stderr, "kernel_launch: shape mismatch: n_in %d out %d (want %zu) ws %zu (want %zu)\n", n_in, out_size, (size_t)O_END, ws_size, (size_t)WS_END); grid = -1; return; }
        int dev = 0, cus = 0, per_cu = 0;
        if (hipGetDevice(&dev) != hipSuccess || hipDeviceGetAttribute(&cus, hipDeviceAttributeMultiprocessorCount, dev) != hipSuccess) { grid = -1; return; }
        if (hipFuncSetAttribute((const void*)mega_fwd, hipFuncAttributeMaxDynamicSharedMemorySize, LDS_BYTES) != hipSuccess) { fprintf(stderr, "kernel_launch: hipFuncSetAttribute failed\n"); grid = -1; return; }
        if (hipOccupancyMaxActiveBlocksPerMultiprocessor(&per_cu, (const void*)mega_fwd, NWAVES * 64, LDS_BYTES) != hipSuccess || per_cu < 1) { fprintf(stderr, "kernel_launch: occupancy query says %d\n", per_cu); per_cu = 1; }
        (void)hipGetLastError();
        grid = cus * 1;
    }
    if (grid < 0) return;
    Args a{};
    for (int i = 0; i < 16; ++i) a.in[i] = (const float*)d_in[i];
    a.out = (float*)d_out; a.ws = (unsigned char*)d_ws;
#if MK_MULTI
    for (int p = 0; p < N_PHASES; ++p) { a.ph_lo = p; a.ph_hi = p + 1; hipLaunchKernelGGL(mega_fwd, dim3(grid), dim3(NWAVES * 64), LDS_BYTES, stream, a); }
#else
    a.ph_lo = 0; a.ph_hi = N_PHASES;
    void* kargs[] = {&a};
    hipError_t e = hipLaunchCooperativeKernel((const void*)mega_fwd, dim3(grid), dim3(NWAVES * 64), kargs, LDS_BYTES, stream);
    if (e != hipSuccess) fprintf(stderr, "cooperative launch failed: %s (grid %d)\n", hipGetErrorString(e), grid);
#endif
}
```
